# Optimizing an MI355X kernel written in HIP

```python
import jax, jax.numpy as jnp
from jax import lax
import numpy as np

D_MODEL = 1024
BATCH = 8
SEQ = 4096
DEPTH = 1

HEAD_DIM = 64
DIL_GROUPS = ((128, 1), (512, 4), (2048, 16))
N_DIL_GROUPS = 3
DIL_HEADS = 4
DIL_WIDTH = N_DIL_GROUPS * DIL_HEADS * HEAD_DIM
DIL_OUT = DIL_HEADS * HEAD_DIM
FOX_HEADS = 8
FOX_WIDTH = FOX_HEADS * HEAD_DIM
MEM_HEADS = 4
MEM_HEAD_DIM = 128
MEM_WIDTH = MEM_HEADS * MEM_HEAD_DIM
MEM_LEN = 256
ROT_DIM = HEAD_DIM // 4
ROPE_THETA = 500000.0
D_FF = 4 * D_MODEL
N_BRANCH = 3
BLOCK_Q = 128
IN_SPLITS = (DIL_WIDTH, DIL_WIDTH, DIL_WIDTH, FOX_WIDTH, FOX_WIDTH, FOX_WIDTH, FOX_HEADS, MEM_WIDTH)
IN_WIDTH = 3 * DIL_WIDTH + 3 * FOX_WIDTH + FOX_HEADS + MEM_WIDTH
EPS = 1e-6

kernel_name = "hybrid_gated_dilated_fox_memory_layer"


def rmsnorm(x, g):
    xf = x.astype(jnp.float32)
    y = xf * lax.rsqrt(jnp.mean(xf * xf, axis=-1, keepdims=True) + EPS)
    return (y * g.astype(jnp.float32)).astype(x.dtype)


def partial_rope(x, cos, sin):
    half = ROT_DIM // 2
    c = cos[None, :, None, None, :].astype(x.dtype)
    s = sin[None, :, None, None, :].astype(x.dtype)
    x1 = x[..., :half]
    x2 = x[..., half:ROT_DIM]
    return jnp.concatenate([x1 * c - x2 * s, x2 * c + x1 * s, x[..., ROT_DIM:]], axis=-1)


def banded_causal_attention(q, k, v, n_back):
    G, N, H, E = q.shape
    C = n_back
    nb = -(-N // C)
    pad = nb * C - N
    padw = ((0, 0), (0, pad), (0, 0), (0, 0))
    qb = jnp.pad(q.astype(jnp.float32), padw).reshape(G, nb, C, H, E)
    kb = jnp.pad(k.astype(jnp.float32), padw).reshape(G, nb, C, H, E)
    vb = jnp.pad(v.astype(jnp.float32), padw).reshape(G, nb, C, H, E)
    k_prev = jnp.concatenate([jnp.zeros_like(kb[:, :1]), kb[:, :-1]], axis=1)
    v_prev = jnp.concatenate([jnp.zeros_like(vb[:, :1]), vb[:, :-1]], axis=1)
    kk = jnp.concatenate([k_prev, kb], axis=2)
    vv = jnp.concatenate([v_prev, vb], axis=2)
    s = jnp.einsum('gbqhe,gbkhe->gbhqk', qb, kk) * (HEAD_DIM ** -0.5)
    qi = jnp.arange(C)[:, None]
    kj = jnp.arange(2 * C)[None, :]
    dist = qi + C - kj
    in_band = (dist >= 0) & (dist <= n_back)
    blk_ok = (jnp.arange(nb)[:, None] > 0) | (jnp.arange(2 * C)[None, :] >= C)
    mask = in_band[None, :, :] & blk_ok[:, None, :]
    s = jnp.where(mask[None, :, None], s, -jnp.inf)
    m = jnp.max(s, axis=-1, keepdims=True)
    p = jnp.exp(s - m)
    den = jnp.sum(p, axis=-1, keepdims=True)
    out = jnp.einsum('gbhqk,gbkhe->gbqhe', p, vv) / den.transpose(0, 1, 3, 2, 4)
    lse = (m + jnp.log(den))[..., 0].transpose(0, 1, 3, 2)
    out = out.reshape(G, nb * C, H, E)[:, :N]
    lse = lse.reshape(G, nb * C, H)[:, :N]
    return out, lse


def dilated_group(q, k, v, window, dilation):
    B, T, H, E = q.shape
    n = T // dilation

    def to_sub(a):
        return a.reshape(B, n, dilation, H, E).transpose(0, 2, 1, 3, 4).reshape(B * dilation, n, H, E)

    out, lse = banded_causal_attention(to_sub(q), to_sub(k), to_sub(v), window // dilation)
    out = out.reshape(B, dilation, n, H, E).transpose(0, 2, 1, 3, 4).reshape(B, T, H, E)
    lse = lse.reshape(B, dilation, n, H).transpose(0, 2, 1, 3).reshape(B, T, H)
    return out, lse


def fox_attention(q, k, v, logf):
    B, T, H, E = q.shape
    nq = T // BLOCK_Q
    kf = k.astype(jnp.float32)
    vf = v.astype(jnp.float32)
    c = jnp.cumsum(logf.astype(jnp.float32), axis=1)
    q_blocks = q.astype(jnp.float32).reshape(B, nq, BLOCK_Q, H, E).transpose(1, 0, 2, 3, 4)
    c_blocks = c.reshape(B, nq, BLOCK_Q, H).transpose(1, 0, 2, 3)
    starts = jnp.arange(nq) * BLOCK_Q
    c_keys = c.transpose(0, 2, 1)
    key_pos = jnp.arange(T)

    def one_block(args):
        qi, ci, start = args
        s = jnp.einsum('bqhe,bkhe->bhqk', qi, kf) * (HEAD_DIM ** -0.5)
        s = s + ci.transpose(0, 2, 1)[..., None] - c_keys[:, :, None, :]
        qpos = start + jnp.arange(BLOCK_Q)
        s = jnp.where(key_pos[None, :] <= qpos[:, None], s, -jnp.inf)
        p = jax.nn.softmax(s, axis=-1)
        return jnp.einsum('bhqk,bkhe->bqhe', p, vf)

    out = lax.map(one_block, (q_blocks, c_blocks, starts))
    return out.transpose(1, 0, 2, 3, 4).reshape(B, T, H * E)


def setup_inputs(seed: int = 0) -> dict:
    key = jax.random.key(seed)
    ks = jax.random.split(key, 24)
    L, D = DEPTH, D_MODEL

    def nrm(k, shape, fan_in):
        return jax.random.normal(k, shape, jnp.float32) * (fan_in ** -0.5)

    def gain(k, shape):
        return 1.0 + 0.05 * jax.random.normal(k, shape, jnp.float32)

    return {
        "x": jax.random.normal(ks[0], (BATCH, SEQ, D), jnp.float32),
        "mem": jax.random.normal(ks[1], (BATCH, MEM_LEN, D), jnp.float32),
        "g_mix": gain(ks[2], (L, D)),
        "w_in": nrm(ks[3], (L, D, IN_WIDTH), D),
        "b_f": 3.0 + 0.1 * jax.random.normal(ks[4], (L, FOX_HEADS), jnp.float32),
        "g_qA": gain(ks[5], (L, HEAD_DIM)),
        "g_kA": gain(ks[6], (L, HEAD_DIM)),
        "g_qB": gain(ks[7], (L, HEAD_DIM)),
        "g_kB": gain(ks[8], (L, HEAD_DIM)),
        "g_mem": gain(ks[9], (L, D)),
        "w_mem_kv": nrm(ks[10], (L, D, 2 * MEM_WIDTH), D),
        "g_qM": gain(ks[11], (L, MEM_HEAD_DIM)),
        "g_kM": gain(ks[12], (L, MEM_HEAD_DIM)),
        "w_gate": nrm(ks[13], (L, D, N_BRANCH * D), D),
        "b_gate": 0.1 * jax.random.normal(ks[14], (L, N_BRANCH * D), jnp.float32),
        "w_br_a": nrm(ks[15], (L, DIL_OUT, D), DIL_OUT),
        "w_br_b": nrm(ks[16], (L, FOX_WIDTH, D), FOX_WIDTH),
        "w_br_m": nrm(ks[17], (L, MEM_WIDTH, D), MEM_WIDTH),
        "w_out": nrm(ks[18], (L, D, D), D),
        "g_mlp": gain(ks[19], (L, D)),
        "w_up": nrm(ks[20], (L, D, D_FF), D),
        "w_down": nrm(ks[21], (L, D_FF, D), D_FF),
    }


def reference(x, mem, g_mix, w_in, b_f, g_qA, g_kA, g_qB, g_kB, g_mem, w_mem_kv, g_qM, g_kM,
              w_gate, b_gate, w_br_a, w_br_b, w_br_m, w_out, g_mlp, w_up, w_down):
    B, T, D = x.shape
    dt = x.dtype
    inv_freq = ROPE_THETA ** (-jnp.arange(0, ROT_DIM, 2, dtype=jnp.float32) / ROT_DIM)
    ang = jnp.arange(T, dtype=jnp.float32)[:, None] * inv_freq[None, :]
    cos, sin = jnp.cos(ang), jnp.sin(ang)
    offs = []
    acc = 0
    for w in IN_SPLITS[:-1]:
        acc += w
        offs.append(acc)

    for l in range(DEPTH):
        h = rmsnorm(x, g_mix[l])
        proj = h @ w_in[l]
        qa, ka, va, qb, kb, vb, fl, qm = jnp.split(proj, offs, axis=-1)

        qa = partial_rope(rmsnorm(qa.reshape(B, T, N_DIL_GROUPS, DIL_HEADS, HEAD_DIM), g_qA[l]), cos, sin)
        ka = partial_rope(rmsnorm(ka.reshape(B, T, N_DIL_GROUPS, DIL_HEADS, HEAD_DIM), g_kA[l]), cos, sin)
        va = va.reshape(B, T, N_DIL_GROUPS, DIL_HEADS, HEAD_DIM)
        outs, lses = [], []
        for gi, (win, dil) in enumerate(DIL_GROUPS):
            o, s = dilated_group(qa[:, :, gi], ka[:, :, gi], va[:, :, gi], win, dil)
            outs.append(o)
            lses.append(s)
        alpha = jax.nn.softmax(jnp.stack(lses, axis=0), axis=0)
        ya = jnp.sum(alpha[..., None] * jnp.stack(outs, axis=0), axis=0).reshape(B, T, DIL_OUT).astype(dt)

        qb = rmsnorm(qb.reshape(B, T, FOX_HEADS, HEAD_DIM), g_qB[l])
        kb = rmsnorm(kb.reshape(B, T, FOX_HEADS, HEAD_DIM), g_kB[l])
        vb = vb.reshape(B, T, FOX_HEADS, HEAD_DIM)
        logf = jax.nn.log_sigmoid(fl.astype(jnp.float32) + b_f[l].astype(jnp.float32))
        yb = fox_attention(qb, kb, vb, logf).astype(dt)

        mem_n = rmsnorm(mem, g_mem[l])
        km, vm = jnp.split(mem_n @ w_mem_kv[l], 2, axis=-1)
        km = rmsnorm(km.reshape(B, MEM_LEN, MEM_HEADS, MEM_HEAD_DIM), g_kM[l]).astype(jnp.float32)
        vm = vm.reshape(B, MEM_LEN, MEM_HEADS, MEM_HEAD_DIM).astype(jnp.float32)
        qm = rmsnorm(qm.reshape(B, T, MEM_HEADS, MEM_HEAD_DIM), g_qM[l]).astype(jnp.float32)
        sm = jnp.einsum('bthe,bshe->bhts', qm, km) * (MEM_HEAD_DIM ** -0.5)
        pm = jax.nn.softmax(sm, axis=-1)
        ym = jnp.einsum('bhts,bshe->bthe', pm, vm).reshape(B, T, MEM_WIDTH).astype(dt)

        gates = jax.nn.sigmoid(h @ w_gate[l] + b_gate[l]).reshape(B, T, N_BRANCH, D)
        merged = (gates[:, :, 0] * (ya @ w_br_a[l])
                  + gates[:, :, 1] * (yb @ w_br_b[l])
                  + gates[:, :, 2] * (ym @ w_br_m[l]))
        x = x + merged @ w_out[l]

        h2 = rmsnorm(x, g_mlp[l])
        x = x + jnp.square(jax.nn.relu(h2 @ w_up[l])) @ w_down[l]
    return x
```

```cpp
#include <hip/hip_runtime.h>
#include <hip/hip_cooperative_groups.h>
#include <cstdio>
#include <cstdint>
namespace cg = cooperative_groups;

#ifndef MK_MULTI
#define MK_MULTI 0
#endif

#define LAS __attribute__((address_space(3)))
typedef unsigned short bf16_t;
typedef short bf16x8 __attribute__((ext_vector_type(8)));
typedef short s16x4 __attribute__((ext_vector_type(4)));
typedef float f32x4 __attribute__((ext_vector_type(4)));
typedef float f32x16 __attribute__((ext_vector_type(16)));
typedef unsigned u32x4 __attribute__((ext_vector_type(4)));
typedef unsigned u32x2 __attribute__((ext_vector_type(2)));

constexpr int B_ = 8, T_ = 4096, DM = 1024, M_ = B_ * T_;
constexpr int NPH = 8;
constexpr float EPS_ = 1e-6f;
constexpr float LOG2E = 1.4426950408889634f, LN2 = 0.6931471805599453f;
constexpr float QSCALE = 0.125f * LOG2E;
constexpr float QSCALE_M = 0.08838834764831845f * LOG2E;

constexpr size_t MiB = 1u << 20;
constexpr size_t WS_SSQ = 0, WS_COS = 256 * 1024, WS_SIN = 384 * 1024, WS_BAR = 512 * 1024, WS_BAR_BYTES = 16384;
constexpr size_t WS_LOGF = 1 * MiB, WS_C2 = 2 * MiB, WS_LSE = 3 * MiB, WS_LO = 4 * MiB + 768 * 1024;
constexpr size_t WS_WCAT = 5 * MiB, WS_WBR = 22 * MiB, WS_WOUT = 25 * MiB, WS_WUP = 27 * MiB, WS_WDN = 35 * MiB;
constexpr size_t WS_KM = 43 * MiB, WS_VM = 45 * MiB;
constexpr size_t WS_QA = 48 * MiB, WS_KA = 96 * MiB, WS_VA = 144 * MiB, WS_QB = 192 * MiB, WS_KB = 224 * MiB, WS_VB = 256 * MiB, WS_QM = 288 * MiB;
constexpr size_t WS_GATES = 320 * MiB, WS_END = 512 * MiB;
constexpr size_t WS_MERGED = 48 * MiB, WS_X1B = 320 * MiB, WS_HMID = 48 * MiB;
constexpr size_t DO_DIL = 0, DO_Y = 48 * MiB;
constexpr int LDS_BYTES = 147456;

struct Params { const float* in[22]; float* out; unsigned char* ws; int ph_lo, ph_hi; };

__device__ __forceinline__ unsigned pk2(float lo, float hi) {
    typedef float f2 __attribute__((ext_vector_type(2))); typedef __bf16 b2 __attribute__((ext_vector_type(2)));
    f2 v = {lo, hi}; b2 b = __builtin_convertvector(v, b2); return __builtin_bit_cast(unsigned, b);
}
__device__ __forceinline__ float bf2f(unsigned short u) { return __uint_as_float(((unsigned)u) << 16); }
__device__ __forceinline__ u32x4 pack8(f32x4 a, f32x4 b) { u32x4 w; w.x = pk2(a[0], a[1]); w.y = pk2(a[2], a[3]); w.z = pk2(b[0], b[1]); w.w = pk2(b[2], b[3]); return w; }
__device__ __forceinline__ void unpack8(u32x4 w, f32x4& a, f32x4& b) {
    a[0] = __uint_as_float(w.x << 16); a[1] = __uint_as_float(w.x & 0xffff0000u); a[2] = __uint_as_float(w.y << 16); a[3] = __uint_as_float(w.y & 0xffff0000u);
    b[0] = __uint_as_float(w.z << 16); b[1] = __uint_as_float(w.z & 0xffff0000u); b[2] = __uint_as_float(w.w << 16); b[3] = __uint_as_float(w.w & 0xffff0000u);
}
__device__ __forceinline__ float sigmoidf_(float x) { return __builtin_amdgcn_rcpf(1.0f + __builtin_amdgcn_exp2f(-x * LOG2E)); }

namespace pg8 {
constexpr int BM = 256, BK = 64, HALF = 128, HTB = HALF * BK * 2, STAGE_BYTES = 8 * HTB, NXCD = 8, WGM = 8;
__host__ __device__ __forceinline__ int lds_byte(int r, int c) { const int st = (r >> 4) * 2 + (c >> 5), rr = r & 15, cc = c & 31, ob = rr * 64 + cc * 2; return st * 1024 + (ob ^ (((ob >> 9) & 1) << 5)); }
__host__ __device__ __forceinline__ void stage_rc(int b, int& R, int& C) { const int st = b / 1024, sb = b % 1024, swz = sb ^ (((sb >> 9) & 1) << 5); R = (st >> 1) * 16 + swz / 64; C = (st & 1) * 32 + (swz % 64) / 2; }
__host__ __device__ __forceinline__ int perm32(int rho) { const int n = rho >> 4, i = rho & 15; return 8 * (i >> 2) + 4 * n + (i & 3); }

struct Unit { int pm, pn, k0, nt, tag, first; };
struct Gemm { const bf16_t* A; const bf16_t* Bt; int lda, ldb; };

__device__ __forceinline__ void tile_order(int L, int nM, int nN, int& pm, int& pn) {
    const int nwg = nM * nN; int wgid = L;
    { const int q = nwg / NXCD, r = nwg % NXCD, xcd = wgid % NXCD, off = wgid / NXCD; wgid = (xcd < r ? xcd * (q + 1) : r * (q + 1) + (xcd - r) * q) + off; }
    const int nig = WGM * nN, gid = wgid / nig, fm = gid * WGM, gsz = (nM - fm) < WGM ? (nM - fm) : WGM;
    pm = fm + ((wgid % nig) % gsz); pn = (wgid % nig) / gsz;
}

template <class Epi, class Sched>
__device__ __forceinline__ void gemm_phase(LAS unsigned char* lds, const Gemm g, const Sched& S, const Epi& E) {
    const int tid = threadIdx.x, wid = __builtin_amdgcn_readfirstlane(tid >> 6), lane = tid & 63, wr = wid >> 2, wc = wid & 3, fr = lane & 15, fq = lane >> 4;
    unsigned voffA[2], voffB[2];
#pragma unroll
    for (int i = 0; i < 2; ++i) { int R, C; stage_rc(tid * 16 + i * 8192, R, C); const int Rb = (R & ~31) + perm32(R & 31);
        voffA[i] = (unsigned)(R * g.lda + C) * 2u; voffB[i] = (unsigned)(Rb * g.ldb + C) * 2u; }
    const size_t kstep = (size_t)(BK * 2);
    const size_t hstepA = (size_t)HALF * g.lda * 2, hstepB = (size_t)HALF * g.ldb * 2, tstepA = 2 * hstepA, tstepB = 2 * hstepB;
    const unsigned ldsw = (unsigned)wid * 1024u;
    const int aoff = lds_byte(wr * 64 + fr, fq * 8), boff = lds_byte(wc * 32 + fr, fq * 8);
#define PG8_SA(b, h) (((b) * 2 + (h)) * HTB)
#define PG8_SB(b, h) ((4 + (b) * 2 + (h)) * HTB)
#define PG8_STAGE(bufoff, gbase, voff) do { _Pragma("unroll") for (int _i = 0; _i < 2; ++_i) \
        __builtin_amdgcn_global_load_lds((const unsigned*)((const char*)(gbase) + (voff)[_i]), (LAS unsigned*)(lds + (bufoff) + ldsw + _i * 8192), 16, 0, 0); } while (0)
#define PG8_LDA(dst, b, h) do { _Pragma("unroll") for (int m = 0; m < 4; ++m) _Pragma("unroll") for (int k = 0; k < 2; ++k) dst[m][k] = *(const LAS bf16x8*)(lds + PG8_SA(b, h) + aoff + m * 2048 + k * 1024); } while (0)
#define PG8_LDB(dst, b, h) do { _Pragma("unroll") for (int n = 0; n < 2; ++n) _Pragma("unroll") for (int k = 0; k < 2; ++k) dst[n][k] = *(const LAS bf16x8*)(lds + PG8_SB(b, h) + boff + n * 2048 + k * 1024); } while (0)
#define PG8_MMA(ai, bj, At, Bt) do { __builtin_amdgcn_s_setprio(1); _Pragma("unroll") for (int m = 0; m < 4; ++m) _Pragma("unroll") for (int n = 0; n < 2; ++n) _Pragma("unroll") for (int k = 0; k < 2; ++k) \
        acc[ai][bj][m][n] = __builtin_amdgcn_mfma_f32_16x16x32_bf16(Bt[n][k], At[m][k], acc[ai][bj][m][n], 0, 0, 0); __builtin_amdgcn_s_setprio(0); } while (0)
#define PG8_WAIT_V(n) asm volatile("s_waitcnt vmcnt(" #n ")" ::: "memory")
#define PG8_WAIT_L(n) asm volatile("s_waitcnt lgkmcnt(" #n ")" ::: "memory")
#define PG8_BAR __builtin_amdgcn_s_barrier()
#define PG8_SCHED __builtin_amdgcn_sched_barrier(0)
    Unit cur, nxt; int ui = 0;
    if (!S.next(0, cur)) return;
    f32x4 acc[2][2][4][2];
#pragma unroll
    for (int a = 0; a < 2; ++a)
#pragma unroll
        for (int b = 0; b < 2; ++b)
#pragma unroll
            for (int m = 0; m < 4; ++m)
#pragma unroll
                for (int n = 0; n < 2; ++n) acc[a][b][m][n] = (f32x4){0.f, 0.f, 0.f, 0.f};
    bf16x8 At[4][2], B0[2][2], B1[2][2];
    const char* cA = (const char*)g.A + (size_t)cur.pm * tstepA + (size_t)cur.k0 * 2; const char* cB = (const char*)g.Bt + (size_t)cur.pn * tstepB + (size_t)cur.k0 * 2;
    PG8_STAGE(PG8_SB(0, 0), cB, voffB); PG8_STAGE(PG8_SB(0, 1), cB + hstepB, voffB); PG8_STAGE(PG8_SA(0, 0), cA, voffA); PG8_STAGE(PG8_SA(0, 1), cA + hstepA, voffA);
    if (wr == 1) PG8_BAR;
    PG8_WAIT_V(2); PG8_BAR;
    PG8_STAGE(PG8_SB(1, 0), cB + kstep, voffB); PG8_STAGE(PG8_SA(1, 0), cA + kstep, voffA); PG8_STAGE(PG8_SB(1, 1), cB + hstepB + kstep, voffB);
    PG8_WAIT_V(6); PG8_BAR;
    for (;;) {
        const bool has_next = S.next(ui + 1, nxt);
        const char* nA = has_next ? (const char*)g.A + (size_t)nxt.pm * tstepA + (size_t)nxt.k0 * 2 : cA; const char* nB = has_next ? (const char*)g.Bt + (size_t)nxt.pn * tstepB + (size_t)nxt.k0 * 2 : cB;
        const int nt = cur.nt;
        for (int t = 0; t < nt; t += 2) {
            const bool last = (t == nt - 2);
            const char* a1 = cA + (size_t)(t + 1) * kstep;
            const char* a2 = last ? nA : cA + (size_t)(t + 2) * kstep; const char* b2 = last ? nB : cB + (size_t)(t + 2) * kstep;
            const char* a3 = a2 + kstep; const char* b3 = b2 + kstep;
            PG8_LDB(B0, 0, 0); PG8_LDB(B1, 0, 1); PG8_SCHED; PG8_LDA(At, 0, 0); PG8_STAGE(PG8_SA(1, 1), a1 + hstepA, voffA);
            PG8_WAIT_V(8); PG8_WAIT_L(0); PG8_BAR; PG8_MMA(0, 0, At, B0); PG8_MMA(0, 1, At, B1); PG8_BAR; PG8_SCHED;
            PG8_LDA(At, 0, 1); PG8_STAGE(PG8_SB(0, 0), b2, voffB); PG8_STAGE(PG8_SB(0, 1), b2 + hstepB, voffB); PG8_STAGE(PG8_SA(0, 0), a2, voffA);
            PG8_WAIT_V(8); PG8_WAIT_L(0); PG8_BAR; PG8_MMA(1, 0, At, B0); PG8_MMA(1, 1, At, B1); PG8_BAR; PG8_SCHED;
            PG8_LDB(B0, 1, 0); PG8_LDB(B1, 1, 1); PG8_SCHED; PG8_LDA(At, 1, 0); PG8_STAGE(PG8_SA(0, 1), a2 + hstepA, voffA);
            PG8_WAIT_V(8); PG8_WAIT_L(0); PG8_BAR; PG8_MMA(0, 0, At, B0); PG8_MMA(0, 1, At, B1); PG8_BAR; PG8_SCHED;
            PG8_LDA(At, 1, 1); PG8_STAGE(PG8_SB(1, 0), b3, voffB); PG8_STAGE(PG8_SB(1, 1), b3 + hstepB, voffB); PG8_STAGE(PG8_SA(1, 0), a3, voffA);
            PG8_WAIT_V(8); PG8_WAIT_L(0); PG8_BAR; PG8_MMA(1, 0, At, B0); PG8_MMA(1, 1, At, B1); PG8_BAR; PG8_SCHED;
        }
        if (wr == 0) PG8_BAR;
        E(acc, cur, wr, wc, fr, fq);
        if (!has_next) break;
        if (nxt.first) {
#pragma unroll
            for (int a = 0; a < 2; ++a)
#pragma unroll
                for (int b = 0; b < 2; ++b)
#pragma unroll
                    for (int m = 0; m < 4; ++m)
#pragma unroll
                        for (int n = 0; n < 2; ++n) acc[a][b][m][n] = (f32x4){0.f, 0.f, 0.f, 0.f};
        }
        cur = nxt; cA = nA; cB = nB; ++ui;
        if (wr == 1) PG8_BAR;
    }
    PG8_WAIT_V(0);
    PG8_BAR;
#undef PG8_SA
#undef PG8_SB
#undef PG8_STAGE
#undef PG8_LDA
#undef PG8_LDB
#undef PG8_MMA
#undef PG8_WAIT_V
#undef PG8_WAIT_L
#undef PG8_BAR
#undef PG8_SCHED
}
}

typedef f32x4 Acc[2][2][4][2];

struct EpiP1 {
    bf16_t *QA, *KA, *VA, *QB, *KB, *VB, *QM, *KM, *VM; unsigned char* GATES8;
    const float *g_qA, *g_kA, *g_qB, *g_kB, *b_gate, *cosT, *sinT;

    __device__ __forceinline__ void norm64(Acc& acc, int rowbase, int wc, int fq, const float* gain, float scale, bool rope, bf16_t* base, int hpb, int h, int dl) const {
        const bool dorope = rope && fq < 2;
        const int db0 = dorope ? 4 * fq : 8 * fq, dn = dorope ? 8 : 4;
#pragma unroll
        for (int ai = 0; ai < 2; ++ai)
#pragma unroll
            for (int m = 0; m < 4; ++m) {
                const int mrow = rowbase + ai * 128 + m * 16, b = mrow >> 12, t = mrow & 4095;
                float ss = 0.f;
#pragma unroll
                for (int bj = 0; bj < 2; ++bj)
#pragma unroll
                    for (int n = 0; n < 2; ++n) { const f32x4 x = acc[ai][bj][m][n]; ss += (x[0] * x[0] + x[1] * x[1]) + (x[2] * x[2] + x[3] * x[3]); }
                ss += __shfl_xor(ss, 16); ss += __shfl_xor(ss, 32);
                const float rstd = __builtin_amdgcn_rsqf(ss * (1.0f / 64.0f) + EPS_) * scale;
                f32x4 y[2][2];
#pragma unroll
                for (int n = 0; n < 2; ++n) { y[0][n] = acc[ai][0][m][n] * rstd * *(const f32x4*)(gain + db0 + dn * n); y[1][n] = acc[ai][1][m][n] * rstd * *(const f32x4*)(gain + 32 + 8 * fq + 4 * n); }
                if (dorope) {
                    const f32x4 c4 = *(const f32x4*)(cosT + t * 8 + 4 * fq), s4 = *(const f32x4*)(sinT + t * 8 + 4 * fq);
                    const f32x4 x1 = y[0][0], x2 = y[0][1];
                    y[0][0] = x1 * c4 - x2 * s4; y[0][1] = x2 * c4 + x1 * s4;
                }
                const int r = t & ((1 << dl) - 1), j = t >> dl;
                const int R = ((b * hpb + h) << 12) + (r << (12 - dl)) + j;
                bf16_t* p = base + (size_t)(R >> 6) * 4096 + (R & 63) * 8 + fq * 512;
#pragma unroll
                for (int bj = 0; bj < 2; ++bj) *(u32x4*)(p + bj * 2048) = pack8(y[bj][0], y[bj][1]);
            }
    }
    __device__ __forceinline__ void v64(Acc& acc, int rowbase, int fq, bf16_t* base, int hpb, int h, int dl) const {
#pragma unroll
        for (int ai = 0; ai < 2; ++ai)
#pragma unroll
            for (int m = 0; m < 4; ++m) {
                const int mrow = rowbase + ai * 128 + m * 16, b = mrow >> 12, t = mrow & 4095;
                const int r = t & ((1 << dl) - 1), j = t >> dl;
                const int R = ((b * hpb + h) << 12) + (r << (12 - dl)) + j;
                bf16_t* p = base + (size_t)(R >> 6) * 4096 + (R & 63) * 32 + fq * 8;
#pragma unroll
                for (int bj = 0; bj < 2; ++bj) *(u32x4*)(p + bj * 2048) = pack8(acc[ai][bj][m][0], acc[ai][bj][m][1]);
            }
    }
    __device__ __forceinline__ void raw128(Acc& acc, int rowbase, int wc, int fq, bf16_t* base, int tl, int lg, bool isv) const {
#pragma unroll
        for (int ai = 0; ai < 2; ++ai)
#pragma unroll
            for (int m = 0; m < 4; ++m) {
                const int mrow = rowbase + ai * 128 + m * 16, b = mrow >> lg, t = mrow & ((1 << lg) - 1);
#pragma unroll
                for (int bj = 0; bj < 2; ++bj) {
                    const int R = ((b * 4 + 2 * tl + bj) << lg) + t;
                    bf16_t* p = isv ? base + (size_t)(R >> 6) * 8192 + wc * 2048 + (R & 63) * 32 + fq * 8
                                    : base + (size_t)(R >> 6) * 8192 + (4 * wc + fq) * 512 + (R & 63) * 8;
                    *(u32x4*)p = pack8(acc[ai][bj][m][0], acc[ai][bj][m][1]);
                }
            }
    }
    __device__ __forceinline__ void operator()(Acc& acc, const pg8::Unit& u, int wr, int wc, int fr_in, int fq_in) const {
        int fr = fr_in, fq = fq_in; asm volatile("" : "+v"(fr), "+v"(fq));
        const int pn = u.pn;
        const int rowbase = u.pm * 256 + wr * 64 + fr;
        if (pn < 15) {
            if (pn < 3)       norm64(acc, rowbase, wc, fq, g_qA, QSCALE, true, QA + (size_t)pn * M_ * 256, 4, wc, 2 * pn);
            else if (pn < 6)  norm64(acc, rowbase, wc, fq, g_kA, 1.0f, true, KA + (size_t)(pn - 3) * M_ * 256, 4, wc, 2 * (pn - 3));
            else if (pn < 9)  v64(acc, rowbase, fq, VA + (size_t)(pn - 6) * M_ * 256, 4, wc, 2 * (pn - 6));
            else if (pn < 11) norm64(acc, rowbase, wc, fq, g_qB, QSCALE, false, QB, 8, 4 * (pn - 9) + wc, 0);
            else if (pn < 13) norm64(acc, rowbase, wc, fq, g_kB, 1.0f, false, KB, 8, 4 * (pn - 11) + wc, 0);
            else              v64(acc, rowbase, fq, VB, 8, 4 * (pn - 13) + wc, 0);
        } else if (pn < 17) {
            raw128(acc, rowbase, wc, fq, QM, pn - 15, 12, false);
        } else if (pn < 29) {
            const int colt = (pn - 17) * 256 + wc * 32 + 8 * fq;
            f32x4 bv[2][2];
#pragma unroll
            for (int bj = 0; bj < 2; ++bj)
#pragma unroll
                for (int n = 0; n < 2; ++n) bv[bj][n] = *(const f32x4*)(b_gate + colt + bj * 128 + 4 * n);
            const int lane_ = fr + 16 * fq, wid_ = wr * 4 + wc;
#pragma unroll
            for (int ai = 0; ai < 2; ++ai)
#pragma unroll
                for (int m = 0; m < 4; ++m) {
                    u32x4 w;
#pragma unroll
                    for (int bj = 0; bj < 2; ++bj)
#pragma unroll
                        for (int n = 0; n < 2; ++n) {
                            const f32x4 v = acc[ai][bj][m][n] + bv[bj][n]; unsigned pk = 0;
#pragma unroll
                            for (int e = 0; e < 4; ++e) { unsigned q = (unsigned)(sigmoidf_(v[e]) * 255.0f + 0.5f); q = q < 1u ? 1u : q; pk |= q << (8 * e); }
                            w[bj * 2 + n] = pk;
                        }
                    *(u32x4*)(GATES8 + ((((((size_t)u.pm * 12 + (pn - 17)) * 2 + ai) * 4 + m) * 8 + wid_) * 64 + lane_) * 16) = w;
                }
        } else {
            const int rb = rowbase - M_;
            if (pn < 31) raw128(acc, rb, wc, fq, KM, pn - 29, 8, false);
            else         raw128(acc, rb, wc, fq, VM, pn - 31, 8, true);
        }
    }
};

struct EpiMerge {
    const unsigned char* GATES8; bf16_t* MERGED;
    __device__ __forceinline__ void operator()(Acc& acc, const pg8::Unit& u, int wr, int wc, int fr_in, int fq_in) const {
        int fr = fr_in, fq = fq_in; asm volatile("" : "+v"(fr), "+v"(fq));
        const int rowbase = u.pm * 256 + wr * 64 + fr, col = u.pn * 256 + wc * 32 + 8 * fq, br = u.tag;
        const int lane_ = fr + 16 * fq, wid_ = wr * 4 + wc;
#pragma unroll
        for (int ai = 0; ai < 2; ++ai)
#pragma unroll
            for (int m = 0; m < 4; ++m) {
                const size_t frag = (((size_t)ai * 4 + m) * 8 + wid_) * 64 + lane_;
                const u32x4 gn = *(const u32x4*)(GATES8 + ((((size_t)u.pm * 12 + br * 4 + u.pn) * 8) * 512 + frag) * 16);
                if (br < 2) {
                    const u32x4 gd = *(const u32x4*)(GATES8 + ((((size_t)u.pm * 12 + (br + 1) * 4 + u.pn) * 8) * 512 + frag) * 16);
#pragma unroll
                    for (int bj = 0; bj < 2; ++bj)
#pragma unroll
                        for (int n = 0; n < 2; ++n)
#pragma unroll
                            for (int e = 0; e < 4; ++e)
                                acc[ai][bj][m][n][e] *= (float)((gn[bj * 2 + n] >> (8 * e)) & 0xffu) * __builtin_amdgcn_rcpf((float)((gd[bj * 2 + n] >> (8 * e)) & 0xffu));
                } else {
                    const int row = rowbase + ai * 128 + m * 16;
#pragma unroll
                    for (int bj = 0; bj < 2; ++bj) {
                        f32x4 o[2];
#pragma unroll
                        for (int n = 0; n < 2; ++n)
#pragma unroll
                            for (int e = 0; e < 4; ++e) o[n][e] = acc[ai][bj][m][n][e] * ((float)((gn[bj * 2 + n] >> (8 * e)) & 0xffu) * (1.0f / 255.0f));
                        *(u32x4*)(MERGED + (size_t)row * 1024 + col + bj * 128) = pack8(o[0], o[1]);
                    }
                }
            }
    }
};
struct EpiOut {
    const float* X; float* OUT; bf16_t* X1B; float* SSQ;
    __device__ __forceinline__ void operator()(Acc& acc, const pg8::Unit& u, int wr, int wc, int fr_in, int fq_in) const {
        int fr = fr_in, fq = fq_in; asm volatile("" : "+v"(fr), "+v"(fq));
        const int rowbase = u.pm * 256 + wr * 64 + fr, col = u.pn * 256 + wc * 32 + 8 * fq;
#pragma unroll
        for (int ai = 0; ai < 2; ++ai)
#pragma unroll
            for (int m = 0; m < 4; ++m) {
                const int row = rowbase + ai * 128 + m * 16; const size_t off = (size_t)row * 1024 + col;
                float ss = 0.f;
#pragma unroll
                for (int bj = 0; bj < 2; ++bj) {
                    const f32x4 x0 = *(const f32x4*)(X + off + bj * 128), x1 = *(const f32x4*)(X + off + bj * 128 + 4);
                    const f32x4 v0 = acc[ai][bj][m][0] + x0, v1 = acc[ai][bj][m][1] + x1;
                    *(u32x4*)(X1B + off + bj * 128) = pack8(v0, v1);
                    ss += (v0[0] * v0[0] + v0[1] * v0[1]) + (v0[2] * v0[2] + v0[3] * v0[3]) + (v1[0] * v1[0] + v1[1] * v1[1]) + (v1[2] * v1[2] + v1[3] * v1[3]);
                }
                ss += __shfl_xor(ss, 16); ss += __shfl_xor(ss, 32);
                if (fq == 0) atomicAdd(SSQ + row, ss);
            }
    }
};
struct EpiUp {
    const float* SSQ; bf16_t* HMID;
    __device__ __forceinline__ void operator()(Acc& acc, const pg8::Unit& u, int wr, int wc, int fr_in, int fq_in) const {
        int fr = fr_in, fq = fq_in; asm volatile("" : "+v"(fr), "+v"(fq));
        const int rowbase = u.pm * 256 + wr * 64 + fr, col = u.pn * 256 + wc * 32 + 8 * fq;
#pragma unroll
        for (int ai = 0; ai < 2; ++ai)
#pragma unroll
            for (int m = 0; m < 4; ++m) {
                const int row = rowbase + ai * 128 + m * 16;
                const float rstd = __builtin_amdgcn_rsqf(SSQ[row] * (1.0f / 1024.0f) + EPS_);
#pragma unroll
                for (int bj = 0; bj < 2; ++bj) {
                    f32x4 v0 = acc[ai][bj][m][0] * rstd, v1 = acc[ai][bj][m][1] * rstd;
#pragma unroll
                    for (int e = 0; e < 4; ++e) { const float a = fmaxf(v0[e], 0.f), b = fmaxf(v1[e], 0.f); v0[e] = a * a; v1[e] = b * b; }
                    *(u32x4*)(HMID + (size_t)row * 4096 + col + bj * 128) = pack8(v0, v1);
                }
            }
    }
};
struct EpiDown {
    float* OUT; const bf16_t* X1B;
    __device__ __forceinline__ void operator()(Acc& acc, const pg8::Unit& u, int wr, int wc, int fr_in, int fq_in) const {
        int fr = fr_in, fq = fq_in; asm volatile("" : "+v"(fr), "+v"(fq));
        const int rowbase = u.pm * 256 + wr * 64 + fr, col = u.pn * 256 + wc * 32 + 8 * fq;
#pragma unroll
        for (int ai = 0; ai < 2; ++ai)
#pragma unroll
            for (int m = 0; m < 4; ++m) {
                const size_t off = (size_t)(rowbase + ai * 128 + m * 16) * 1024 + col;
#pragma unroll
                for (int bj = 0; bj < 2; ++bj) {
                    f32x4 x0, x1; unpack8(*(const u32x4*)(X1B + off + bj * 128), x0, x1);
                    *(f32x4*)(OUT + off + bj * 128) = acc[ai][bj][m][0] + x0; *(f32x4*)(OUT + off + bj * 128 + 4) = acc[ai][bj][m][1] + x1;
                }
            }
    }
};

struct SchedP1 { int G, c;
    __device__ __forceinline__ bool next(int i, pg8::Unit& u) const {
        const int L = i * G + c;
        if (L < 3712) pg8::tile_order(L, 128, 29, u.pm, u.pn);
        else if (L < 3744) { const int idx = L - 3712; u.pm = 128 + (idx >> 2); u.pn = 29 + (idx & 3); }
        else return false;
        u.k0 = 0; u.nt = 16; u.tag = 0; u.first = 1; return true; } };
struct SchedSimple { int G, c, nN, nt;
    __device__ __forceinline__ bool next(int i, pg8::Unit& u) const {
        const int L = i * G + c; if (L >= 128 * nN) return false;
        pg8::tile_order(L, 128, nN, u.pm, u.pn); u.k0 = 0; u.nt = nt; u.tag = 0; u.first = 1; return true; } };
struct SchedP3 { int G, c;
    __device__ __forceinline__ bool next(int i, pg8::Unit& u) const {
        const int ti = i / 3, br = i - 3 * ti; const int L = ti * G + c; if (L >= 512) return false;
        pg8::tile_order(L, 128, 4, u.pm, u.pn); u.k0 = (br == 0) ? 0 : (br == 1 ? 256 : 768); u.nt = (br == 0) ? 4 : 8; u.tag = br; u.first = (br == 0); return true; } };

__device__ __forceinline__ float max3f(float a, float b, float c) { float r; asm("v_max3_f32 %0, %1, %2, %3" : "=v"(r) : "v"(a), "v"(b), "v"(c)); return r; }
__device__ __forceinline__ float max2f(float a, float b) { float r; asm("v_max_f32_e32 %0, %1, %2" : "=v"(r) : "v"(a), "v"(b)); return r; }
__device__ __forceinline__ float halfmax(float m) { auto rr = __builtin_amdgcn_permlane32_swap(__float_as_uint(m), __float_as_uint(m), false, false); return max2f(__uint_as_float(rr[0]), __uint_as_float(rr[1])); }
__device__ __forceinline__ float halfsum(float m) { auto rr = __builtin_amdgcn_permlane32_swap(__float_as_uint(m), __float_as_uint(m), false, false); return __uint_as_float(rr[0]) + __uint_as_float(rr[1]); }
__device__ __forceinline__ float rowmax32(f32x16& p0, f32x16& p1) {
    asm volatile("s_nop 15\n\ts_nop 7" : "+v"(p0), "+v"(p1));
    float a = max3f(p0[0], p0[1], p1[0]), b = max3f(p0[2], p0[3], p1[1]); a = max3f(a, p1[2], p1[3]);
#pragma unroll
    for (int r = 4; r < 16; r += 4) { a = max3f(a, p0[r], p0[r + 1]); b = max3f(b, p0[r + 2], p0[r + 3]); a = max3f(a, p1[r], p1[r + 1]); b = max3f(b, p1[r + 2], p1[r + 3]); }
    return halfmax(max2f(a, b));
}

template <int D, int MODE>
__device__ __forceinline__ void attn_unit(LAS unsigned char* lds, const bf16_t* __restrict__ Qs, const bf16_t* __restrict__ Ks, const bf16_t* __restrict__ Vs,
                                          const float* __restrict__ c2s, int qblk, bf16_t* out, int opitch, int orow0, int odl, float* lse, int fox_lo, float smax) {
    constexpr int TB = 128 * D, NP = TB / 16 / 512, KS = D / 16, DB = D / 32, TE = 64 * D;
    constexpr int TPS = (D == 64) ? 2 : 1;
    constexpr int OFF_V = 2 * TPS * TB, OFF_C = 4 * TPS * TB, OFF_O = OFF_C + 2 * TPS * 256, PITCH = 2 * D + 16;
    const int tid = threadIdx.x, lane = tid & 63, wid = __builtin_amdgcn_readfirstlane(tid >> 6), r32 = lane & 31, hi = lane >> 5;
    const int jw = qblk * 256 + 32 * wid;
    int kt_lo = 0, kt_hi = 4;
    if (MODE == 0) { kt_lo = 4 * qblk - 2; if (kt_lo < 0) kt_lo = 0; kt_hi = 4 * qblk + 4; }
    if (MODE == 1) { kt_hi = 4 * qblk + 4; kt_lo = fox_lo; }
    const int ntile = kt_hi - kt_lo, nstep = (ntile + TPS - 1) / TPS;
#define KT(i) ((MODE == 1) ? (kt_hi - 1 - (i)) : (kt_lo + (i)))
    bf16x8 qf[KS];
    { const bf16_t* qp = Qs + (size_t)(jw >> 6) * TE + ((jw & 63) + r32) * 8 + hi * 512;
#pragma unroll
      for (int ks = 0; ks < KS; ++ks) qf[ks] = *(const bf16x8*)(qp + ks * 1024); }
    float cq = 0.f; if (MODE == 1) cq = c2s[jw + r32];
    f32x16 o[DB];
#pragma unroll
    for (int d = 0; d < DB; ++d)
#pragma unroll
        for (int i = 0; i < 16; ++i) o[d][i] = 0.f;
    float mrun = (MODE == 1) ? 0.f : -1e30f, lrun = 0.f; bool started = false; (void)started;
    u32x4 kr[TPS][NP], vr[TPS][NP]; f32x4 cr[TPS];
#pragma unroll
    for (int sb = 0; sb < TPS; ++sb) cr[sb] = (f32x4){0.f, 0.f, 0.f, 0.f};
#define ATT_GLOAD(st_) do { _Pragma("unroll") for (int sb_ = 0; sb_ < TPS; ++sb_) { const int i_ = (st_) * TPS + sb_; if (i_ < ntile) { const int kt_ = KT(i_); \
        const u32x4* kp_ = (const u32x4*)(Ks + (size_t)kt_ * TE) + tid; const u32x4* vp_ = (const u32x4*)(Vs + (size_t)kt_ * TE) + tid; \
        _Pragma("unroll") for (int p_ = 0; p_ < NP; ++p_) { kr[sb_][p_] = kp_[p_ * 512]; vr[sb_][p_] = vp_[p_ * 512]; } \
        if (MODE == 1) { if (tid < 16) cr[sb_] = ((const f32x4*)(c2s + kt_ * 64))[tid]; } } } } while (0)
    constexpr int OFF_F = OFF_O + 8 * 32 * PITCH;
    if (MODE == 1) { if (lane == 0) ((LAS unsigned*)(lds + OFF_F))[wid] = 0u; }
    ATT_GLOAD(0);
    for (int st = 0; st < nstep; ++st) {
#pragma unroll
        for (int sb = 0; sb < TPS; ++sb) { const int slot = (st & 1) * TPS + sb;
          LAS u32x4* kd = (LAS u32x4*)(lds + slot * TB) + tid; LAS u32x4* vd = (LAS u32x4*)(lds + OFF_V + slot * TB) + tid;
#pragma unroll
          for (int p = 0; p < NP; ++p) { kd[p * 512] = kr[sb][p]; vd[p * 512] = vr[sb][p]; }
          if (MODE == 1) { if (tid < 16) ((LAS f32x4*)(lds + OFF_C + slot * 256))[tid] = cr[sb]; } }
        __syncthreads();
        if (MODE == 1) {
            const u32x4 f0 = ((const LAS u32x4*)(lds + OFF_F))[0], f1 = ((const LAS u32x4*)(lds + OFF_F))[1];
            if ((f0.x & f0.y & f0.z & f0.w & f1.x & f1.y & f1.z & f1.w) != 0u) break;
        }
        if (st + 1 < nstep) ATT_GLOAD(st + 1);
#pragma unroll
      for (int sb = 0; sb < TPS; ++sb) {
        const int it = st * TPS + sb; if (it >= ntile) break;
        const int kt = KT(it);
        const int buf = (st & 1) * TPS + sb;
        bool active = true;
        if (MODE == 0) active = (kt * 64 + 63 >= jw - 128) && (kt * 64 <= jw + 31);
        if (MODE == 1) {
            active = (kt * 64 <= jw + 31);
            if (active) { const float cend = ((const LAS float*)(lds + OFF_C + buf * 256))[63];
                active = !started || __builtin_amdgcn_ballot_w64(smax + cq - cend - mrun >= -135.0f) != 0;
                if (!active) { if (lane == 0) ((LAS unsigned*)(lds + OFF_F))[wid] = 1u; } }
        }
        if (active) {
            f32x16 s0, s1;
            if (MODE == 1) {
                const LAS f32x4* cb = (const LAS f32x4*)(lds + OFF_C + buf * 256);
                const float cqm = cq - mrun;
#pragma unroll
                for (int i4 = 0; i4 < 4; ++i4) { const f32x4 c0 = cb[2 * i4 + hi], c1 = cb[8 + 2 * i4 + hi];
#pragma unroll
                    for (int e = 0; e < 4; ++e) { s0[4 * i4 + e] = cqm - c0[e]; s1[4 * i4 + e] = cqm - c1[e]; } }
            } else {
#pragma unroll
                for (int i = 0; i < 16; ++i) { s0[i] = 0.f; s1[i] = 0.f; }
            }
            const LAS unsigned char* kb = lds + buf * TB + hi * 1024 + r32 * 16;
#pragma unroll
            for (int ks = 0; ks < KS; ++ks) {
                const bf16x8 a0 = *(const LAS bf16x8*)(kb + ks * 2048), a1 = *(const LAS bf16x8*)(kb + ks * 2048 + 512);
                s0 = __builtin_amdgcn_mfma_f32_32x32x16_bf16(a0, qf[ks], s0, 0, 0, 0);
                s1 = __builtin_amdgcn_mfma_f32_32x32x16_bf16(a1, qf[ks], s1, 0, 0, 0);
            }
            const int q = jw + r32, key0 = kt * 64 + 4 * hi;
            if (MODE == 0) {
#pragma unroll
                for (int i = 0; i < 16; ++i) { const int key = key0 + 8 * (i >> 2) + (i & 3);
                    if (key > q || key < q - 128) s0[i] = -INFINITY;
                    if (key + 32 > q || key + 32 < q - 128) s1[i] = -INFINITY; }
            }
            if (MODE == 1) {
                if (kt * 64 + 63 > jw) {
#pragma unroll
                    for (int i = 0; i < 16; ++i) { const int key = key0 + 8 * (i >> 2) + (i & 3);
                        if (key > q) s0[i] = -INFINITY;
                        if (key + 32 > q) s1[i] = -INFINITY; }
                }
            }
            const float mx = rowmax32(s0, s1);
            float rs = 0.f;
            if (MODE == 1) {
                if (!started) {
                    started = true; mrun = mx;
#pragma unroll
                    for (int i = 0; i < 16; ++i) { s0[i] -= mx; s1[i] -= mx; }
                } else if (__builtin_amdgcn_ballot_w64(mx > 0.f) != 0) {
                    const float dl = max2f(mx, 0.f), alpha = __builtin_amdgcn_exp2f(-dl);
                    mrun += dl; lrun *= alpha;
#pragma unroll
                    for (int i = 0; i < 16; ++i) { s0[i] -= dl; s1[i] -= dl; }
#pragma unroll
                    for (int d = 0; d < DB; ++d)
#pragma unroll
                        for (int i = 0; i < 16; ++i) o[d][i] *= alpha;
                }
#pragma unroll
                for (int i = 0; i < 16; ++i) { s0[i] = __builtin_amdgcn_exp2f(s0[i]); s1[i] = __builtin_amdgcn_exp2f(s1[i]); rs += s0[i] + s1[i]; }
            } else {
                const float mnew = max2f(mrun, mx);
                if (__builtin_amdgcn_ballot_w64(mnew > mrun) != 0) {
                    const float alpha = __builtin_amdgcn_exp2f(mrun - mnew);
                    lrun *= alpha;
#pragma unroll
                    for (int d = 0; d < DB; ++d)
#pragma unroll
                        for (int i = 0; i < 16; ++i) o[d][i] *= alpha;
                }
                mrun = mnew;
#pragma unroll
                for (int i = 0; i < 16; ++i) { s0[i] = __builtin_amdgcn_exp2f(s0[i] - mnew); s1[i] = __builtin_amdgcn_exp2f(s1[i] - mnew); rs += s0[i] + s1[i]; }
            }
            lrun += rs;
            u32x4 pw[4];
            pw[0] = (u32x4){pk2(s0[0], s0[1]), pk2(s0[2], s0[3]), pk2(s0[4], s0[5]), pk2(s0[6], s0[7])};
            pw[1] = (u32x4){pk2(s0[8], s0[9]), pk2(s0[10], s0[11]), pk2(s0[12], s0[13]), pk2(s0[14], s0[15])};
            pw[2] = (u32x4){pk2(s1[0], s1[1]), pk2(s1[2], s1[3]), pk2(s1[4], s1[5]), pk2(s1[6], s1[7])};
            pw[3] = (u32x4){pk2(s1[8], s1[9]), pk2(s1[10], s1[11]), pk2(s1[12], s1[13]), pk2(s1[14], s1[15])};
            const LAS unsigned char* vb = lds + OFF_V + buf * TB + ((lane >> 4) & 1) * 32 + (lane & 3) * 8 + (4 * hi + ((lane & 15) >> 2)) * 64;
#pragma unroll
            for (int d = 0; d < DB; ++d)
#pragma unroll
                for (int kk = 0; kk < 4; ++kk) {
                    typedef short v4i16_t __attribute__((ext_vector_type(4)));
                    const s16x4 lo = __builtin_bit_cast(s16x4, __builtin_amdgcn_ds_read_tr16_b64_v4i16((LAS v4i16_t*)(vb + d * 4096 + kk * 1024)));
                    const s16x4 hh = __builtin_bit_cast(s16x4, __builtin_amdgcn_ds_read_tr16_b64_v4i16((LAS v4i16_t*)(vb + d * 4096 + kk * 1024 + 512)));
                    const bf16x8 vf = (bf16x8){lo[0], lo[1], lo[2], lo[3], hh[0], hh[1], hh[2], hh[3]};
                    o[d] = __builtin_amdgcn_mfma_f32_32x32x16_bf16(vf, __builtin_bit_cast(bf16x8, pw[kk]), o[d], 0, 0, 0);
                }
        }
      }
    }
#undef ATT_GLOAD
#undef KT
    lrun = halfsum(lrun);
    const float inv = 1.0f / lrun;
    if (MODE == 0) { if (hi == 0) lse[(size_t)(orow0 + ((jw + r32) << odl)) * 4] = (mrun + __builtin_amdgcn_logf(lrun)) * LN2; }
    LAS unsigned char* stw = lds + OFF_O + wid * (32 * PITCH);
#pragma unroll
    for (int d = 0; d < DB; ++d)
#pragma unroll
        for (int i4 = 0; i4 < 4; ++i4) {
            u32x2 w; w.x = pk2(o[d][4 * i4] * inv, o[d][4 * i4 + 1] * inv); w.y = pk2(o[d][4 * i4 + 2] * inv, o[d][4 * i4 + 3] * inv);
            *(LAS u32x2*)(stw + r32 * PITCH + (32 * d + 8 * i4 + 4 * hi) * 2) = w;
        }
    constexpr int LPR = D / 8, RPI = 64 / LPR;
#pragma unroll
    for (int it = 0; it < 32 / RPI; ++it) {
        const int row = it * RPI + lane / LPR, ch = lane % LPR;
        const u32x4 v = *(const LAS u32x4*)(stw + row * PITCH + ch * 16);
        const int mrow = orow0 + ((jw + row) << odl);
        *(u32x4*)(out + (size_t)mrow * opitch + ch * 8) = v;
    }
    __syncthreads();
}

struct DilUnit { const bf16_t *Qs, *Ks, *Vs; bf16_t* out; float* lse; int qblk, orow0, odl; };
__device__ __forceinline__ void dil_decode(unsigned char* ws, bf16_t* DIL, float* LSE, int L, DilUnit& u) {
    const int gi = L / 512, rem = L % 512, bh = rem >> 4, rj = rem & 15, b = bh >> 2, h = bh & 3;
    const int dl = 2 * gi, qpb = 16 >> dl;
    const int r = rj / qpb; u.qblk = rj % qpb;
    const size_t Rs = ((size_t)(b * 4 + h) << 12) + ((size_t)r << (12 - dl));
    u.Qs = (const bf16_t*)(ws + WS_QA) + (size_t)gi * M_ * 256 + Rs * 64;
    u.Ks = (const bf16_t*)(ws + WS_KA) + (size_t)gi * M_ * 256 + Rs * 64;
    u.Vs = (const bf16_t*)(ws + WS_VA) + (size_t)gi * M_ * 256 + Rs * 64;
    u.out = DIL + (size_t)gi * M_ * 256 + h * 64; u.lse = LSE + (size_t)gi * M_ * 4 + h; u.orow0 = b * 4096 + r; u.odl = dl;
}
__device__ __forceinline__ void dil_phase(LAS unsigned char* lds, unsigned char* ws, bf16_t* DIL, float* LSE, int bx, int G) {
    constexpr int TB = 8192, TE = 4096, OFF_V = 6 * TB, OFF_O = 12 * TB, PITCH = 144;
    typedef short v4i16_t __attribute__((ext_vector_type(4)));
    int tid = threadIdx.x; asm volatile("" : "+v"(tid));
    const int lane = tid & 63, wid = __builtin_amdgcn_readfirstlane(tid >> 6), r32 = lane & 31, hi = lane >> 5;
    if (bx >= 1536) return;
    DilUnit cur, nxt; dil_decode(ws, DIL, LSE, bx, cur);
    u32x4 kr[6], vr[6]; bf16x8 qn[4];
#define DIL_LOAD(U) do { const int t0_ = 4 * (U).qblk - 2; \
        _Pragma("unroll") for (int s_ = 0; s_ < 6; ++s_) { if (t0_ + s_ >= 0) { kr[s_] = ((const u32x4*)((U).Ks + (size_t)(t0_ + s_) * TE))[tid]; vr[s_] = ((const u32x4*)((U).Vs + (size_t)(t0_ + s_) * TE))[tid]; } } \
        const int jw_ = (U).qblk * 256 + 32 * wid; const bf16_t* qp_ = (U).Qs + (size_t)(jw_ >> 6) * TE + ((jw_ & 63) + r32) * 8 + hi * 512; \
        _Pragma("unroll") for (int ks = 0; ks < 4; ++ks) qn[ks] = *(const bf16x8*)(qp_ + ks * 1024); } while (0)
#pragma unroll
    for (int s = 0; s < 6; ++s) { kr[s] = (u32x4){0u, 0u, 0u, 0u}; vr[s] = (u32x4){0u, 0u, 0u, 0u}; }
    DIL_LOAD(cur);
    for (int L = bx; L < 1536; L += G) {
        const bool has_next = (L + G < 1536);
        if (has_next) dil_decode(ws, DIL, LSE, L + G, nxt);
#pragma unroll
        for (int s = 0; s < 6; ++s) { ((LAS u32x4*)(lds + s * TB))[tid] = kr[s]; ((LAS u32x4*)(lds + OFF_V + s * TB))[tid] = vr[s]; }
        bf16x8 qf[4];
#pragma unroll
        for (int ks = 0; ks < 4; ++ks) qf[ks] = qn[ks];
        __syncthreads();
        if (has_next) DIL_LOAD(nxt);
        const int jw = cur.qblk * 256 + 32 * wid, q = jw + r32, t0 = 4 * cur.qblk - 2;
        int kfirst = (jw - 128) >> 6; if (kfirst < 0) kfirst = 0;
        const int klast = (jw + 31) >> 6;
        f32x16 o[2];
#pragma unroll
        for (int d = 0; d < 2; ++d)
#pragma unroll
            for (int i = 0; i < 16; ++i) o[d][i] = 0.f;
        float mrun = -1e30f, lrun = 0.f;
        for (int kt = kfirst; kt <= klast; ++kt) {
            const int slot = kt - t0;
            f32x16 s0, s1;
#pragma unroll
            for (int i = 0; i < 16; ++i) { s0[i] = 0.f; s1[i] = 0.f; }
            const LAS unsigned char* kb = lds + slot * TB + hi * 1024 + r32 * 16;
#pragma unroll
            for (int ks = 0; ks < 4; ++ks) {
                const bf16x8 a0 = *(const LAS bf16x8*)(kb + ks * 2048), a1 = *(const LAS bf16x8*)(kb + ks * 2048 + 512);
                s0 = __builtin_amdgcn_mfma_f32_32x32x16_bf16(a0, qf[ks], s0, 0, 0, 0);
                s1 = __builtin_amdgcn_mfma_f32_32x32x16_bf16(a1, qf[ks], s1, 0, 0, 0);
            }
            const int key0 = kt * 64 + 4 * hi;
#pragma unroll
            for (int i = 0; i < 16; ++i) { const int key = key0 + 8 * (i >> 2) + (i & 3);
                if (key > q || key < q - 128) s0[i] = -INFINITY;
                if (key + 32 > q || key + 32 < q - 128) s1[i] = -INFINITY; }
            const float mx = rowmax32(s0, s1);
            const float mnew = max2f(mrun, mx);
            if (__builtin_amdgcn_ballot_w64(mnew > mrun) != 0) {
                const float alpha = __builtin_amdgcn_exp2f(mrun - mnew);
                lrun *= alpha;
#pragma unroll
                for (int d = 0; d < 2; ++d)
#pragma unroll
                    for (int i = 0; i < 16; ++i) o[d][i] *= alpha;
            }
            mrun = mnew;
            float rs = 0.f;
#pragma unroll
            for (int i = 0; i < 16; ++i) { s0[i] = __builtin_amdgcn_exp2f(s0[i] - mnew); s1[i] = __builtin_amdgcn_exp2f(s1[i] - mnew); rs += s0[i] + s1[i]; }
            lrun += rs;
            u32x4 pw[4];
            pw[0] = (u32x4){pk2(s0[0], s0[1]), pk2(s0[2], s0[3]), pk2(s0[4], s0[5]), pk2(s0[6], s0[7])};
            pw[1] = (u32x4){pk2(s0[8], s0[9]), pk2(s0[10], s0[11]), pk2(s0[12], s0[13]), pk2(s0[14], s0[15])};
            pw[2] = (u32x4){pk2(s1[0], s1[1]), pk2(s1[2], s1[3]), pk2(s1[4], s1[5]), pk2(s1[6], s1[7])};
            pw[3] = (u32x4){pk2(s1[8], s1[9]), pk2(s1[10], s1[11]), pk2(s1[12], s1[13]), pk2(s1[14], s1[15])};
            const LAS unsigned char* vb = lds + OFF_V + slot * TB + ((lane >> 4) & 1) * 32 + (lane & 3) * 8 + (4 * hi + ((lane & 15) >> 2)) * 64;
#pragma unroll
            for (int d = 0; d < 2; ++d)
#pragma unroll
                for (int kk = 0; kk < 4; ++kk) {
                    const s16x4 lo = __builtin_bit_cast(s16x4, __builtin_amdgcn_ds_read_tr16_b64_v4i16((LAS v4i16_t*)(vb + d * 4096 + kk * 1024)));
                    const s16x4 hh = __builtin_bit_cast(s16x4, __builtin_amdgcn_ds_read_tr16_b64_v4i16((LAS v4i16_t*)(vb + d * 4096 + kk * 1024 + 512)));
                    const bf16x8 vf = (bf16x8){lo[0], lo[1], lo[2], lo[3], hh[0], hh[1], hh[2], hh[3]};
                    o[d] = __builtin_amdgcn_mfma_f32_32x32x16_bf16(vf, __builtin_bit_cast(bf16x8, pw[kk]), o[d], 0, 0, 0);
                }
        }
        lrun = halfsum(lrun);
        const float inv = 1.0f / lrun;
        if (hi == 0) cur.lse[(size_t)(cur.orow0 + ((jw + r32) << cur.odl)) * 4] = (mrun + __builtin_amdgcn_logf(lrun)) * LN2;
        LAS unsigned char* stw = lds + OFF_O + wid * (32 * PITCH);
#pragma unroll
        for (int d = 0; d < 2; ++d)
#pragma unroll
            for (int i4 = 0; i4 < 4; ++i4) {
                u32x2 w; w.x = pk2(o[d][4 * i4] * inv, o[d][4 * i4 + 1] * inv); w.y = pk2(o[d][4 * i4 + 2] * inv, o[d][4 * i4 + 3] * inv);
                *(LAS u32x2*)(stw + r32 * PITCH + (32 * d + 8 * i4 + 4 * hi) * 2) = w;
            }
#pragma unroll
        for (int it = 0; it < 4; ++it) {
            const int row = it * 8 + (lane >> 3), ch = lane & 7;
            const u32x4 v = *(const LAS u32x4*)(stw + row * PITCH + ch * 16);
            const int mrow = cur.orow0 + ((jw + row) << cur.odl);
            *(u32x4*)(cur.out + (size_t)mrow * 256 + ch * 8) = v;
        }
        __syncthreads();
        cur = nxt;
    }
#undef DIL_LOAD
}

__device__ __forceinline__ void memnorm_unit(LAS unsigned char* lds, bf16_t* tiles, const float* gain, float scale) {
    int tid = threadIdx.x; asm volatile("" : "+v"(tid));
    const int lane = tid & 63, wid = tid >> 6;
    LAS float* part = (LAS float*)lds;
    u32x4 raw[4][2];
#pragma unroll
    for (int t = 0; t < 4; ++t) { raw[t][0] = *(const u32x4*)(tiles + (size_t)t * 8192 + (2 * wid) * 512 + lane * 8); raw[t][1] = *(const u32x4*)(tiles + (size_t)t * 8192 + (2 * wid + 1) * 512 + lane * 8); }
#pragma unroll
    for (int t = 0; t < 4; ++t) {
        f32x4 a0, a1, b0, b1; unpack8(raw[t][0], a0, a1); unpack8(raw[t][1], b0, b1);
        float ss = 0.f;
#pragma unroll
        for (int e = 0; e < 4; ++e) ss += a0[e] * a0[e] + a1[e] * a1[e] + b0[e] * b0[e] + b1[e] * b1[e];
        part[(t * 8 + wid) * 64 + lane] = ss;
    }
    __syncthreads();
    const f32x4 g0 = *(const f32x4*)(gain + 16 * wid), g1 = *(const f32x4*)(gain + 16 * wid + 4), g2 = *(const f32x4*)(gain + 16 * wid + 8), g3 = *(const f32x4*)(gain + 16 * wid + 12);
#pragma unroll
    for (int t = 0; t < 4; ++t) {
        float tot = 0.f;
#pragma unroll
        for (int w = 0; w < 8; ++w) tot += part[(t * 8 + w) * 64 + lane];
        const float rstd = __builtin_amdgcn_rsqf(tot * (1.0f / 128.0f) + EPS_) * scale;
        f32x4 a0, a1, b0, b1; unpack8(raw[t][0], a0, a1); unpack8(raw[t][1], b0, b1);
        *(u32x4*)(tiles + (size_t)t * 8192 + (2 * wid) * 512 + lane * 8) = pack8(a0 * g0 * rstd, a1 * g1 * rstd);
        *(u32x4*)(tiles + (size_t)t * 8192 + (2 * wid + 1) * 512 + lane * 8) = pack8(b0 * g2 * rstd, b1 * g3 * rstd);
    }
    __syncthreads();
}

__device__ __forceinline__ void cumsum_unit(LAS unsigned char* lds, const float* logf, float* c2, int bh, const float* gq, const float* gk, int* lo_tab) {
    const int tid = threadIdx.x, lane = tid & 63, wid = tid >> 6, b = bh >> 3, h = bh & 7;
    LAS float* wt = (LAS float*)lds;
    LAS float* wstart = (LAS float*)(lds + 64); LAS float* wend = (LAS float*)(lds + 64 + 256);
    float v[8]; float run = 0.f;
#pragma unroll
    for (int k = 0; k < 8; ++k) { run += logf[(size_t)(b * 4096 + tid * 8 + k) * 8 + h]; v[k] = run; }
    float inc = run;
#pragma unroll
    for (int o = 1; o < 64; o <<= 1) { const float t = __shfl_up(inc, o); if (lane >= o) inc += t; }
    if (lane == 63) wt[wid] = inc;
    __syncthreads();
    float pre = inc - run;
    for (int w = 0; w < wid; ++w) pre += wt[w];
#pragma unroll
    for (int k = 0; k < 8; ++k) c2[(size_t)bh * 4096 + tid * 8 + k] = (pre + v[k]) * LOG2E;
    if ((tid & 7) == 0) wstart[tid >> 3] = (pre + v[0]) * LOG2E;
    if ((tid & 7) == 7) wend[tid >> 3] = (pre + v[7]) * LOG2E;
    __syncthreads();
    float gqm = 0.f, gkm = 0.f;
    for (int i = 0; i < 64; ++i) { gqm = fmaxf(gqm, fabsf(gq[i])); gkm = fmaxf(gkm, fabsf(gk[i])); }
    const float smax = 64.0f * QSCALE * gqm * gkm * 1.02f;
    if (tid < 16) {
        const float cq0 = wstart[4 * tid]; int lo = 0;
        while (lo < 4 * tid && smax + cq0 - wend[lo] + smax < -135.0f) ++lo;
        lo_tab[bh * 16 + tid] = lo;
    }
    if (bh == 0 && tid == 0) ((float*)lo_tab)[1024] = smax;
    __syncthreads();
}

__device__ __forceinline__ void merge_unit(const bf16_t* DIL, const float* LSE, bf16_t* Y, int u) {
    const int tid = threadIdx.x;
#pragma unroll
    for (int k = 0; k < 4; ++k) {
        const int it = tid + 512 * k, row = 64 * u + (it >> 5), c8 = it & 31, h = c8 >> 3;
        const float l0 = LSE[(size_t)row * 4 + h], l1 = LSE[(size_t)(M_ + row) * 4 + h], l2 = LSE[(size_t)(2 * M_ + row) * 4 + h];
        const float mx = fmaxf(l0, fmaxf(l1, l2));
        float w0 = __expf(l0 - mx), w1 = __expf(l1 - mx), w2 = __expf(l2 - mx);
        const float inv = 1.0f / (w0 + w1 + w2); w0 *= inv; w1 *= inv; w2 *= inv;
        f32x4 a0, a1, b0, b1, c0, c1;
        unpack8(*(const u32x4*)(DIL + (size_t)row * 256 + c8 * 8), a0, a1);
        unpack8(*(const u32x4*)(DIL + (size_t)(M_ + row) * 256 + c8 * 8), b0, b1);
        unpack8(*(const u32x4*)(DIL + (size_t)(2 * M_ + row) * 256 + c8 * 8), c0, c1);
        *(u32x4*)(Y + (size_t)row * 1280 + c8 * 8) = pack8(a0 * w0 + b0 * w1 + c0 * w2, a1 * w0 + b1 * w1 + c1 * w2);
    }
}

__device__ __forceinline__ float wave_sum(float v) {
#pragma unroll
    for (int o = 1; o < 64; o <<= 1) v += __shfl_xor(v, o);
    return v;
}
__device__ __forceinline__ void cat_src(const Params& P, int n, const float*& base, int& ld, int& col) {
    const int tile = n >> 8, c = n & 255, bj = c >> 7, wc = (c >> 5) & 3, j = c & 31;
    if (tile < 15) {
        int colbase, head; bool rope = false;
        if (tile < 3) { colbase = 0; head = tile * 4 + wc; rope = true; }
        else if (tile < 6) { colbase = 768; head = (tile - 3) * 4 + wc; rope = true; }
        else if (tile < 9) { colbase = 1536; head = (tile - 6) * 4 + wc; }
        else if (tile < 11) { colbase = 2304; head = (tile - 9) * 4 + wc; }
        else if (tile < 13) { colbase = 2816; head = (tile - 11) * 4 + wc; }
        else { colbase = 3328; head = (tile - 13) * 4 + wc; }
        const int p = 32 * bj + j; const int d = (rope && p < 16) ? ((p & 3) + 4 * ((p >> 3) & 1) + 8 * ((p >> 2) & 1)) : p;
        base = P.in[3]; ld = 4360; col = colbase + head * 64 + d;
    } else if (tile < 17) { base = P.in[3]; ld = 4360; col = 3848 + (2 * (tile - 15) + bj) * 128 + 32 * wc + j; }
    else if (tile < 29) { base = P.in[13]; ld = 3072; col = n - 4352; }
    else if (tile < 31) { base = P.in[10]; ld = 1024; col = (2 * (tile - 29) + bj) * 128 + 32 * wc + j; }
    else { base = P.in[10]; ld = 1024; col = 512 + (2 * (tile - 31) + bj) * 128 + 32 * wc + j; }
}
__device__ __forceinline__ void transpose_item(const float* srcp  , int ldsrc, int k0, const float* kscale, bf16_t* dst, int ldd, int drow0, int dcol0,
                                               LAS float* scr, int lane) {
    float tv[32];
#pragma unroll
    for (int i = 0; i < 32; ++i) { const int kk = 2 * i + (lane >> 5); tv[i] = srcp[(size_t)(k0 + kk) * ldsrc]; }
    if (kscale) {
#pragma unroll
        for (int i = 0; i < 32; ++i) tv[i] *= kscale[k0 + 2 * i + (lane >> 5)];
    }
#pragma unroll
    for (int i = 0; i < 32; ++i) scr[(2 * i + (lane >> 5)) * 33 + (lane & 31)] = tv[i];
    asm volatile("s_waitcnt lgkmcnt(0)" ::: "memory");
    const int c = lane & 7;
#pragma unroll
    for (int jx = 0; jx < 4; ++jx) { const int n = (lane >> 3) + 8 * jx; const LAS float* s = scr + (8 * c) * 33 + n;
        u32x4 o; o.x = pk2(s[0 * 33], s[1 * 33]); o.y = pk2(s[2 * 33], s[3 * 33]); o.z = pk2(s[4 * 33], s[5 * 33]); o.w = pk2(s[6 * 33], s[7 * 33]);
        *(u32x4*)(dst + (size_t)(drow0 + n) * ldd + dcol0 + k0 + 8 * c) = o; }
    asm volatile("s_waitcnt lgkmcnt(0)" ::: "memory");
}

__device__ __forceinline__ void p0_prologue(const Params& P, LAS unsigned char* lds, int vcu, int G) {
    const int tid = threadIdx.x, lane = tid & 63, wave = tid >> 6;
    unsigned char* ws = P.ws;
    const float* w_in = P.in[3];
    LAS float* wfl = (LAS float*)(lds + 73728);
    { float wv[16], gv[16];
#pragma unroll
      for (int j = 0; j < 16; ++j) { const int i = tid + 512 * j, k = i >> 3, c = i & 7; wv[j] = w_in[(size_t)k * 4360 + 3840 + c]; gv[j] = P.in[2][k]; }
#pragma unroll
      for (int j = 0; j < 16; ++j) { const int i = tid + 512 * j, k = i >> 3, c = i & 7; wfl[c * 1024 + k] = wv[j] * gv[j]; } }
    const int gtid = vcu * 512 + tid, GT = G * 512;
    { float* ssq = (float*)(ws + WS_SSQ); for (int i = gtid; i < M_; i += GT) ssq[i] = 0.f; }
    { float* cosT = (float*)(ws + WS_COS); float* sinT = (float*)(ws + WS_SIN);
      for (int i = gtid; i < 4096 * 8; i += GT) { const int t = i >> 3, f = i & 7; const float inv = powf(500000.0f, -(float)(2 * f) / 16.0f); const float ang = (float)t * inv; cosT[i] = cosf(ang); sinT[i] = sinf(ang); } }
    LAS float* scr = (LAS float*)(lds + wave * 8448);
    const int gw = vcu * 8 + wave, NGW = G * 8;
    constexpr int I_CAT = 16 * 264, I_BA = 4 * 32, I_BB = 8 * 32, I_BM = 8 * 32, I_OUT = 16 * 32, I_UP = 16 * 128, I_DN = 64 * 32;
    constexpr int NITEMS = I_CAT + I_BA + I_BB + I_BM + I_OUT + I_UP + I_DN;
    bf16_t* WCAT = (bf16_t*)(ws + WS_WCAT); bf16_t* WBR = (bf16_t*)(ws + WS_WBR); bf16_t* WOUT = (bf16_t*)(ws + WS_WOUT); bf16_t* WUP = (bf16_t*)(ws + WS_WUP); bf16_t* WDN = (bf16_t*)(ws + WS_WDN);
    for (int it = gw; it < NITEMS; it += NGW) {
        int r = it;
        if (r < I_CAT) { const int kb = r / 264, nb = r % 264; const float* base; int ld, col; cat_src(P, nb * 32 + (lane & 31), base, ld, col);
            transpose_item(base + col, ld, kb * 64, nullptr, WCAT, 1024, nb * 32, 0, scr, lane); continue; }
        r -= I_CAT;
        if (r < I_BA) { const int kb = r / 32, nb = r % 32; transpose_item(P.in[15] + nb * 32 + (lane & 31), 1024, kb * 64, nullptr, WBR, 1280, nb * 32, 0, scr, lane); continue; }
        r -= I_BA;
        if (r < I_BB) { const int kb = r / 32, nb = r % 32; transpose_item(P.in[16] + nb * 32 + (lane & 31), 1024, kb * 64, nullptr, WBR, 1280, nb * 32, 256, scr, lane); continue; }
        r -= I_BB;
        if (r < I_BM) { const int kb = r / 32, nb = r % 32; transpose_item(P.in[17] + nb * 32 + (lane & 31), 1024, kb * 64, nullptr, WBR, 1280, nb * 32, 768, scr, lane); continue; }
        r -= I_BM;
        if (r < I_OUT) { const int kb = r / 32, nb = r % 32; transpose_item(P.in[18] + nb * 32 + (lane & 31), 1024, kb * 64, nullptr, WOUT, 1024, nb * 32, 0, scr, lane); continue; }
        r -= I_OUT;
        if (r < I_UP) { const int kb = r / 128, nb = r % 128; transpose_item(P.in[20] + nb * 32 + (lane & 31), 4096, kb * 64, P.in[19], WUP, 1024, nb * 32, 0, scr, lane); continue; }
        r -= I_UP;
        { const int kb = r / 32, nb = r % 32; transpose_item(P.in[21] + nb * 32 + (lane & 31), 1024, kb * 64, nullptr, WDN, 4096, nb * 32, 0, scr, lane); }
    }
    __syncthreads();
    bf16_t* AALL = (bf16_t*)P.out;
    float* logf = (float*)(ws + WS_LOGF);
    const float* bfv = P.in[4];
    constexpr int RB = 2;
    for (int base = gw * RB; base < M_ + 2048; base += NGW * RB) {
        const bool ismem = base >= M_;
        const float* xb = ismem ? P.in[1] + (size_t)(base - M_) * 1024 : P.in[0] + (size_t)base * 1024;
        const float* gp = ismem ? P.in[9] : P.in[2];
        f32x4 v[RB][4];
#pragma unroll
        for (int r = 0; r < RB; ++r)
#pragma unroll
            for (int j = 0; j < 4; ++j) v[r][j] = ((const f32x4*)(xb + (size_t)r * 1024))[lane + 64 * j];
        float ssq[RB], red[RB];
#pragma unroll
        for (int r = 0; r < RB; ++r) { float s = 0.f;
#pragma unroll
            for (int j = 0; j < 4; ++j) s += (v[r][j][0] * v[r][j][0] + v[r][j][1] * v[r][j][1]) + (v[r][j][2] * v[r][j][2] + v[r][j][3] * v[r][j][3]);
            ssq[r] = s; red[r] = 0.f; }
        if (!ismem) {
            float a[RB][8];
#pragma unroll
            for (int c = 0; c < 8; ++c) {
                f32x4 w[4];
#pragma unroll
                for (int j = 0; j < 4; ++j) w[j] = ((const LAS f32x4*)(wfl + c * 1024))[lane + 64 * j];
#pragma unroll
                for (int r = 0; r < RB; ++r) { float t = 0.f;
#pragma unroll
                    for (int j = 0; j < 4; ++j) t += (v[r][j][0] * w[j][0] + v[r][j][1] * w[j][1]) + (v[r][j][2] * w[j][2] + v[r][j][3] * w[j][3]);
                    a[r][c] = t; }
            }
#pragma unroll
            for (int r = 0; r < RB; ++r) {
                float b4[4], b2[2];
#pragma unroll
                for (int i = 0; i < 4; ++i) { const float keep = (lane & 32) ? a[r][i + 4] : a[r][i], send = (lane & 32) ? a[r][i] : a[r][i + 4]; b4[i] = keep + __shfl_xor(send, 32); }
#pragma unroll
                for (int i = 0; i < 2; ++i) { const float keep = (lane & 16) ? b4[i + 2] : b4[i], send = (lane & 16) ? b4[i] : b4[i + 2]; b2[i] = keep + __shfl_xor(send, 16); }
                { const float keep = (lane & 8) ? b2[1] : b2[0], send = (lane & 8) ? b2[0] : b2[1]; red[r] = keep + __shfl_xor(send, 8); }
            }
#pragma unroll
            for (int o = 4; o >= 1; o >>= 1)
#pragma unroll
                for (int r = 0; r < RB; ++r) red[r] += __shfl_xor(red[r], o);
        }
#pragma unroll
        for (int o = 1; o < 64; o <<= 1)
#pragma unroll
            for (int r = 0; r < RB; ++r) ssq[r] += __shfl_xor(ssq[r], o);
#pragma unroll
        for (int r = 0; r < RB; ++r) {
            const float rstd = 1.0f / sqrtf(ssq[r] * (1.0f / 1024.0f) + EPS_);
#pragma unroll
            for (int j = 0; j < 4; ++j) { const f32x4 g = ((const f32x4*)gp)[lane + 64 * j]; const f32x4 y = v[r][j] * rstd * g;
                u32x2 w; w.x = pk2(y[0], y[1]); w.y = pk2(y[2], y[3]); ((u32x2*)(AALL + (size_t)(base + r) * 1024))[lane + 64 * j] = w; }
            if (!ismem && (lane & 7) == 0) { const int c = lane >> 3; const float z = red[r] * rstd + bfv[c]; logf[(size_t)(base + r) * 8 + c] = fminf(z, 0.f) - log1pf(expf(-fabsf(z))); }
        }
    }
}


#define XB_TMO      128
#define XB_XCNT(j)  (256  + 64 * (j))
#define XB_XSUB(j)  (1280 + 64 * (j))
#define XB_XGEN(j)  (2304 + 64 * (j))
#define XB_TOP      3328
#define XB_TOPGEN   3392
#define XCD_BAR_WORDS 3456
#define XB_SPIN_CAP (1u << 20)
__device__ __forceinline__ unsigned xb_ld(unsigned* p)              { return __hip_atomic_load(p, __ATOMIC_RELAXED, __HIP_MEMORY_SCOPE_AGENT); }
__device__ __forceinline__ unsigned xb_add(unsigned* p, unsigned v) { return __hip_atomic_fetch_add(p, v, __ATOMIC_RELAXED, __HIP_MEMORY_SCOPE_AGENT); }
__device__ __forceinline__ unsigned xb_xcc_id() { return (unsigned)__builtin_amdgcn_s_getreg((3 << 11) | 20) & 0xFu; }
#define XB_SPIN(cond, bar) do { unsigned _sp = 0; while (cond) { __builtin_amdgcn_s_sleep(1); \
    if ((++_sp & 255u) == 0u) { if (xb_ld(&(bar)[XB_TMO])) break; if (_sp > XB_SPIN_CAP) { atomicAdd(&(bar)[XB_TMO], 1u); break; } } } } while (0)
struct XcdBarrier { unsigned* bar; unsigned x; volatile LAS unsigned* st; };
__device__ __forceinline__ XcdBarrier xcd_barrier_post(unsigned* bar, volatile LAS unsigned* st) {
    XcdBarrier b; b.bar = bar; b.x = xb_xcc_id(); b.st = st;
    if (threadIdx.x == 0) (void)xb_add(&bar[XB_XCNT(b.x)], 1u);
    return b;
}
__device__ __forceinline__ void xcd_barrier_complete(unsigned* bar, unsigned x, unsigned& nloc, unsigned& nx) {
    const unsigned G = gridDim.x * gridDim.y * gridDim.z;
    unsigned sum, cnt, mine, sp = 0u;
    for (;;) {
        sum = 0u; cnt = 0u; mine = 0u;
#pragma unroll
        for (unsigned j = 0; j < 16; ++j) { const unsigned c = xb_ld(&bar[XB_XCNT(j)]); sum += c; cnt += (c > 0u) ? 1u : 0u; mine = (j == x) ? c : mine; }
        if (sum == G) break;
        __builtin_amdgcn_s_sleep(1);
        if ((++sp & 255u) == 0u) { if (xb_ld(&bar[XB_TMO])) break; if (sp > XB_SPIN_CAP) { atomicAdd(&bar[XB_TMO], 1u); break; } }
    }
    nloc = mine > 0u ? mine : 1u; nx = cnt > 0u ? cnt : 1u;
}
__device__ __forceinline__ void xcd_barrier(const XcdBarrier& b) {
    asm volatile("s_waitcnt vmcnt(0)" ::: "memory");
    __syncthreads();
    if (threadIdx.x == 0) {
        unsigned* bar = b.bar;
        __builtin_amdgcn_s_waitcnt(0);
        unsigned nloc = b.st[0], nx = b.st[1];
        if (nloc == 0u) { xcd_barrier_complete(bar, b.x, nloc, nx); b.st[0] = nloc; b.st[1] = nx; }
        const unsigned old = xb_add(&bar[XB_XSUB(b.x)], 1u);
        const unsigned gen = old / nloc;
        if (old + 1u == (gen + 1u) * nloc) {
            __builtin_amdgcn_fence(__ATOMIC_RELEASE, "agent");
            asm volatile("s_waitcnt vmcnt(0)" ::: "memory");
            const unsigned og = xb_add(&bar[XB_TOP], 1u);
            const unsigned tg = og / nx;
            if (og + 1u == (tg + 1u) * nx) xb_add(&bar[XB_TOPGEN], 1u);
            else XB_SPIN(xb_ld(&bar[XB_TOPGEN]) == tg, bar);
            __builtin_amdgcn_fence(__ATOMIC_ACQUIRE, "agent");
            xb_add(&bar[XB_XGEN(b.x)], 1u);
            asm volatile("s_waitcnt vmcnt(0)" ::: "memory");
        } else {
            XB_SPIN(xb_ld(&bar[XB_XGEN(b.x)]) == gen, bar);
            __builtin_amdgcn_fence(__ATOMIC_ACQUIRE, "agent");
            asm volatile("s_waitcnt vmcnt(0)" ::: "memory");
        }
    }
    __syncthreads();
}

__global__ void __launch_bounds__(512, 2) mk_fwd(Params P) {
    extern __shared__ __attribute__((aligned(16))) unsigned char lds_raw[];
    LAS unsigned char* lds = (LAS unsigned char*)lds_raw;
    const int G = gridDim.x, bx = blockIdx.x;
    const int vcu = (G % 8 == 0) ? (bx % 8) * (G / 8) + bx / 8 : bx;
    unsigned char* ws = P.ws;
    const int lo = P.ph_lo, hi = P.ph_hi;
#ifndef PHASE_MASK
#define PHASE_MASK 255
#endif
#define IN(k) (((PHASE_MASK >> (k)) & 1) && lo <= (k) && (k) < hi)
#define SEAM(k) do { if (IN(k) && IN((k) + 1)) { if ((k) == 0) cg::this_grid().sync(); else xcd_barrier(xbar); } } while (0)
    volatile LAS unsigned* xst = (volatile LAS unsigned*)(lds + LDS_BYTES - 64);
    if (threadIdx.x < 2) xst[threadIdx.x] = 0u;
    __syncthreads();
    XcdBarrier xbar; xbar.bar = (unsigned*)(ws + WS_BAR); xbar.x = 0; xbar.st = xst;
    if (hi - lo > 1) xbar = xcd_barrier_post((unsigned*)(ws + WS_BAR), xst);
    bf16_t* AALL = (bf16_t*)P.out;
    bf16_t* DIL = (bf16_t*)((unsigned char*)P.out + DO_DIL);
    bf16_t* Y = (bf16_t*)((unsigned char*)P.out + DO_Y);
    float* LSE = (float*)(ws + WS_LSE);
    float* C2 = (float*)(ws + WS_C2);

    if (IN(0)) { p0_prologue(P, lds, vcu, G); }
    SEAM(0);
    if (IN(1)) {
        pg8::Gemm g{AALL, (const bf16_t*)(ws + WS_WCAT), 1024, 1024};
        SchedP1 S{G, bx};
        EpiP1 E{(bf16_t*)(ws + WS_QA), (bf16_t*)(ws + WS_KA), (bf16_t*)(ws + WS_VA), (bf16_t*)(ws + WS_QB), (bf16_t*)(ws + WS_KB), (bf16_t*)(ws + WS_VB), (bf16_t*)(ws + WS_QM),
                (bf16_t*)(ws + WS_KM), (bf16_t*)(ws + WS_VM), (unsigned char*)(ws + WS_GATES), P.in[5], P.in[6], P.in[7], P.in[8], P.in[14], (const float*)(ws + WS_COS), (const float*)(ws + WS_SIN)};
        pg8::gemm_phase<EpiP1, SchedP1>(lds, g, S, E);
    }
    SEAM(1);
    if (IN(2)) {
        dil_phase(lds, ws, DIL, LSE, bx, G);
        for (int L = bx; L < 512 + 32 + 64; L += G) {
            if (L < 512) {
                memnorm_unit(lds, (bf16_t*)(ws + WS_QM) + (size_t)L * 4 * 8192, P.in[11], QSCALE_M);
            } else if (L < 512 + 32) {
                memnorm_unit(lds, (bf16_t*)(ws + WS_KM) + (size_t)(L - 512) * 4 * 8192, P.in[12], 1.0f);
            } else {
                cumsum_unit(lds, (const float*)(ws + WS_LOGF), C2, L - 544, P.in[7], P.in[8], (int*)(ws + WS_LO));
            }
        }
    }
    SEAM(2);
    if (IN(3)) {
        const int* LO = (const int*)(ws + WS_LO); const float smax_fox = ((const float*)LO)[1024];
        for (int i = 0;; ++i) {
            const int L = (i & 1) ? i * G + (G - 1 - bx) : i * G + bx;
            if (i * G >= 2048) break;
            if (L >= 2048) continue;
            if (L < 1024) {
                const int qblk = 15 - (L >> 6), bh = L & 63, b = bh >> 3, h = bh & 7;
                const size_t Rs = (size_t)bh << 12;
                attn_unit<64, 1>(lds, (const bf16_t*)(ws + WS_QB) + Rs * 64, (const bf16_t*)(ws + WS_KB) + Rs * 64, (const bf16_t*)(ws + WS_VB) + Rs * 64, C2 + Rs, qblk,
                                 Y + 256 + h * 64, 1280, b * 4096, 0, nullptr, LO[bh * 16 + qblk], smax_fox);
            } else if (L < 1536) {
                const int u = L - 1024, bh = u >> 4, qblk = u & 15, b = bh >> 2, h = bh & 3;
                attn_unit<128, 2>(lds, (const bf16_t*)(ws + WS_QM) + ((size_t)bh << 12) * 128, (const bf16_t*)(ws + WS_KM) + ((size_t)bh << 8) * 128, (const bf16_t*)(ws + WS_VM) + ((size_t)bh << 8) * 128,
                                  nullptr, qblk, Y + 768 + h * 128, 1280, b * 4096, 0, nullptr, 0, 0.f);
            } else {
                merge_unit(DIL, LSE, Y, L - 1536);
            }
        }
    }
    SEAM(3);
    if (IN(4)) {
        pg8::Gemm g{Y, (const bf16_t*)(ws + WS_WBR), 1280, 1280};
        SchedP3 S{G, bx};
        EpiMerge E{(const unsigned char*)(ws + WS_GATES), (bf16_t*)(ws + WS_MERGED)};
        pg8::gemm_phase<EpiMerge, SchedP3>(lds, g, S, E);
    }
    SEAM(4);
    if (IN(5)) {
        pg8::Gemm g{(const bf16_t*)(ws + WS_MERGED), (const bf16_t*)(ws + WS_WOUT), 1024, 1024};
        SchedSimple S{G, bx, 4, 16};
        EpiOut E{P.in[0], P.out, (bf16_t*)(ws + WS_X1B), (float*)(ws + WS_SSQ)};
        pg8::gemm_phase<EpiOut, SchedSimple>(lds, g, S, E);
    }
    SEAM(5);
    if (IN(6)) {
        pg8::Gemm g{(const bf16_t*)(ws + WS_X1B), (const bf16_t*)(ws + WS_WUP), 1024, 1024};
        SchedSimple S{G, bx, 16, 16};
        EpiUp E{(const float*)(ws + WS_SSQ), (bf16_t*)(ws + WS_HMID)};
        pg8::gemm_phase<EpiUp, SchedSimple>(lds, g, S, E);
    }
    SEAM(6);
    if (IN(7)) {
        pg8::Gemm g{(const bf16_t*)(ws + WS_HMID), (const bf16_t*)(ws + WS_WDN), 4096, 4096};
        SchedSimple S{G, bx, 4, 64};
        EpiDown E{P.out, (const bf16_t*)(ws + WS_X1B)};
        pg8::gemm_phase<EpiDown, SchedSimple>(lds, g, S, E);
    }
#undef IN
#undef SEAM
}

extern "C" void kernel_launch(void* const* d_in, const int* in_sizes, int n_in, void* d_out, int out_size, void* d_ws, size_t ws_size, hipStream_t stream) {
    static int grid = 0;
    if (grid == 0) {
        if (n_in != 22 || in_sizes[0] != M_ * DM || out_size != M_ * DM || ws_size < WS_END) {
            fprintf(stderr, "kernel_launch: unexpected shapes (n_in %d, in0 %d, out %d, ws %zu); nothing launched\n", n_in, n_in > 0 ? in_sizes[0] : -1, out_size, ws_size); grid = -1; return; }
        int dev = 0, cus = 0, per_cu = 0;
        if (hipGetDevice(&dev) != hipSuccess || hipDeviceGetAttribute(&cus, hipDeviceAttributeMultiprocessorCount, dev) != hipSuccess) { grid = -1; return; }
        if (hipFuncSetAttribute((const void*)mk_fwd, hipFuncAttributeMaxDynamicSharedMemorySize, LDS_BYTES) != hipSuccess) { fprintf(stderr, "kernel_launch: hipFuncSetAttribute failed\n"); grid = -1; return; }
        if (hipOccupancyMaxActiveBlocksPerMultiprocessor(&per_cu, (const void*)mk_fwd, 512, LDS_BYTES) != hipSuccess || per_cu < 1) { fprintf(stderr, "kernel_launch: occupancy query gave %d\n", per_cu); (void)hipGetLastError(); grid = -1; return; }
        grid = cus * 1;
    }
    if (grid < 0) return;
    if (hipMemsetAsync((char*)d_ws + WS_BAR, 0, WS_BAR_BYTES, stream) != hipSuccess) { fprintf(stderr, "kernel_launch: hipMemsetAsync failed\n"); return; }
    Params p{};
    for (int i = 0; i < 22; ++i) p.in[i] = (const float*)d_in[i];
    p.out = (float*)d_out; p.ws = (unsigned char*)d_ws;
#if MK_MULTI
    for (int ph = 0; ph < NPH; ++ph) { p.ph_lo = ph; p.ph_hi = ph + 1; hipLaunchKernelGGL(mk_fwd, dim3(grid), dim3(512), LDS_BYTES, stream, p); }
#else
    p.ph_lo = 0; p.ph_hi = NPH;
    void* args[] = {&p};
    hipError_t e = hipLaunchCooperativeKernel((const void*)mk_fwd, dim3(grid), dim3(512), args, LDS_BYTES, stream);
    if (e != hipSuccess) fprintf(stderr, "cooperative launch failed: %s (grid %d)\n", hipGetErrorString(e), grid);
#endif
}
```

```cpp
#include <hip/hip_runtime.h>
#include <hip/hip_cooperative_groups.h>
#include <cstdio>
#include <cstdint>
namespace cg = cooperative_groups;

#ifndef MK_MULTI
#define MK_MULTI 0
#endif

#define LAS __attribute__((address_space(3)))
typedef unsigned short bf16_t;
typedef short bf16x8 __attribute__((ext_vector_type(8)));
typedef short s16x4 __attribute__((ext_vector_type(4)));
typedef float f32x4 __attribute__((ext_vector_type(4)));
typedef float f32x16 __attribute__((ext_vector_type(16)));
typedef unsigned u32x4 __attribute__((ext_vector_type(4)));
typedef unsigned u32x2 __attribute__((ext_vector_type(2)));

constexpr int B_ = 8, T_ = 4096, DM = 1024, M_ = B_ * T_;
constexpr int NPH = 8;
constexpr float EPS_ = 1e-6f;
constexpr float LOG2E = 1.4426950408889634f, LN2 = 0.6931471805599453f;
constexpr float QSCALE = 0.125f * LOG2E;
constexpr float QSCALE_M = 0.08838834764831845f * LOG2E;

constexpr size_t MiB = 1u << 20;
constexpr size_t WS_SSQ = 0, WS_COS = 256 * 1024, WS_SIN = 384 * 1024, WS_BAR = 512 * 1024, WS_BAR_BYTES = 16384;
constexpr size_t WS_LOGF = 1 * MiB, WS_C2 = 2 * MiB, WS_LSE = 3 * MiB, WS_LO = 4 * MiB + 768 * 1024;
constexpr size_t WS_WCAT = 5 * MiB, WS_WBR = 22 * MiB, WS_WOUT = 25 * MiB, WS_WUP = 27 * MiB, WS_WDN = 35 * MiB;
constexpr size_t WS_KM = 43 * MiB, WS_VM = 45 * MiB, WS_SSQQ = 47 * MiB;
constexpr size_t WS_QA = 48 * MiB, WS_KA = 96 * MiB, WS_VA = 144 * MiB, WS_QB = 192 * MiB, WS_KB = 224 * MiB, WS_VB = 256 * MiB, WS_QM = 288 * MiB;
constexpr size_t WS_GATES = 320 * MiB, WS_END = 512 * MiB;
constexpr size_t WS_MERGED = 48 * MiB, WS_X1B = 320 * MiB, WS_HMID = 48 * MiB;
constexpr size_t DO_DIL = 0, DO_Y = 48 * MiB;
constexpr int LDS_BYTES = 147456;

struct Params { const float* in[22]; float* out; unsigned char* ws; int ph_lo, ph_hi; };

__device__ __forceinline__ unsigned pk2(float lo, float hi) {
    typedef float f2 __attribute__((ext_vector_type(2))); typedef __bf16 b2 __attribute__((ext_vector_type(2)));
    f2 v = {lo, hi}; b2 b = __builtin_convertvector(v, b2); return __builtin_bit_cast(unsigned, b);
}
__device__ __forceinline__ float bf2f(unsigned short u) { return __uint_as_float(((unsigned)u) << 16); }
__device__ __forceinline__ u32x4 pack8(f32x4 a, f32x4 b) { u32x4 w; w.x = pk2(a[0], a[1]); w.y = pk2(a[2], a[3]); w.z = pk2(b[0], b[1]); w.w = pk2(b[2], b[3]); return w; }
__device__ __forceinline__ void unpack8(u32x4 w, f32x4& a, f32x4& b) {
    a[0] = __uint_as_float(w.x << 16); a[1] = __uint_as_float(w.x & 0xffff0000u); a[2] = __uint_as_float(w.y << 16); a[3] = __uint_as_float(w.y & 0xffff0000u);
    b[0] = __uint_as_float(w.z << 16); b[1] = __uint_as_float(w.z & 0xffff0000u); b[2] = __uint_as_float(w.w << 16); b[3] = __uint_as_float(w.w & 0xffff0000u);
}
__device__ __forceinline__ float sigmoidf_(float x) { return __builtin_amdgcn_rcpf(1.0f + __builtin_amdgcn_exp2f(-x * LOG2E)); }

namespace pg8 {
constexpr int BM = 256, BK = 64, HALF = 128, HTB = HALF * BK * 2, STAGE_BYTES = 8 * HTB, NXCD = 8, WGM = 8;
__host__ __device__ __forceinline__ int lds_byte(int r, int c) { const int st = (r >> 4) * 2 + (c >> 5), rr = r & 15, cc = c & 31, ob = rr * 64 + cc * 2; return st * 1024 + (ob ^ (((ob >> 9) & 1) << 5)); }
__host__ __device__ __forceinline__ void stage_rc(int b, int& R, int& C) { const int st = b / 1024, sb = b % 1024, swz = sb ^ (((sb >> 9) & 1) << 5); R = (st >> 1) * 16 + swz / 64; C = (st & 1) * 32 + (swz % 64) / 2; }
__host__ __device__ __forceinline__ int perm32(int rho) { const int n = rho >> 4, i = rho & 15; return 8 * (i >> 2) + 4 * n + (i & 3); }

struct Unit { int pm, pn, k0, nt, tag, first; };
struct Gemm { const bf16_t* A; const bf16_t* Bt; int lda, ldb; };

__device__ __forceinline__ void tile_order(int L, int nM, int nN, int& pm, int& pn) {
    const int nwg = nM * nN; int wgid = L;
    { const int q = nwg / NXCD, r = nwg % NXCD, xcd = wgid % NXCD, off = wgid / NXCD; wgid = (xcd < r ? xcd * (q + 1) : r * (q + 1) + (xcd - r) * q) + off; }
    const int nig = WGM * nN, gid = wgid / nig, fm = gid * WGM, gsz = (nM - fm) < WGM ? (nM - fm) : WGM;
    pm = fm + ((wgid % nig) % gsz); pn = (wgid % nig) / gsz;
}

template <class Epi, class Sched>
__device__ __forceinline__ void gemm_phase(LAS unsigned char* lds, const Gemm g, const Sched& S, const Epi& E) {
    const int tid = threadIdx.x, wid = __builtin_amdgcn_readfirstlane(tid >> 6), lane = tid & 63, wr = wid >> 2, wc = wid & 3, fr = lane & 15, fq = lane >> 4;
    unsigned voffA[2], voffB[2];
#pragma unroll
    for (int i = 0; i < 2; ++i) { int R, C; stage_rc(tid * 16 + i * 8192, R, C); const int Rb = (R & ~31) + perm32(R & 31);
        voffA[i] = (unsigned)(R * g.lda + C) * 2u; voffB[i] = (unsigned)(Rb * g.ldb + C) * 2u; }
    const size_t kstep = (size_t)(BK * 2);
    const size_t hstepA = (size_t)HALF * g.lda * 2, hstepB = (size_t)HALF * g.ldb * 2, tstepA = 2 * hstepA, tstepB = 2 * hstepB;
    const unsigned ldsw = (unsigned)wid * 1024u;
    const int aoff = lds_byte(wr * 64 + fr, fq * 8), boff = lds_byte(wc * 32 + fr, fq * 8);
#define PG8_SA(b, h) (((b) * 2 + (h)) * HTB)
#define PG8_SB(b, h) ((4 + (b) * 2 + (h)) * HTB)
#define PG8_STAGE(bufoff, gbase, voff) do { _Pragma("unroll") for (int _i = 0; _i < 2; ++_i) \
        __builtin_amdgcn_global_load_lds((const unsigned*)((const char*)(gbase) + (voff)[_i]), (LAS unsigned*)(lds + (bufoff) + ldsw + _i * 8192), 16, 0, 0); } while (0)
#define PG8_LDA(dst, b, h) do { _Pragma("unroll") for (int m = 0; m < 4; ++m) _Pragma("unroll") for (int k = 0; k < 2; ++k) dst[m][k] = *(const LAS bf16x8*)(lds + PG8_SA(b, h) + aoff + m * 2048 + k * 1024); } while (0)
#define PG8_LDB(dst, b, h) do { _Pragma("unroll") for (int n = 0; n < 2; ++n) _Pragma("unroll") for (int k = 0; k < 2; ++k) dst[n][k] = *(const LAS bf16x8*)(lds + PG8_SB(b, h) + boff + n * 2048 + k * 1024); } while (0)
#define PG8_MMA(ai, bj, At, Bt) do { __builtin_amdgcn_s_setprio(1); _Pragma("unroll") for (int m = 0; m < 4; ++m) _Pragma("unroll") for (int n = 0; n < 2; ++n) _Pragma("unroll") for (int k = 0; k < 2; ++k) \
        acc[ai][bj][m][n] = __builtin_amdgcn_mfma_f32_16x16x32_bf16(Bt[n][k], At[m][k], acc[ai][bj][m][n], 0, 0, 0); __builtin_amdgcn_s_setprio(0); } while (0)
#define PG8_WAIT_V(n) asm volatile("s_waitcnt vmcnt(" #n ")" ::: "memory")
#define PG8_WAIT_L(n) asm volatile("s_waitcnt lgkmcnt(" #n ")" ::: "memory")
#define PG8_BAR __builtin_amdgcn_s_barrier()
#define PG8_SCHED __builtin_amdgcn_sched_barrier(0)
    Unit cur, nxt; int ui = 0;
    if (!S.next(0, cur)) return;
    f32x4 acc[2][2][4][2];
#pragma unroll
    for (int a = 0; a < 2; ++a)
#pragma unroll
        for (int b = 0; b < 2; ++b)
#pragma unroll
            for (int m = 0; m < 4; ++m)
#pragma unroll
                for (int n = 0; n < 2; ++n) acc[a][b][m][n] = (f32x4){0.f, 0.f, 0.f, 0.f};
    bf16x8 At[4][2], B0[2][2], B1[2][2];
    const char* cA = (const char*)g.A + (size_t)cur.pm * tstepA + (size_t)cur.k0 * 2; const char* cB = (const char*)g.Bt + (size_t)cur.pn * tstepB + (size_t)cur.k0 * 2;
    PG8_STAGE(PG8_SB(0, 0), cB, voffB); PG8_STAGE(PG8_SB(0, 1), cB + hstepB, voffB); PG8_STAGE(PG8_SA(0, 0), cA, voffA); PG8_STAGE(PG8_SA(0, 1), cA + hstepA, voffA);
    if (wr == 1) PG8_BAR;
    PG8_WAIT_V(2); PG8_BAR;
    PG8_STAGE(PG8_SB(1, 0), cB + kstep, voffB); PG8_STAGE(PG8_SA(1, 0), cA + kstep, voffA); PG8_STAGE(PG8_SB(1, 1), cB + hstepB + kstep, voffB);
    PG8_WAIT_V(6); PG8_BAR;
    for (;;) {
        const bool has_next = S.next(ui + 1, nxt);
        const char* nA = has_next ? (const char*)g.A + (size_t)nxt.pm * tstepA + (size_t)nxt.k0 * 2 : cA; const char* nB = has_next ? (const char*)g.Bt + (size_t)nxt.pn * tstepB + (size_t)nxt.k0 * 2 : cB;
        const int nt = cur.nt;
        for (int t = 0; t < nt; t += 2) {
            const bool last = (t == nt - 2);
            const char* a1 = cA + (size_t)(t + 1) * kstep;
            const char* a2 = last ? nA : cA + (size_t)(t + 2) * kstep; const char* b2 = last ? nB : cB + (size_t)(t + 2) * kstep;
            const char* a3 = a2 + kstep; const char* b3 = b2 + kstep;
            PG8_LDB(B0, 0, 0); PG8_LDB(B1, 0, 1); PG8_SCHED; PG8_LDA(At, 0, 0); PG8_STAGE(PG8_SA(1, 1), a1 + hstepA, voffA);
            PG8_WAIT_V(8); PG8_WAIT_L(0); PG8_BAR; PG8_MMA(0, 0, At, B0); PG8_MMA(0, 1, At, B1); PG8_BAR; PG8_SCHED;
            PG8_LDA(At, 0, 1); PG8_STAGE(PG8_SB(0, 0), b2, voffB); PG8_STAGE(PG8_SB(0, 1), b2 + hstepB, voffB); PG8_STAGE(PG8_SA(0, 0), a2, voffA);
            PG8_WAIT_V(8); PG8_WAIT_L(0); PG8_BAR; PG8_MMA(1, 0, At, B0); PG8_MMA(1, 1, At, B1); PG8_BAR; PG8_SCHED;
            PG8_LDB(B0, 1, 0); PG8_LDB(B1, 1, 1); PG8_SCHED; PG8_LDA(At, 1, 0); PG8_STAGE(PG8_SA(0, 1), a2 + hstepA, voffA);
            PG8_WAIT_V(8); PG8_WAIT_L(0); PG8_BAR; PG8_MMA(0, 0, At, B0); PG8_MMA(0, 1, At, B1); PG8_BAR; PG8_SCHED;
            PG8_LDA(At, 1, 1); PG8_STAGE(PG8_SB(1, 0), b3, voffB); PG8_STAGE(PG8_SB(1, 1), b3 + hstepB, voffB); PG8_STAGE(PG8_SA(1, 0), a3, voffA);
            PG8_WAIT_V(8); PG8_WAIT_L(0); PG8_BAR; PG8_MMA(1, 0, At, B0); PG8_MMA(1, 1, At, B1); PG8_BAR; PG8_SCHED;
        }
        if (wr == 0) PG8_BAR;
        E(acc, cur, wr, wc, fr, fq);
        if (!has_next) break;
        if (nxt.first) {
#pragma unroll
            for (int a = 0; a < 2; ++a)
#pragma unroll
                for (int b = 0; b < 2; ++b)
#pragma unroll
                    for (int m = 0; m < 4; ++m)
#pragma unroll
                        for (int n = 0; n < 2; ++n) acc[a][b][m][n] = (f32x4){0.f, 0.f, 0.f, 0.f};
        }
        cur = nxt; cA = nA; cB = nB; ++ui;
        if (wr == 1) PG8_BAR;
    }
    PG8_WAIT_V(0);
    PG8_BAR;
#undef PG8_SA
#undef PG8_SB
#undef PG8_STAGE
#undef PG8_LDA
#undef PG8_LDB
#undef PG8_MMA
#undef PG8_WAIT_V
#undef PG8_WAIT_L
#undef PG8_BAR
#undef PG8_SCHED
}
}

typedef f32x4 Acc[2][2][4][2];

struct EpiP1 {
    bf16_t *QA, *KA, *VA, *QB, *KB, *VB, *QM, *KM, *VM; unsigned char* GATES8; float* SSQQ;
    const float *g_qA, *g_kA, *g_qB, *g_kB, *b_gate, *cosT, *sinT;

    __device__ __forceinline__ void norm64(Acc& acc, int rowbase, int wc, int fq, const float* gain, float scale, bool rope, bf16_t* base, int hpb, int h, int dl) const {
        const bool dorope = rope && fq < 2;
        const int db0 = dorope ? 4 * fq : 8 * fq, dn = dorope ? 8 : 4;
#pragma unroll
        for (int ai = 0; ai < 2; ++ai)
#pragma unroll
            for (int m = 0; m < 4; ++m) {
                const int mrow = rowbase + ai * 128 + m * 16, b = mrow >> 12, t = mrow & 4095;
                float ss = 0.f;
#pragma unroll
                for (int bj = 0; bj < 2; ++bj)
#pragma unroll
                    for (int n = 0; n < 2; ++n) { const f32x4 x = acc[ai][bj][m][n]; ss += (x[0] * x[0] + x[1] * x[1]) + (x[2] * x[2] + x[3] * x[3]); }
                ss += __shfl_xor(ss, 16); ss += __shfl_xor(ss, 32);
                const float rstd = __builtin_amdgcn_rsqf(ss * (1.0f / 64.0f) + EPS_) * scale;
                f32x4 y[2][2];
#pragma unroll
                for (int n = 0; n < 2; ++n) { y[0][n] = acc[ai][0][m][n] * rstd * *(const f32x4*)(gain + db0 + dn * n); y[1][n] = acc[ai][1][m][n] * rstd * *(const f32x4*)(gain + 32 + 8 * fq + 4 * n); }
                if (dorope) {
                    const f32x4 c4 = *(const f32x4*)(cosT + t * 8 + 4 * fq), s4 = *(const f32x4*)(sinT + t * 8 + 4 * fq);
                    const f32x4 x1 = y[0][0], x2 = y[0][1];
                    y[0][0] = x1 * c4 - x2 * s4; y[0][1] = x2 * c4 + x1 * s4;
                }
                const int r = t & ((1 << dl) - 1), j = t >> dl;
                const int R = ((b * hpb + h) << 12) + (r << (12 - dl)) + j;
                bf16_t* p = base + (size_t)(R >> 6) * 4096 + (R & 63) * 8 + fq * 512;
#pragma unroll
                for (int bj = 0; bj < 2; ++bj) *(u32x4*)(p + bj * 2048) = pack8(y[bj][0], y[bj][1]);
            }
    }
    __device__ __forceinline__ void v64(Acc& acc, int rowbase, int fq, bf16_t* base, int hpb, int h, int dl) const {
#pragma unroll
        for (int ai = 0; ai < 2; ++ai)
#pragma unroll
            for (int m = 0; m < 4; ++m) {
                const int mrow = rowbase + ai * 128 + m * 16, b = mrow >> 12, t = mrow & 4095;
                const int r = t & ((1 << dl) - 1), j = t >> dl;
                const int R = ((b * hpb + h) << 12) + (r << (12 - dl)) + j;
                bf16_t* p = base + (size_t)(R >> 6) * 4096 + (R & 63) * 32 + fq * 8;
#pragma unroll
                for (int bj = 0; bj < 2; ++bj) *(u32x4*)(p + bj * 2048) = pack8(acc[ai][bj][m][0], acc[ai][bj][m][1]);
            }
    }
    __device__ __forceinline__ void raw128(Acc& acc, int rowbase, int wc, int fq, bf16_t* base, int tl, int lg, bool isv, float* ssq) const {
#pragma unroll
        for (int ai = 0; ai < 2; ++ai)
#pragma unroll
            for (int m = 0; m < 4; ++m) {
                const int mrow = rowbase + ai * 128 + m * 16, b = mrow >> lg, t = mrow & ((1 << lg) - 1);
#pragma unroll
                for (int bj = 0; bj < 2; ++bj) {
                    if (ssq) {
                        const f32x4 x0 = acc[ai][bj][m][0], x1 = acc[ai][bj][m][1];
                        float ps = (x0[0] * x0[0] + x0[1] * x0[1]) + (x0[2] * x0[2] + x0[3] * x0[3]) + (x1[0] * x1[0] + x1[1] * x1[1]) + (x1[2] * x1[2] + x1[3] * x1[3]);
                        ps += __shfl_xor(ps, 16); ps += __shfl_xor(ps, 32);
                        if (fq == 0) atomicAdd(ssq + (size_t)mrow * 4 + 2 * tl + bj, ps);
                    }
                    const int R = ((b * 4 + 2 * tl + bj) << lg) + t;
                    bf16_t* p = isv ? base + (size_t)(R >> 6) * 8192 + wc * 2048 + (R & 63) * 32 + fq * 8
                                    : base + (size_t)(R >> 6) * 8192 + (4 * wc + fq) * 512 + (R & 63) * 8;
                    *(u32x4*)p = pack8(acc[ai][bj][m][0], acc[ai][bj][m][1]);
                }
            }
    }
    __device__ __forceinline__ void operator()(Acc& acc, const pg8::Unit& u, int wr, int wc, int fr_in, int fq_in) const {
        int fr = fr_in, fq = fq_in; asm volatile("" : "+v"(fr), "+v"(fq));
        const int pn = u.pn;
        const int rowbase = u.pm * 256 + wr * 64 + fr;
        if (pn < 15) {
            if (pn < 3)       norm64(acc, rowbase, wc, fq, g_qA, QSCALE, true, QA + (size_t)pn * M_ * 256, 4, wc, 2 * pn);
            else if (pn < 6)  norm64(acc, rowbase, wc, fq, g_kA, 1.0f, true, KA + (size_t)(pn - 3) * M_ * 256, 4, wc, 2 * (pn - 3));
            else if (pn < 9)  v64(acc, rowbase, fq, VA + (size_t)(pn - 6) * M_ * 256, 4, wc, 2 * (pn - 6));
            else if (pn < 11) norm64(acc, rowbase, wc, fq, g_qB, QSCALE, false, QB, 8, 4 * (pn - 9) + wc, 0);
            else if (pn < 13) norm64(acc, rowbase, wc, fq, g_kB, 1.0f, false, KB, 8, 4 * (pn - 11) + wc, 0);
            else              v64(acc, rowbase, fq, VB, 8, 4 * (pn - 13) + wc, 0);
        } else if (pn < 17) {
            raw128(acc, rowbase, wc, fq, QM, pn - 15, 12, false, SSQQ);
        } else if (pn < 29) {
            const int colt = (pn - 17) * 256 + wc * 32 + 8 * fq;
            f32x4 bv[2][2];
#pragma unroll
            for (int bj = 0; bj < 2; ++bj)
#pragma unroll
                for (int n = 0; n < 2; ++n) bv[bj][n] = *(const f32x4*)(b_gate + colt + bj * 128 + 4 * n);
            const int lane_ = fr + 16 * fq, wid_ = wr * 4 + wc;
#pragma unroll
            for (int ai = 0; ai < 2; ++ai)
#pragma unroll
                for (int m = 0; m < 4; ++m) {
                    u32x4 w;
#pragma unroll
                    for (int bj = 0; bj < 2; ++bj)
#pragma unroll
                        for (int n = 0; n < 2; ++n) {
                            const f32x4 v = acc[ai][bj][m][n] + bv[bj][n]; unsigned pk = 0;
#pragma unroll
                            for (int e = 0; e < 4; ++e) { unsigned q = (unsigned)(sigmoidf_(v[e]) * 255.0f + 0.5f); q = q < 1u ? 1u : q; pk |= q << (8 * e); }
                            w[bj * 2 + n] = pk;
                        }
                    *(u32x4*)(GATES8 + ((((((size_t)u.pm * 12 + (pn - 17)) * 2 + ai) * 4 + m) * 8 + wid_) * 64 + lane_) * 16) = w;
                }
        } else {
            const int rb = rowbase - M_;
            if (pn < 31) raw128(acc, rb, wc, fq, KM, pn - 29, 8, false, nullptr);
            else         raw128(acc, rb, wc, fq, VM, pn - 31, 8, true, nullptr);
        }
    }
};

struct EpiMerge {
    const unsigned char* GATES8; bf16_t* MERGED;
    __device__ __forceinline__ void operator()(Acc& acc, const pg8::Unit& u, int wr, int wc, int fr_in, int fq_in) const {
        int fr = fr_in, fq = fq_in; asm volatile("" : "+v"(fr), "+v"(fq));
        const int rowbase = u.pm * 256 + wr * 64 + fr, col = u.pn * 256 + wc * 32 + 8 * fq, br = u.tag;
        const int lane_ = fr + 16 * fq, wid_ = wr * 4 + wc;
#pragma unroll
        for (int ai = 0; ai < 2; ++ai)
#pragma unroll
            for (int m = 0; m < 4; ++m) {
                const size_t frag = (((size_t)ai * 4 + m) * 8 + wid_) * 64 + lane_;
                const u32x4 gn = *(const u32x4*)(GATES8 + ((((size_t)u.pm * 12 + br * 4 + u.pn) * 8) * 512 + frag) * 16);
                if (br < 2) {
                    const u32x4 gd = *(const u32x4*)(GATES8 + ((((size_t)u.pm * 12 + (br + 1) * 4 + u.pn) * 8) * 512 + frag) * 16);
#pragma unroll
                    for (int bj = 0; bj < 2; ++bj)
#pragma unroll
                        for (int n = 0; n < 2; ++n)
#pragma unroll
                            for (int e = 0; e < 4; ++e)
                                acc[ai][bj][m][n][e] *= (float)((gn[bj * 2 + n] >> (8 * e)) & 0xffu) * __builtin_amdgcn_rcpf((float)((gd[bj * 2 + n] >> (8 * e)) & 0xffu));
                } else {
                    const int row = rowbase + ai * 128 + m * 16;
#pragma unroll
                    for (int bj = 0; bj < 2; ++bj) {
                        f32x4 o[2];
#pragma unroll
                        for (int n = 0; n < 2; ++n)
#pragma unroll
                            for (int e = 0; e < 4; ++e) o[n][e] = acc[ai][bj][m][n][e] * ((float)((gn[bj * 2 + n] >> (8 * e)) & 0xffu) * (1.0f / 255.0f));
                        *(u32x4*)(MERGED + (size_t)row * 1024 + col + bj * 128) = pack8(o[0], o[1]);
                    }
                }
            }
    }
};
struct EpiOut {
    const float* X; float* OUT; bf16_t* X1B; float* SSQ;
    __device__ __forceinline__ void operator()(Acc& acc, const pg8::Unit& u, int wr, int wc, int fr_in, int fq_in) const {
        int fr = fr_in, fq = fq_in; asm volatile("" : "+v"(fr), "+v"(fq));
        const int rowbase = u.pm * 256 + wr * 64 + fr, col = u.pn * 256 + wc * 32 + 8 * fq;
#pragma unroll
        for (int ai = 0; ai < 2; ++ai)
#pragma unroll
            for (int m = 0; m < 4; ++m) {
                const int row = rowbase + ai * 128 + m * 16; const size_t off = (size_t)row * 1024 + col;
                float ss = 0.f;
#pragma unroll
                for (int bj = 0; bj < 2; ++bj) {
                    const f32x4 x0 = *(const f32x4*)(X + off + bj * 128), x1 = *(const f32x4*)(X + off + bj * 128 + 4);
                    const f32x4 v0 = acc[ai][bj][m][0] + x0, v1 = acc[ai][bj][m][1] + x1;
                    *(u32x4*)(X1B + off + bj * 128) = pack8(v0, v1);
                    ss += (v0[0] * v0[0] + v0[1] * v0[1]) + (v0[2] * v0[2] + v0[3] * v0[3]) + (v1[0] * v1[0] + v1[1] * v1[1]) + (v1[2] * v1[2] + v1[3] * v1[3]);
                }
                ss += __shfl_xor(ss, 16); ss += __shfl_xor(ss, 32);
                if (fq == 0) atomicAdd(SSQ + row, ss);
            }
    }
};
struct EpiUp {
    const float* SSQ; bf16_t* HMID;
    __device__ __forceinline__ void operator()(Acc& acc, const pg8::Unit& u, int wr, int wc, int fr_in, int fq_in) const {
        int fr = fr_in, fq = fq_in; asm volatile("" : "+v"(fr), "+v"(fq));
        const int rowbase = u.pm * 256 + wr * 64 + fr, col = u.pn * 256 + wc * 32 + 8 * fq;
#pragma unroll
        for (int ai = 0; ai < 2; ++ai)
#pragma unroll
            for (int m = 0; m < 4; ++m) {
                const int row = rowbase + ai * 128 + m * 16;
                const float rstd = __builtin_amdgcn_rsqf(SSQ[row] * (1.0f / 1024.0f) + EPS_);
#pragma unroll
                for (int bj = 0; bj < 2; ++bj) {
                    f32x4 v0 = acc[ai][bj][m][0] * rstd, v1 = acc[ai][bj][m][1] * rstd;
#pragma unroll
                    for (int e = 0; e < 4; ++e) { const float a = fmaxf(v0[e], 0.f), b = fmaxf(v1[e], 0.f); v0[e] = a * a; v1[e] = b * b; }
                    *(u32x4*)(HMID + (size_t)row * 4096 + col + bj * 128) = pack8(v0, v1);
                }
            }
    }
};
struct EpiDown {
    float* OUT; const bf16_t* X1B;
    __device__ __forceinline__ void operator()(Acc& acc, const pg8::Unit& u, int wr, int wc, int fr_in, int fq_in) const {
        int fr = fr_in, fq = fq_in; asm volatile("" : "+v"(fr), "+v"(fq));
        const int rowbase = u.pm * 256 + wr * 64 + fr, col = u.pn * 256 + wc * 32 + 8 * fq;
#pragma unroll
        for (int ai = 0; ai < 2; ++ai)
#pragma unroll
            for (int m = 0; m < 4; ++m) {
                const size_t off = (size_t)(rowbase + ai * 128 + m * 16) * 1024 + col;
#pragma unroll
                for (int bj = 0; bj < 2; ++bj) {
                    f32x4 x0, x1; unpack8(*(const u32x4*)(X1B + off + bj * 128), x0, x1);
                    *(f32x4*)(OUT + off + bj * 128) = acc[ai][bj][m][0] + x0; *(f32x4*)(OUT + off + bj * 128 + 4) = acc[ai][bj][m][1] + x1;
                }
            }
    }
};

struct SchedP1 { int G, c;
    __device__ __forceinline__ bool next(int i, pg8::Unit& u) const {
        const int L = i * G + c;
        if (L < 3712) pg8::tile_order(L, 128, 29, u.pm, u.pn);
        else if (L < 3744) { const int idx = L - 3712; u.pm = 128 + (idx >> 2); u.pn = 29 + (idx & 3); }
        else return false;
        u.k0 = 0; u.nt = 16; u.tag = 0; u.first = 1; return true; } };
struct SchedSimple { int G, c, nN, nt;
    __device__ __forceinline__ bool next(int i, pg8::Unit& u) const {
        const int L = i * G + c; if (L >= 128 * nN) return false;
        pg8::tile_order(L, 128, nN, u.pm, u.pn); u.k0 = 0; u.nt = nt; u.tag = 0; u.first = 1; return true; } };
struct SchedP3 { int G, c;
    __device__ __forceinline__ bool next(int i, pg8::Unit& u) const {
        const int ti = i / 3, br = i - 3 * ti; const int L = ti * G + c; if (L >= 512) return false;
        pg8::tile_order(L, 128, 4, u.pm, u.pn); u.k0 = (br == 0) ? 0 : (br == 1 ? 256 : 768); u.nt = (br == 0) ? 4 : 8; u.tag = br; u.first = (br == 0); return true; } };

__device__ __forceinline__ float max3f(float a, float b, float c) { float r; asm("v_max3_f32 %0, %1, %2, %3" : "=v"(r) : "v"(a), "v"(b), "v"(c)); return r; }
__device__ __forceinline__ float max2f(float a, float b) { float r; asm("v_max_f32_e32 %0, %1, %2" : "=v"(r) : "v"(a), "v"(b)); return r; }
__device__ __forceinline__ float halfmax(float m) { auto rr = __builtin_amdgcn_permlane32_swap(__float_as_uint(m), __float_as_uint(m), false, false); return max2f(__uint_as_float(rr[0]), __uint_as_float(rr[1])); }
__device__ __forceinline__ float halfsum(float m) { auto rr = __builtin_amdgcn_permlane32_swap(__float_as_uint(m), __float_as_uint(m), false, false); return __uint_as_float(rr[0]) + __uint_as_float(rr[1]); }
__device__ __forceinline__ float rowmax32(f32x16& p0, f32x16& p1) {
    asm volatile("s_nop 15\n\ts_nop 7" : "+v"(p0), "+v"(p1));
    float a = max3f(p0[0], p0[1], p1[0]), b = max3f(p0[2], p0[3], p1[1]); a = max3f(a, p1[2], p1[3]);
#pragma unroll
    for (int r = 4; r < 16; r += 4) { a = max3f(a, p0[r], p0[r + 1]); b = max3f(b, p0[r + 2], p0[r + 3]); a = max3f(a, p1[r], p1[r + 1]); b = max3f(b, p1[r + 2], p1[r + 3]); }
    return halfmax(max2f(a, b));
}

template <int D, int MODE>
__device__ __forceinline__ void attn_unit(LAS unsigned char* lds, const bf16_t* __restrict__ Qs, const bf16_t* __restrict__ Ks, const bf16_t* __restrict__ Vs,
                                          const float* __restrict__ c2s, int qblk, bf16_t* out, int opitch, int orow0, int odl, float* lse, int fox_lo, float smax) {
    constexpr int TB = 128 * D, NP = TB / 16 / 512, KS = D / 16, DB = D / 32, TE = 64 * D;
    constexpr int TPS = (D == 64) ? 2 : 1;
    constexpr int OFF_V = 2 * TPS * TB, OFF_C = 4 * TPS * TB, OFF_O = OFF_C + 2 * TPS * 256, PITCH = 2 * D + 16;
    const int tid = threadIdx.x, lane = tid & 63, wid = __builtin_amdgcn_readfirstlane(tid >> 6), r32 = lane & 31, hi = lane >> 5;
    const int jw = qblk * 256 + 32 * wid;
    int kt_lo = 0, kt_hi = 4;
    if (MODE == 0) { kt_lo = 4 * qblk - 2; if (kt_lo < 0) kt_lo = 0; kt_hi = 4 * qblk + 4; }
    if (MODE == 1) { kt_hi = 4 * qblk + 4; kt_lo = fox_lo; }
    const int ntile = kt_hi - kt_lo, nstep = (ntile + TPS - 1) / TPS;
#define KT(i) ((MODE == 1) ? (kt_hi - 1 - (i)) : (kt_lo + (i)))
    bf16x8 qf[KS];
    { const bf16_t* qp = Qs + (size_t)(jw >> 6) * TE + ((jw & 63) + r32) * 8 + hi * 512;
#pragma unroll
      for (int ks = 0; ks < KS; ++ks) qf[ks] = *(const bf16x8*)(qp + ks * 1024); }
    float cq = 0.f; if (MODE == 1) cq = c2s[jw + r32];
    float rq = 1.f; if (MODE == 2) rq = __builtin_amdgcn_rsqf(c2s[(size_t)(jw + r32) * 4] * (1.0f / 128.0f) + EPS_) * QSCALE_M;
    f32x16 o[DB];
#pragma unroll
    for (int d = 0; d < DB; ++d)
#pragma unroll
        for (int i = 0; i < 16; ++i) o[d][i] = 0.f;
    float mrun = (MODE == 1) ? 0.f : -1e30f, lrun = 0.f; bool started = false; (void)started;
    u32x4 kr[TPS][NP], vr[TPS][NP]; f32x4 cr[TPS];
#pragma unroll
    for (int sb = 0; sb < TPS; ++sb) cr[sb] = (f32x4){0.f, 0.f, 0.f, 0.f};
#define ATT_GLOAD(st_) do { _Pragma("unroll") for (int sb_ = 0; sb_ < TPS; ++sb_) { const int i_ = (st_) * TPS + sb_; if (i_ < ntile) { const int kt_ = KT(i_); \
        const u32x4* kp_ = (const u32x4*)(Ks + (size_t)kt_ * TE) + tid; const u32x4* vp_ = (const u32x4*)(Vs + (size_t)kt_ * TE) + tid; \
        _Pragma("unroll") for (int p_ = 0; p_ < NP; ++p_) { kr[sb_][p_] = kp_[p_ * 512]; vr[sb_][p_] = vp_[p_ * 512]; } \
        if (MODE == 1) { if (tid < 16) cr[sb_] = ((const f32x4*)(c2s + kt_ * 64))[tid]; } } } } while (0)
    constexpr int OFF_F = OFF_O + 8 * 32 * PITCH;
    if (MODE == 1) { if (lane == 0) ((LAS unsigned*)(lds + OFF_F))[wid] = 0u; }
    ATT_GLOAD(0);
    for (int st = 0; st < nstep; ++st) {
#pragma unroll
        for (int sb = 0; sb < TPS; ++sb) { const int slot = (st & 1) * TPS + sb;
          LAS u32x4* kd = (LAS u32x4*)(lds + slot * TB) + tid; LAS u32x4* vd = (LAS u32x4*)(lds + OFF_V + slot * TB) + tid;
#pragma unroll
          for (int p = 0; p < NP; ++p) { kd[p * 512] = kr[sb][p]; vd[p * 512] = vr[sb][p]; }
          if (MODE == 1) { if (tid < 16) ((LAS f32x4*)(lds + OFF_C + slot * 256))[tid] = cr[sb]; } }
        __syncthreads();
        if (MODE == 1) {
            const u32x4 f0 = ((const LAS u32x4*)(lds + OFF_F))[0], f1 = ((const LAS u32x4*)(lds + OFF_F))[1];
            if ((f0.x & f0.y & f0.z & f0.w & f1.x & f1.y & f1.z & f1.w) != 0u) break;
        }
        if (st + 1 < nstep) ATT_GLOAD(st + 1);
#pragma unroll
      for (int sb = 0; sb < TPS; ++sb) {
        const int it = st * TPS + sb; if (it >= ntile) break;
        const int kt = KT(it);
        const int buf = (st & 1) * TPS + sb;
        bool active = true;
        if (MODE == 0) active = (kt * 64 + 63 >= jw - 128) && (kt * 64 <= jw + 31);
        if (MODE == 1) {
            active = (kt * 64 <= jw + 31);
            if (active) { const float cend = ((const LAS float*)(lds + OFF_C + buf * 256))[63];
                active = !started || __builtin_amdgcn_ballot_w64(smax + cq - cend - mrun >= -135.0f) != 0;
                if (!active) { if (lane == 0) ((LAS unsigned*)(lds + OFF_F))[wid] = 1u; } }
        }
        if (active) {
            f32x16 s0, s1;
            if (MODE == 1) {
                const LAS f32x4* cb = (const LAS f32x4*)(lds + OFF_C + buf * 256);
                const float cqm = cq - mrun;
#pragma unroll
                for (int i4 = 0; i4 < 4; ++i4) { const f32x4 c0 = cb[2 * i4 + hi], c1 = cb[8 + 2 * i4 + hi];
#pragma unroll
                    for (int e = 0; e < 4; ++e) { s0[4 * i4 + e] = cqm - c0[e]; s1[4 * i4 + e] = cqm - c1[e]; } }
            } else {
#pragma unroll
                for (int i = 0; i < 16; ++i) { s0[i] = 0.f; s1[i] = 0.f; }
            }
            const LAS unsigned char* kb = lds + buf * TB + hi * 1024 + r32 * 16;
#pragma unroll
            for (int ks = 0; ks < KS; ++ks) {
                const bf16x8 a0 = *(const LAS bf16x8*)(kb + ks * 2048), a1 = *(const LAS bf16x8*)(kb + ks * 2048 + 512);
                s0 = __builtin_amdgcn_mfma_f32_32x32x16_bf16(a0, qf[ks], s0, 0, 0, 0);
                s1 = __builtin_amdgcn_mfma_f32_32x32x16_bf16(a1, qf[ks], s1, 0, 0, 0);
            }
            if (MODE == 2) {
#pragma unroll
                for (int i = 0; i < 16; ++i) { s0[i] *= rq; s1[i] *= rq; }
            }
            const int q = jw + r32, key0 = kt * 64 + 4 * hi;
            if (MODE == 0) {
#pragma unroll
                for (int i = 0; i < 16; ++i) { const int key = key0 + 8 * (i >> 2) + (i & 3);
                    if (key > q || key < q - 128) s0[i] = -INFINITY;
                    if (key + 32 > q || key + 32 < q - 128) s1[i] = -INFINITY; }
            }
            if (MODE == 1) {
                if (kt * 64 + 63 > jw) {
#pragma unroll
                    for (int i = 0; i < 16; ++i) { const int key = key0 + 8 * (i >> 2) + (i & 3);
                        if (key > q) s0[i] = -INFINITY;
                        if (key + 32 > q) s1[i] = -INFINITY; }
                }
            }
            const float mx = rowmax32(s0, s1);
            float rs = 0.f;
            if (MODE == 1) {
                if (!started) {
                    started = true; mrun = mx;
#pragma unroll
                    for (int i = 0; i < 16; ++i) { s0[i] -= mx; s1[i] -= mx; }
                } else if (__builtin_amdgcn_ballot_w64(mx > 0.f) != 0) {
                    const float dl = max2f(mx, 0.f), alpha = __builtin_amdgcn_exp2f(-dl);
                    mrun += dl; lrun *= alpha;
#pragma unroll
                    for (int i = 0; i < 16; ++i) { s0[i] -= dl; s1[i] -= dl; }
#pragma unroll
                    for (int d = 0; d < DB; ++d)
#pragma unroll
                        for (int i = 0; i < 16; ++i) o[d][i] *= alpha;
                }
#pragma unroll
                for (int i = 0; i < 16; ++i) { s0[i] = __builtin_amdgcn_exp2f(s0[i]); s1[i] = __builtin_amdgcn_exp2f(s1[i]); rs += s0[i] + s1[i]; }
            } else {
                const float mnew = max2f(mrun, mx);
                if (__builtin_amdgcn_ballot_w64(mnew > mrun) != 0) {
                    const float alpha = __builtin_amdgcn_exp2f(mrun - mnew);
                    lrun *= alpha;
#pragma unroll
                    for (int d = 0; d < DB; ++d)
#pragma unroll
                        for (int i = 0; i < 16; ++i) o[d][i] *= alpha;
                }
                mrun = mnew;
#pragma unroll
                for (int i = 0; i < 16; ++i) { s0[i] = __builtin_amdgcn_exp2f(s0[i] - mnew); s1[i] = __builtin_amdgcn_exp2f(s1[i] - mnew); rs += s0[i] + s1[i]; }
            }
            lrun += rs;
            u32x4 pw[4];
            pw[0] = (u32x4){pk2(s0[0], s0[1]), pk2(s0[2], s0[3]), pk2(s0[4], s0[5]), pk2(s0[6], s0[7])};
            pw[1] = (u32x4){pk2(s0[8], s0[9]), pk2(s0[10], s0[11]), pk2(s0[12], s0[13]), pk2(s0[14], s0[15])};
            pw[2] = (u32x4){pk2(s1[0], s1[1]), pk2(s1[2], s1[3]), pk2(s1[4], s1[5]), pk2(s1[6], s1[7])};
            pw[3] = (u32x4){pk2(s1[8], s1[9]), pk2(s1[10], s1[11]), pk2(s1[12], s1[13]), pk2(s1[14], s1[15])};
            const LAS unsigned char* vb = lds + OFF_V + buf * TB + ((lane >> 4) & 1) * 32 + (lane & 3) * 8 + (4 * hi + ((lane & 15) >> 2)) * 64;
#pragma unroll
            for (int d = 0; d < DB; ++d)
#pragma unroll
                for (int kk = 0; kk < 4; ++kk) {
                    typedef short v4i16_t __attribute__((ext_vector_type(4)));
                    const s16x4 lo = __builtin_bit_cast(s16x4, __builtin_amdgcn_ds_read_tr16_b64_v4i16((LAS v4i16_t*)(vb + d * 4096 + kk * 1024)));
                    const s16x4 hh = __builtin_bit_cast(s16x4, __builtin_amdgcn_ds_read_tr16_b64_v4i16((LAS v4i16_t*)(vb + d * 4096 + kk * 1024 + 512)));
                    const bf16x8 vf = (bf16x8){lo[0], lo[1], lo[2], lo[3], hh[0], hh[1], hh[2], hh[3]};
                    o[d] = __builtin_amdgcn_mfma_f32_32x32x16_bf16(vf, __builtin_bit_cast(bf16x8, pw[kk]), o[d], 0, 0, 0);
                }
        }
      }
    }
#undef ATT_GLOAD
#undef KT
    lrun = halfsum(lrun);
    const float inv = 1.0f / lrun;
    if (MODE == 0) { if (hi == 0) lse[(size_t)(orow0 + ((jw + r32) << odl)) * 4] = (mrun + __builtin_amdgcn_logf(lrun)) * LN2; }
    LAS unsigned char* stw = lds + OFF_O + wid * (32 * PITCH);
#pragma unroll
    for (int d = 0; d < DB; ++d)
#pragma unroll
        for (int i4 = 0; i4 < 4; ++i4) {
            u32x2 w; w.x = pk2(o[d][4 * i4] * inv, o[d][4 * i4 + 1] * inv); w.y = pk2(o[d][4 * i4 + 2] * inv, o[d][4 * i4 + 3] * inv);
            *(LAS u32x2*)(stw + r32 * PITCH + (32 * d + 8 * i4 + 4 * hi) * 2) = w;
        }
    constexpr int LPR = D / 8, RPI = 64 / LPR;
#pragma unroll
    for (int it = 0; it < 32 / RPI; ++it) {
        const int row = it * RPI + lane / LPR, ch = lane % LPR;
        const u32x4 v = *(const LAS u32x4*)(stw + row * PITCH + ch * 16);
        const int mrow = orow0 + ((jw + row) << odl);
        *(u32x4*)(out + (size_t)mrow * opitch + ch * 8) = v;
    }
    __syncthreads();
}

struct DilUnit { const bf16_t *Qs, *Ks, *Vs; bf16_t* out; float* lse; int qblk, orow0, odl; };
__device__ __forceinline__ void dil_decode(unsigned char* ws, bf16_t* DIL, float* LSE, int L, DilUnit& u) {
    const int gi = L / 512, rem = L % 512, bh = rem >> 4, rj = rem & 15, b = bh >> 2, h = bh & 3;
    const int dl = 2 * gi, qpb = 16 >> dl;
    const int r = rj / qpb; u.qblk = rj % qpb;
    const size_t Rs = ((size_t)(b * 4 + h) << 12) + ((size_t)r << (12 - dl));
    u.Qs = (const bf16_t*)(ws + WS_QA) + (size_t)gi * M_ * 256 + Rs * 64;
    u.Ks = (const bf16_t*)(ws + WS_KA) + (size_t)gi * M_ * 256 + Rs * 64;
    u.Vs = (const bf16_t*)(ws + WS_VA) + (size_t)gi * M_ * 256 + Rs * 64;
    u.out = DIL + (size_t)gi * M_ * 256 + h * 64; u.lse = LSE + (size_t)gi * M_ * 4 + h; u.orow0 = b * 4096 + r; u.odl = dl;
}
__device__ __forceinline__ void dil_phase(LAS unsigned char* lds, unsigned char* ws, bf16_t* DIL, float* LSE, int bx, int G) {
    constexpr int TB = 8192, TE = 4096, OFF_V = 6 * TB, OFF_O = 12 * TB, PITCH = 144;
    typedef short v4i16_t __attribute__((ext_vector_type(4)));
    int tid = threadIdx.x; asm volatile("" : "+v"(tid));
    const int lane = tid & 63, wid = __builtin_amdgcn_readfirstlane(tid >> 6), r32 = lane & 31, hi = lane >> 5;
    if (bx >= 1536) return;
    DilUnit cur, nxt; dil_decode(ws, DIL, LSE, bx, cur);
    u32x4 kr[6], vr[6]; bf16x8 qn[4];
#define DIL_LOAD(U) do { const int t0_ = 4 * (U).qblk - 2; \
        _Pragma("unroll") for (int s_ = 0; s_ < 6; ++s_) { if (t0_ + s_ >= 0) { kr[s_] = ((const u32x4*)((U).Ks + (size_t)(t0_ + s_) * TE))[tid]; vr[s_] = ((const u32x4*)((U).Vs + (size_t)(t0_ + s_) * TE))[tid]; } } \
        const int jw_ = (U).qblk * 256 + 32 * wid; const bf16_t* qp_ = (U).Qs + (size_t)(jw_ >> 6) * TE + ((jw_ & 63) + r32) * 8 + hi * 512; \
        _Pragma("unroll") for (int ks = 0; ks < 4; ++ks) qn[ks] = *(const bf16x8*)(qp_ + ks * 1024); } while (0)
#pragma unroll
    for (int s = 0; s < 6; ++s) { kr[s] = (u32x4){0u, 0u, 0u, 0u}; vr[s] = (u32x4){0u, 0u, 0u, 0u}; }
    DIL_LOAD(cur);
    for (int L = bx; L < 1536; L += G) {
        const bool has_next = (L + G < 1536);
        if (has_next) dil_decode(ws, DIL, LSE, L + G, nxt);
#pragma unroll
        for (int s = 0; s < 6; ++s) { ((LAS u32x4*)(lds + s * TB))[tid] = kr[s]; ((LAS u32x4*)(lds + OFF_V + s * TB))[tid] = vr[s]; }
        bf16x8 qf[4];
#pragma unroll
        for (int ks = 0; ks < 4; ++ks) qf[ks] = qn[ks];
        __syncthreads();
        if (has_next) DIL_LOAD(nxt);
        const int jw = cur.qblk * 256 + 32 * wid, q = jw + r32, t0 = 4 * cur.qblk - 2;
        int kfirst = (jw - 128) >> 6; if (kfirst < 0) kfirst = 0;
        const int klast = (jw + 31) >> 6;
        f32x16 o[2];
#pragma unroll
        for (int d = 0; d < 2; ++d)
#pragma unroll
            for (int i = 0; i < 16; ++i) o[d][i] = 0.f;
        float mrun = -1e30f, lrun = 0.f;
        for (int kt = kfirst; kt <= klast; ++kt) {
            const int slot = kt - t0;
            f32x16 s0, s1;
#pragma unroll
            for (int i = 0; i < 16; ++i) { s0[i] = 0.f; s1[i] = 0.f; }
            const LAS unsigned char* kb = lds + slot * TB + hi * 1024 + r32 * 16;
#pragma unroll
            for (int ks = 0; ks < 4; ++ks) {
                const bf16x8 a0 = *(const LAS bf16x8*)(kb + ks * 2048), a1 = *(const LAS bf16x8*)(kb + ks * 2048 + 512);
                s0 = __builtin_amdgcn_mfma_f32_32x32x16_bf16(a0, qf[ks], s0, 0, 0, 0);
                s1 = __builtin_amdgcn_mfma_f32_32x32x16_bf16(a1, qf[ks], s1, 0, 0, 0);
            }
            const int key0 = kt * 64 + 4 * hi;
#pragma unroll
            for (int i = 0; i < 16; ++i) { const int key = key0 + 8 * (i >> 2) + (i & 3);
                if (key > q || key < q - 128) s0[i] = -INFINITY;
                if (key + 32 > q || key + 32 < q - 128) s1[i] = -INFINITY; }
            const float mx = rowmax32(s0, s1);
            const float mnew = max2f(mrun, mx);
            if (__builtin_amdgcn_ballot_w64(mnew > mrun) != 0) {
                const float alpha = __builtin_amdgcn_exp2f(mrun - mnew);
                lrun *= alpha;
#pragma unroll
                for (int d = 0; d < 2; ++d)
#pragma unroll
                    for (int i = 0; i < 16; ++i) o[d][i] *= alpha;
            }
            mrun = mnew;
            float rs = 0.f;
#pragma unroll
            for (int i = 0; i < 16; ++i) { s0[i] = __builtin_amdgcn_exp2f(s0[i] - mnew); s1[i] = __builtin_amdgcn_exp2f(s1[i] - mnew); rs += s0[i] + s1[i]; }
            lrun += rs;
            u32x4 pw[4];
            pw[0] = (u32x4){pk2(s0[0], s0[1]), pk2(s0[2], s0[3]), pk2(s0[4], s0[5]), pk2(s0[6], s0[7])};
            pw[1] = (u32x4){pk2(s0[8], s0[9]), pk2(s0[10], s0[11]), pk2(s0[12], s0[13]), pk2(s0[14], s0[15])};
            pw[2] = (u32x4){pk2(s1[0], s1[1]), pk2(s1[2], s1[3]), pk2(s1[4], s1[5]), pk2(s1[6], s1[7])};
            pw[3] = (u32x4){pk2(s1[8], s1[9]), pk2(s1[10], s1[11]), pk2(s1[12], s1[13]), pk2(s1[14], s1[15])};
            const LAS unsigned char* vb = lds + OFF_V + slot * TB + ((lane >> 4) & 1) * 32 + (lane & 3) * 8 + (4 * hi + ((lane & 15) >> 2)) * 64;
#pragma unroll
            for (int d = 0; d < 2; ++d)
#pragma unroll
                for (int kk = 0; kk < 4; ++kk) {
                    const s16x4 lo = __builtin_bit_cast(s16x4, __builtin_amdgcn_ds_read_tr16_b64_v4i16((LAS v4i16_t*)(vb + d * 4096 + kk * 1024)));
                    const s16x4 hh = __builtin_bit_cast(s16x4, __builtin_amdgcn_ds_read_tr16_b64_v4i16((LAS v4i16_t*)(vb + d * 4096 + kk * 1024 + 512)));
                    const bf16x8 vf = (bf16x8){lo[0], lo[1], lo[2], lo[3], hh[0], hh[1], hh[2], hh[3]};
                    o[d] = __builtin_amdgcn_mfma_f32_32x32x16_bf16(vf, __builtin_bit_cast(bf16x8, pw[kk]), o[d], 0, 0, 0);
                }
        }
        lrun = halfsum(lrun);
        const float inv = 1.0f / lrun;
        if (hi == 0) cur.lse[(size_t)(cur.orow0 + ((jw + r32) << cur.odl)) * 4] = (mrun + __builtin_amdgcn_logf(lrun)) * LN2;
        LAS unsigned char* stw = lds + OFF_O + wid * (32 * PITCH);
#pragma unroll
        for (int d = 0; d < 2; ++d)
#pragma unroll
            for (int i4 = 0; i4 < 4; ++i4) {
                u32x2 w; w.x = pk2(o[d][4 * i4] * inv, o[d][4 * i4 + 1] * inv); w.y = pk2(o[d][4 * i4 + 2] * inv, o[d][4 * i4 + 3] * inv);
                *(LAS u32x2*)(stw + r32 * PITCH + (32 * d + 8 * i4 + 4 * hi) * 2) = w;
            }
#pragma unroll
        for (int it = 0; it < 4; ++it) {
            const int row = it * 8 + (lane >> 3), ch = lane & 7;
            const u32x4 v = *(const LAS u32x4*)(stw + row * PITCH + ch * 16);
            const int mrow = cur.orow0 + ((jw + row) << cur.odl);
            *(u32x4*)(cur.out + (size_t)mrow * 256 + ch * 8) = v;
        }
        __syncthreads();
        cur = nxt;
    }
#undef DIL_LOAD
}

__device__ __forceinline__ void memnorm_unit(LAS unsigned char* lds, bf16_t* tiles, const float* gain, const float* gain2, float scale) {
    int tid = threadIdx.x; asm volatile("" : "+v"(tid));
    const int lane = tid & 63, wid = tid >> 6;
    LAS float* part = (LAS float*)lds;
    u32x4 raw[4][2];
#pragma unroll
    for (int t = 0; t < 4; ++t) { raw[t][0] = *(const u32x4*)(tiles + (size_t)t * 8192 + (2 * wid) * 512 + lane * 8); raw[t][1] = *(const u32x4*)(tiles + (size_t)t * 8192 + (2 * wid + 1) * 512 + lane * 8); }
#pragma unroll
    for (int t = 0; t < 4; ++t) {
        f32x4 a0, a1, b0, b1; unpack8(raw[t][0], a0, a1); unpack8(raw[t][1], b0, b1);
        float ss = 0.f;
#pragma unroll
        for (int e = 0; e < 4; ++e) ss += a0[e] * a0[e] + a1[e] * a1[e] + b0[e] * b0[e] + b1[e] * b1[e];
        part[(t * 8 + wid) * 64 + lane] = ss;
    }
    __syncthreads();
    const f32x4 g0 = *(const f32x4*)(gain + 16 * wid) * *(const f32x4*)(gain2 + 16 * wid), g1 = *(const f32x4*)(gain + 16 * wid + 4) * *(const f32x4*)(gain2 + 16 * wid + 4),
                g2 = *(const f32x4*)(gain + 16 * wid + 8) * *(const f32x4*)(gain2 + 16 * wid + 8), g3 = *(const f32x4*)(gain + 16 * wid + 12) * *(const f32x4*)(gain2 + 16 * wid + 12);
#pragma unroll
    for (int t = 0; t < 4; ++t) {
        float tot = 0.f;
#pragma unroll
        for (int w = 0; w < 8; ++w) tot += part[(t * 8 + w) * 64 + lane];
        const float rstd = __builtin_amdgcn_rsqf(tot * (1.0f / 128.0f) + EPS_) * scale;
        f32x4 a0, a1, b0, b1; unpack8(raw[t][0], a0, a1); unpack8(raw[t][1], b0, b1);
        *(u32x4*)(tiles + (size_t)t * 8192 + (2 * wid) * 512 + lane * 8) = pack8(a0 * g0 * rstd, a1 * g1 * rstd);
        *(u32x4*)(tiles + (size_t)t * 8192 + (2 * wid + 1) * 512 + lane * 8) = pack8(b0 * g2 * rstd, b1 * g3 * rstd);
    }
    __syncthreads();
}

__device__ __forceinline__ void cumsum_unit(LAS unsigned char* lds, const float* logf, float* c2, int bh, const float* gq, const float* gk, int* lo_tab) {
    const int tid = threadIdx.x, lane = tid & 63, wid = tid >> 6, b = bh >> 3, h = bh & 7;
    LAS float* wt = (LAS float*)lds;
    LAS float* wstart = (LAS float*)(lds + 64); LAS float* wend = (LAS float*)(lds + 64 + 256);
    float v[8]; float run = 0.f;
#pragma unroll
    for (int k = 0; k < 8; ++k) { run += logf[(size_t)(b * 4096 + tid * 8 + k) * 8 + h]; v[k] = run; }
    float inc = run;
#pragma unroll
    for (int o = 1; o < 64; o <<= 1) { const float t = __shfl_up(inc, o); if (lane >= o) inc += t; }
    if (lane == 63) wt[wid] = inc;
    __syncthreads();
    float pre = inc - run;
    for (int w = 0; w < wid; ++w) pre += wt[w];
#pragma unroll
    for (int k = 0; k < 8; ++k) c2[(size_t)bh * 4096 + tid * 8 + k] = (pre + v[k]) * LOG2E;
    if ((tid & 7) == 0) wstart[tid >> 3] = (pre + v[0]) * LOG2E;
    if ((tid & 7) == 7) wend[tid >> 3] = (pre + v[7]) * LOG2E;
    __syncthreads();
    float gqm = 0.f, gkm = 0.f;
    for (int i = 0; i < 64; ++i) { gqm = fmaxf(gqm, fabsf(gq[i])); gkm = fmaxf(gkm, fabsf(gk[i])); }
    const float smax = 64.0f * QSCALE * gqm * gkm * 1.02f;
    if (tid < 16) {
        const float cq0 = wstart[4 * tid]; int lo = 0;
        while (lo < 4 * tid && smax + cq0 - wend[lo] + smax < -135.0f) ++lo;
        lo_tab[bh * 16 + tid] = lo;
    }
    if (bh == 0 && tid == 0) ((float*)lo_tab)[1024] = smax;
    __syncthreads();
}

__device__ __forceinline__ void merge_unit(const bf16_t* DIL, const float* LSE, bf16_t* Y, int u) {
    const int tid = threadIdx.x;
#pragma unroll
    for (int k = 0; k < 4; ++k) {
        const int it = tid + 512 * k, row = 64 * u + (it >> 5), c8 = it & 31, h = c8 >> 3;
        const float l0 = LSE[(size_t)row * 4 + h], l1 = LSE[(size_t)(M_ + row) * 4 + h], l2 = LSE[(size_t)(2 * M_ + row) * 4 + h];
        const float mx = fmaxf(l0, fmaxf(l1, l2));
        float w0 = __expf(l0 - mx), w1 = __expf(l1 - mx), w2 = __expf(l2 - mx);
        const float inv = 1.0f / (w0 + w1 + w2); w0 *= inv; w1 *= inv; w2 *= inv;
        f32x4 a0, a1, b0, b1, c0, c1;
        unpack8(*(const u32x4*)(DIL + (size_t)row * 256 + c8 * 8), a0, a1);
        unpack8(*(const u32x4*)(DIL + (size_t)(M_ + row) * 256 + c8 * 8), b0, b1);
        unpack8(*(const u32x4*)(DIL + (size_t)(2 * M_ + row) * 256 + c8 * 8), c0, c1);
        *(u32x4*)(Y + (size_t)row * 1280 + c8 * 8) = pack8(a0 * w0 + b0 * w1 + c0 * w2, a1 * w0 + b1 * w1 + c1 * w2);
    }
}

__device__ __forceinline__ float wave_sum(float v) {
#pragma unroll
    for (int o = 1; o < 64; o <<= 1) v += __shfl_xor(v, o);
    return v;
}
__device__ __forceinline__ void cat_src(const Params& P, int n, const float*& base, int& ld, int& col) {
    const int tile = n >> 8, c = n & 255, bj = c >> 7, wc = (c >> 5) & 3, j = c & 31;
    if (tile < 15) {
        int colbase, head; bool rope = false;
        if (tile < 3) { colbase = 0; head = tile * 4 + wc; rope = true; }
        else if (tile < 6) { colbase = 768; head = (tile - 3) * 4 + wc; rope = true; }
        else if (tile < 9) { colbase = 1536; head = (tile - 6) * 4 + wc; }
        else if (tile < 11) { colbase = 2304; head = (tile - 9) * 4 + wc; }
        else if (tile < 13) { colbase = 2816; head = (tile - 11) * 4 + wc; }
        else { colbase = 3328; head = (tile - 13) * 4 + wc; }
        const int p = 32 * bj + j; const int d = (rope && p < 16) ? ((p & 3) + 4 * ((p >> 3) & 1) + 8 * ((p >> 2) & 1)) : p;
        base = P.in[3]; ld = 4360; col = colbase + head * 64 + d;
    } else if (tile < 17) { base = P.in[3]; ld = 4360; col = 3848 + (2 * (tile - 15) + bj) * 128 + 32 * wc + j; }
    else if (tile < 29) { base = P.in[13]; ld = 3072; col = n - 4352; }
    else if (tile < 31) { base = P.in[10]; ld = 1024; col = (2 * (tile - 29) + bj) * 128 + 32 * wc + j; }
    else { base = P.in[10]; ld = 1024; col = 512 + (2 * (tile - 31) + bj) * 128 + 32 * wc + j; }
}
__device__ __forceinline__ void transpose_item(const float* srcp  , int ldsrc, int k0, const float* kscale, bf16_t* dst, int ldd, int drow0, int dcol0,
                                               LAS float* scr, int lane) {
    float tv[32];
#pragma unroll
    for (int i = 0; i < 32; ++i) { const int kk = 2 * i + (lane >> 5); tv[i] = srcp[(size_t)(k0 + kk) * ldsrc]; }
    if (kscale) {
#pragma unroll
        for (int i = 0; i < 32; ++i) tv[i] *= kscale[k0 + 2 * i + (lane >> 5)];
    }
#pragma unroll
    for (int i = 0; i < 32; ++i) scr[(2 * i + (lane >> 5)) * 33 + (lane & 31)] = tv[i];
    asm volatile("s_waitcnt lgkmcnt(0)" ::: "memory");
    const int c = lane & 7;
#pragma unroll
    for (int jx = 0; jx < 4; ++jx) { const int n = (lane >> 3) + 8 * jx; const LAS float* s = scr + (8 * c) * 33 + n;
        u32x4 o; o.x = pk2(s[0 * 33], s[1 * 33]); o.y = pk2(s[2 * 33], s[3 * 33]); o.z = pk2(s[4 * 33], s[5 * 33]); o.w = pk2(s[6 * 33], s[7 * 33]);
        *(u32x4*)(dst + (size_t)(drow0 + n) * ldd + dcol0 + k0 + 8 * c) = o; }
    asm volatile("s_waitcnt lgkmcnt(0)" ::: "memory");
}

__device__ __forceinline__ void p0_prologue(const Params& P, LAS unsigned char* lds, int vcu, int G) {
    const int tid = threadIdx.x, lane = tid & 63, wave = tid >> 6;
    unsigned char* ws = P.ws;
    const float* w_in = P.in[3];
    LAS float* wfl = (LAS float*)(lds + 73728);
    { float wv[16], gv[16];
#pragma unroll
      for (int j = 0; j < 16; ++j) { const int i = tid + 512 * j, k = i >> 3, c = i & 7; wv[j] = w_in[(size_t)k * 4360 + 3840 + c]; gv[j] = P.in[2][k]; }
#pragma unroll
      for (int j = 0; j < 16; ++j) { const int i = tid + 512 * j, k = i >> 3, c = i & 7; wfl[c * 1024 + k] = wv[j] * gv[j]; } }
    const int gtid = vcu * 512 + tid, GT = G * 512;
    { float* ssq = (float*)(ws + WS_SSQ); for (int i = gtid; i < M_; i += GT) ssq[i] = 0.f;
      float* ssqq = (float*)(ws + WS_SSQQ); for (int i = gtid; i < M_ * 4; i += GT) ssqq[i] = 0.f; }
    { float* cosT = (float*)(ws + WS_COS); float* sinT = (float*)(ws + WS_SIN);
      for (int i = gtid; i < 4096 * 8; i += GT) { const int t = i >> 3, f = i & 7; const float inv = powf(500000.0f, -(float)(2 * f) / 16.0f); const float ang = (float)t * inv; cosT[i] = cosf(ang); sinT[i] = sinf(ang); } }
    LAS float* scr = (LAS float*)(lds + wave * 8448);
    const int gw = vcu * 8 + wave, NGW = G * 8;
    constexpr int I_CAT = 16 * 264, I_BA = 4 * 32, I_BB = 8 * 32, I_BM = 8 * 32, I_OUT = 16 * 32, I_UP = 16 * 128, I_DN = 64 * 32;
    constexpr int NITEMS = I_CAT + I_BA + I_BB + I_BM + I_OUT + I_UP + I_DN;
    bf16_t* WCAT = (bf16_t*)(ws + WS_WCAT); bf16_t* WBR = (bf16_t*)(ws + WS_WBR); bf16_t* WOUT = (bf16_t*)(ws + WS_WOUT); bf16_t* WUP = (bf16_t*)(ws + WS_WUP); bf16_t* WDN = (bf16_t*)(ws + WS_WDN);
    for (int it = gw; it < NITEMS; it += NGW) {
        int r = it;
        if (r < I_CAT) { const int kb = r / 264, nb = r % 264; const float* base; int ld, col; cat_src(P, nb * 32 + (lane & 31), base, ld, col);
            transpose_item(base + col, ld, kb * 64, nullptr, WCAT, 1024, nb * 32, 0, scr, lane); continue; }
        r -= I_CAT;
        if (r < I_BA) { const int kb = r / 32, nb = r % 32; transpose_item(P.in[15] + nb * 32 + (lane & 31), 1024, kb * 64, nullptr, WBR, 1280, nb * 32, 0, scr, lane); continue; }
        r -= I_BA;
        if (r < I_BB) { const int kb = r / 32, nb = r % 32; transpose_item(P.in[16] + nb * 32 + (lane & 31), 1024, kb * 64, nullptr, WBR, 1280, nb * 32, 256, scr, lane); continue; }
        r -= I_BB;
        if (r < I_BM) { const int kb = r / 32, nb = r % 32; transpose_item(P.in[17] + nb * 32 + (lane & 31), 1024, kb * 64, nullptr, WBR, 1280, nb * 32, 768, scr, lane); continue; }
        r -= I_BM;
        if (r < I_OUT) { const int kb = r / 32, nb = r % 32; transpose_item(P.in[18] + nb * 32 + (lane & 31), 1024, kb * 64, nullptr, WOUT, 1024, nb * 32, 0, scr, lane); continue; }
        r -= I_OUT;
        if (r < I_UP) { const int kb = r / 128, nb = r % 128; transpose_item(P.in[20] + nb * 32 + (lane & 31), 4096, kb * 64, P.in[19], WUP, 1024, nb * 32, 0, scr, lane); continue; }
        r -= I_UP;
        { const int kb = r / 32, nb = r % 32; transpose_item(P.in[21] + nb * 32 + (lane & 31), 1024, kb * 64, nullptr, WDN, 4096, nb * 32, 0, scr, lane); }
    }
    __syncthreads();
    bf16_t* AALL = (bf16_t*)P.out;
    float* logf = (float*)(ws + WS_LOGF);
    const float* bfv = P.in[4];
    constexpr int RB = 2;
    for (int base = gw * RB; base < M_ + 2048; base += NGW * RB) {
        const bool ismem = base >= M_;
        const float* xb = ismem ? P.in[1] + (size_t)(base - M_) * 1024 : P.in[0] + (size_t)base * 1024;
        const float* gp = ismem ? P.in[9] : P.in[2];
        f32x4 v[RB][4];
#pragma unroll
        for (int r = 0; r < RB; ++r)
#pragma unroll
            for (int j = 0; j < 4; ++j) v[r][j] = ((const f32x4*)(xb + (size_t)r * 1024))[lane + 64 * j];
        float ssq[RB], red[RB];
#pragma unroll
        for (int r = 0; r < RB; ++r) { float s = 0.f;
#pragma unroll
            for (int j = 0; j < 4; ++j) s += (v[r][j][0] * v[r][j][0] + v[r][j][1] * v[r][j][1]) + (v[r][j][2] * v[r][j][2] + v[r][j][3] * v[r][j][3]);
            ssq[r] = s; red[r] = 0.f; }
        if (!ismem) {
            float a[RB][8];
#pragma unroll
            for (int c = 0; c < 8; ++c) {
                f32x4 w[4];
#pragma unroll
                for (int j = 0; j < 4; ++j) w[j] = ((const LAS f32x4*)(wfl + c * 1024))[lane + 64 * j];
#pragma unroll
                for (int r = 0; r < RB; ++r) { float t = 0.f;
#pragma unroll
                    for (int j = 0; j < 4; ++j) t += (v[r][j][0] * w[j][0] + v[r][j][1] * w[j][1]) + (v[r][j][2] * w[j][2] + v[r][j][3] * w[j][3]);
                    a[r][c] = t; }
            }
#pragma unroll
            for (int r = 0; r < RB; ++r) {
                float b4[4], b2[2];
#pragma unroll
                for (int i = 0; i < 4; ++i) { const float keep = (lane & 32) ? a[r][i + 4] : a[r][i], send = (lane & 32) ? a[r][i] : a[r][i + 4]; b4[i] = keep + __shfl_xor(send, 32); }
#pragma unroll
                for (int i = 0; i < 2; ++i) { const float keep = (lane & 16) ? b4[i + 2] : b4[i], send = (lane & 16) ? b4[i] : b4[i + 2]; b2[i] = keep + __shfl_xor(send, 16); }
                { const float keep = (lane & 8) ? b2[1] : b2[0], send = (lane & 8) ? b2[0] : b2[1]; red[r] = keep + __shfl_xor(send, 8); }
            }
#pragma unroll
            for (int o = 4; o >= 1; o >>= 1)
#pragma unroll
                for (int r = 0; r < RB; ++r) red[r] += __shfl_xor(red[r], o);
        }
#pragma unroll
        for (int o = 1; o < 64; o <<= 1)
#pragma unroll
            for (int r = 0; r < RB; ++r) ssq[r] += __shfl_xor(ssq[r], o);
#pragma unroll
        for (int r = 0; r < RB; ++r) {
            const float rstd = 1.0f / sqrtf(ssq[r] * (1.0f / 1024.0f) + EPS_);
#pragma unroll
            for (int j = 0; j < 4; ++j) { const f32x4 g = ((const f32x4*)gp)[lane + 64 * j]; const f32x4 y = v[r][j] * rstd * g;
                u32x2 w; w.x = pk2(y[0], y[1]); w.y = pk2(y[2], y[3]); ((u32x2*)(AALL + (size_t)(base + r) * 1024))[lane + 64 * j] = w; }
            if (!ismem && (lane & 7) == 0) { const int c = lane >> 3; const float z = red[r] * rstd + bfv[c]; logf[(size_t)(base + r) * 8 + c] = fminf(z, 0.f) - log1pf(expf(-fabsf(z))); }
        }
    }
}


#define XB_TMO      128
#define XB_XCNT(j)  (256  + 64 * (j))
#define XB_XSUB(j)  (1280 + 64 * (j))
#define XB_XGEN(j)  (2304 + 64 * (j))
#define XB_TOP      3328
#define XB_TOPGEN   3392
#define XCD_BAR_WORDS 3456
#define XB_SPIN_CAP (1u << 20)
__device__ __forceinline__ unsigned xb_ld(unsigned* p)              { return __hip_atomic_load(p, __ATOMIC_RELAXED, __HIP_MEMORY_SCOPE_AGENT); }
__device__ __forceinline__ unsigned xb_add(unsigned* p, unsigned v) { return __hip_atomic_fetch_add(p, v, __ATOMIC_RELAXED, __HIP_MEMORY_SCOPE_AGENT); }
__device__ __forceinline__ unsigned xb_xcc_id() { return (unsigned)__builtin_amdgcn_s_getreg((3 << 11) | 20) & 0xFu; }
#define XB_SPIN(cond, bar) do { unsigned _sp = 0; while (cond) { __builtin_amdgcn_s_sleep(1); \
    if ((++_sp & 255u) == 0u) { if (xb_ld(&(bar)[XB_TMO])) break; if (_sp > XB_SPIN_CAP) { atomicAdd(&(bar)[XB_TMO], 1u); break; } } } } while (0)
struct XcdBarrier { unsigned* bar; unsigned x; volatile LAS unsigned* st; };
__device__ __forceinline__ XcdBarrier xcd_barrier_post(unsigned* bar, volatile LAS unsigned* st) {
    XcdBarrier b; b.bar = bar; b.x = xb_xcc_id(); b.st = st;
    if (threadIdx.x == 0) (void)xb_add(&bar[XB_XCNT(b.x)], 1u);
    return b;
}
__device__ __forceinline__ void xcd_barrier_complete(unsigned* bar, unsigned x, unsigned& nloc, unsigned& nx) {
    const unsigned G = gridDim.x * gridDim.y * gridDim.z;
    unsigned sum, cnt, mine, sp = 0u;
    for (;;) {
        sum = 0u; cnt = 0u; mine = 0u;
#pragma unroll
        for (unsigned j = 0; j < 16; ++j) { const unsigned c = xb_ld(&bar[XB_XCNT(j)]); sum += c; cnt += (c > 0u) ? 1u : 0u; mine = (j == x) ? c : mine; }
        if (sum == G) break;
        __builtin_amdgcn_s_sleep(1);
        if ((++sp & 255u) == 0u) { if (xb_ld(&bar[XB_TMO])) break; if (sp > XB_SPIN_CAP) { atomicAdd(&bar[XB_TMO], 1u); break; } }
    }
    nloc = mine > 0u ? mine : 1u; nx = cnt > 0u ? cnt : 1u;
}
__device__ __forceinline__ void xcd_barrier(const XcdBarrier& b) {
    asm volatile("s_waitcnt vmcnt(0)" ::: "memory");
    __syncthreads();
    if (threadIdx.x == 0) {
        unsigned* bar = b.bar;
        __builtin_amdgcn_s_waitcnt(0);
        unsigned nloc = b.st[0], nx = b.st[1];
        if (nloc == 0u) { xcd_barrier_complete(bar, b.x, nloc, nx); b.st[0] = nloc; b.st[1] = nx; }
        const unsigned old = xb_add(&bar[XB_XSUB(b.x)], 1u);
        const unsigned gen = old / nloc;
        if (old + 1u == (gen + 1u) * nloc) {
            __builtin_amdgcn_fence(__ATOMIC_RELEASE, "agent");
            asm volatile("s_waitcnt vmcnt(0)" ::: "memory");
            const unsigned og = xb_add(&bar[XB_TOP], 1u);
            const unsigned tg = og / nx;
            if (og + 1u == (tg + 1u) * nx) xb_add(&bar[XB_TOPGEN], 1u);
            else XB_SPIN(xb_ld(&bar[XB_TOPGEN]) == tg, bar);
            __builtin_amdgcn_fence(__ATOMIC_ACQUIRE, "agent");
            xb_add(&bar[XB_XGEN(b.x)], 1u);
            asm volatile("s_waitcnt vmcnt(0)" ::: "memory");
        } else {
            XB_SPIN(xb_ld(&bar[XB_XGEN(b.x)]) == gen, bar);
            __builtin_amdgcn_fence(__ATOMIC_ACQUIRE, "agent");
            asm volatile("s_waitcnt vmcnt(0)" ::: "memory");
        }
    }
    __syncthreads();
}

__global__ void __launch_bounds__(512, 2) mk_fwd(Params P) {
    extern __shared__ __attribute__((aligned(16))) unsigned char lds_raw[];
    LAS unsigned char* lds = (LAS unsigned char*)lds_raw;
    const int G = gridDim.x, bx = blockIdx.x;
    const int vcu = (G % 8 == 0) ? (bx % 8) * (G / 8) + bx / 8 : bx;
    unsigned char* ws = P.ws;
    const int lo = P.ph_lo, hi = P.ph_hi;
#ifndef PHASE_MASK
#define PHASE_MASK 255
#endif
#define IN(k) (((PHASE_MASK >> (k)) & 1) && lo <= (k) && (k) < hi)
#define SEAM(k) do { if (IN(k) && IN((k) + 1)) { if ((k) == 0) cg::this_grid().sync(); else xcd_barrier(xbar); } } while (0)
    volatile LAS unsigned* xst = (volatile LAS unsigned*)(lds + LDS_BYTES - 64);
    if (threadIdx.x < 2) xst[threadIdx.x] = 0u;
    __syncthreads();
    XcdBarrier xbar; xbar.bar = (unsigned*)(ws + WS_BAR); xbar.x = 0; xbar.st = xst;
    if (hi - lo > 1) xbar = xcd_barrier_post((unsigned*)(ws + WS_BAR), xst);
    bf16_t* AALL = (bf16_t*)P.out;
    bf16_t* DIL = (bf16_t*)((unsigned char*)P.out + DO_DIL);
    bf16_t* Y = (bf16_t*)((unsigned char*)P.out + DO_Y);
    float* LSE = (float*)(ws + WS_LSE);
    float* C2 = (float*)(ws + WS_C2);

    if (IN(0)) { p0_prologue(P, lds, vcu, G); }
    SEAM(0);
    if (IN(1)) {
        if (G >= 224 && bx >= G - 64) cumsum_unit(lds, (const float*)(ws + WS_LOGF), C2, bx - (G - 64), P.in[7], P.in[8], (int*)(ws + WS_LO));
        pg8::Gemm g{AALL, (const bf16_t*)(ws + WS_WCAT), 1024, 1024};
        SchedP1 S{G, bx};
        EpiP1 E{(bf16_t*)(ws + WS_QA), (bf16_t*)(ws + WS_KA), (bf16_t*)(ws + WS_VA), (bf16_t*)(ws + WS_QB), (bf16_t*)(ws + WS_KB), (bf16_t*)(ws + WS_VB), (bf16_t*)(ws + WS_QM),
                (bf16_t*)(ws + WS_KM), (bf16_t*)(ws + WS_VM), (unsigned char*)(ws + WS_GATES), (float*)(ws + WS_SSQQ), P.in[5], P.in[6], P.in[7], P.in[8], P.in[14], (const float*)(ws + WS_COS), (const float*)(ws + WS_SIN)};
        pg8::gemm_phase<EpiP1, SchedP1>(lds, g, S, E);
    }
    SEAM(1);
    if (IN(2)) {
        dil_phase(lds, ws, DIL, LSE, bx, G);
        for (int L = bx; L < 32 + 64; L += G) {
            if (L < 32) {
                memnorm_unit(lds, (bf16_t*)(ws + WS_KM) + (size_t)L * 4 * 8192, P.in[12], P.in[11], 1.0f);
            } else if (G < 224) {
                cumsum_unit(lds, (const float*)(ws + WS_LOGF), C2, L - 32, P.in[7], P.in[8], (int*)(ws + WS_LO));
            }
        }
    }
    SEAM(2);
    if (IN(3)) {
        const int* LO = (const int*)(ws + WS_LO); const float smax_fox = ((const float*)LO)[1024];
        for (int i = 0;; ++i) {
            const int L = (i & 1) ? i * G + (G - 1 - bx) : i * G + bx;
            if (i * G >= 2048) break;
            if (L >= 2048) continue;
            if (L < 1024) {
                const int qblk = 15 - (L >> 6), bh = L & 63, b = bh >> 3, h = bh & 7;
                const size_t Rs = (size_t)bh << 12;
                attn_unit<64, 1>(lds, (const bf16_t*)(ws + WS_QB) + Rs * 64, (const bf16_t*)(ws + WS_KB) + Rs * 64, (const bf16_t*)(ws + WS_VB) + Rs * 64, C2 + Rs, qblk,
                                 Y + 256 + h * 64, 1280, b * 4096, 0, nullptr, LO[bh * 16 + qblk], smax_fox);
            } else if (L < 1536) {
                const int u = L - 1024, bh = u >> 4, qblk = u & 15, b = bh >> 2, h = bh & 3;
                attn_unit<128, 2>(lds, (const bf16_t*)(ws + WS_QM) + ((size_t)bh << 12) * 128, (const bf16_t*)(ws + WS_KM) + ((size_t)bh << 8) * 128, (const bf16_t*)(ws + WS_VM) + ((size_t)bh << 8) * 128,
                                  (const float*)(ws + WS_SSQQ) + (size_t)b * 4096 * 4 + h, qblk, Y + 768 + h * 128, 1280, b * 4096, 0, nullptr, 0, 0.f);
            } else {
                merge_unit(DIL, LSE, Y, L - 1536);
            }
        }
    }
    SEAM(3);
    if (IN(4)) {
        pg8::Gemm g{Y, (const bf16_t*)(ws + WS_WBR), 1280, 1280};
        SchedP3 S{G, bx};
        EpiMerge E{(const unsigned char*)(ws + WS_GATES), (bf16_t*)(ws + WS_MERGED)};
        pg8::gemm_phase<EpiMerge, SchedP3>(lds, g, S, E);
    }
    SEAM(4);
    if (IN(5)) {
        pg8::Gemm g{(const bf16_t*)(ws + WS_MERGED), (const bf16_t*)(ws + WS_WOUT), 1024, 1024};
        SchedSimple S{G, bx, 4, 16};
        EpiOut E{P.in[0], P.out, (bf16_t*)(ws + WS_X1B), (float*)(ws + WS_SSQ)};
        pg8::gemm_phase<EpiOut, SchedSimple>(lds, g, S, E);
    }
    SEAM(5);
    if (IN(6)) {
        pg8::Gemm g{(const bf16_t*)(ws + WS_X1B), (const bf16_t*)(ws + WS_WUP), 1024, 1024};
        SchedSimple S{G, bx, 16, 16};
        EpiUp E{(const float*)(ws + WS_SSQ), (bf16_t*)(ws + WS_HMID)};
        pg8::gemm_phase<EpiUp, SchedSimple>(lds, g, S, E);
    }
    SEAM(6);
    if (IN(7)) {
        pg8::Gemm g{(const bf16_t*)(ws + WS_HMID), (const bf16_t*)(ws + WS_WDN), 4096, 4096};
        SchedSimple S{G, bx, 4, 64};
        EpiDown E{P.out, (const bf16_t*)(ws + WS_X1B)};
        pg8::gemm_phase<EpiDown, SchedSimple>(lds, g, S, E);
    }
#undef IN
#undef SEAM
}

extern "C" void kernel_launch(void* const* d_in, const int* in_sizes, int n_in, void* d_out, int out_size, void* d_ws, size_t ws_size, hipStream_t stream) {
    static int grid = 0;
    if (grid == 0) {
        if (n_in != 22 || in_sizes[0] != M_ * DM || out_size != M_ * DM || ws_size < WS_END) {
            fprintf(stderr, "kernel_launch: unexpected shapes (n_in %d, in0 %d, out %d, ws %zu); nothing launched\n", n_in, n_in > 0 ? in_sizes[0] : -1, out_size, ws_size); grid = -1; return; }
        int dev = 0, cus = 0, per_cu = 0;
        if (hipGetDevice(&dev) != hipSuccess || hipDeviceGetAttribute(&cus, hipDeviceAttributeMultiprocessorCount, dev) != hipSuccess) { grid = -1; return; }
        if (hipFuncSetAttribute((const void*)mk_fwd, hipFuncAttributeMaxDynamicSharedMemorySize, LDS_BYTES) != hipSuccess) { fprintf(stderr, "kernel_launch: hipFuncSetAttribute failed\n"); grid = -1; return; }
        if (hipOccupancyMaxActiveBlocksPerMultiprocessor(&per_cu, (const void*)mk_fwd, 512, LDS_BYTES) != hipSuccess || per_cu < 1) { fprintf(stderr, "kernel_launch: occupancy query gave %d\n", per_cu); (void)hipGetLastError(); grid = -1; return; }
        grid = cus * 1;
    }
    if (grid < 0) return;
    if (hipMemsetAsync((char*)d_ws + WS_BAR, 0, WS_BAR_BYTES, stream) != hipSuccess) { fprintf(stderr, "kernel_launch: hipMemsetAsync failed\n"); return; }
    Params p{};
    for (int i = 0; i < 22; ++i) p.in[i] = (const float*)d_in[i];
    p.out = (float*)d_out; p.ws = (unsigned char*)d_ws;
#if MK_MULTI
    for (int ph = 0; ph < NPH; ++ph) { p.ph_lo = ph; p.ph_hi = ph + 1; hipLaunchKernelGGL(mk_fwd, dim3(grid), dim3(512), LDS_BYTES, stream, p); }
#else
    p.ph_lo = 0; p.ph_hi = NPH;
    void* args[] = {&p};
    hipError_t e = hipLaunchCooperativeKernel((const void*)mk_fwd, dim3(grid), dim3(512), args, LDS_BYTES, stream);
    if (e != hipSuccess) fprintf(stderr, "cooperative launch failed: %s (grid %d)\n", hipGetErrorString(e), grid);
#endif
}
```

```cpp
#include <hip/hip_runtime.h>
#include <hip/hip_cooperative_groups.h>
#include <cstdio>
#include <cstdint>
namespace cg = cooperative_groups;

#ifndef MK_MULTI
#define MK_MULTI 0
#endif

#define LAS __attribute__((address_space(3)))
typedef unsigned short bf16_t;
typedef short bf16x8 __attribute__((ext_vector_type(8)));
typedef short s16x4 __attribute__((ext_vector_type(4)));
typedef float f32x4 __attribute__((ext_vector_type(4)));
typedef float f32x16 __attribute__((ext_vector_type(16)));
typedef unsigned u32x4 __attribute__((ext_vector_type(4)));
typedef unsigned u32x2 __attribute__((ext_vector_type(2)));

constexpr int B_ = 8, T_ = 4096, DM = 1024, M_ = B_ * T_;
constexpr int NPH = 8;
constexpr float EPS_ = 1e-6f;
constexpr float LOG2E = 1.4426950408889634f, LN2 = 0.6931471805599453f;
constexpr float QSCALE = 0.125f * LOG2E;
constexpr float QSCALE_M = 0.08838834764831845f * LOG2E;

constexpr size_t MiB = 1u << 20;
constexpr size_t WS_SSQ = 0, WS_COS = 256 * 1024, WS_SIN = 384 * 1024, WS_BAR = 512 * 1024, WS_BAR_BYTES = 16384;
constexpr size_t WS_LOGF = 1 * MiB, WS_C2 = 2 * MiB, WS_LSE = 3 * MiB, WS_LO = 4 * MiB + 768 * 1024;
constexpr size_t WS_WCAT = 5 * MiB, WS_WBR = 22 * MiB, WS_WOUT = 25 * MiB, WS_WUP = 27 * MiB, WS_WDN = 35 * MiB;
constexpr size_t WS_KM = 43 * MiB, WS_VM = 45 * MiB, WS_SSQQ = 47 * MiB;
constexpr size_t WS_QA = 48 * MiB, WS_KA = 96 * MiB, WS_VA = 144 * MiB, WS_QB = 192 * MiB, WS_KB = 224 * MiB, WS_VB = 256 * MiB, WS_QM = 288 * MiB;
constexpr size_t WS_GATES = 320 * MiB, WS_END = 512 * MiB;
constexpr size_t WS_MERGED = 48 * MiB, WS_X1B = 320 * MiB, WS_HMID = 48 * MiB;
constexpr size_t DO_DIL = 0, DO_Y = 48 * MiB;
constexpr int LDS_BYTES = 147456;

struct Params { const float* in[22]; float* out; unsigned char* ws; int ph_lo, ph_hi; };

__device__ __forceinline__ unsigned pk2(float lo, float hi) {
    typedef float f2 __attribute__((ext_vector_type(2))); typedef __bf16 b2 __attribute__((ext_vector_type(2)));
    f2 v = {lo, hi}; b2 b = __builtin_convertvector(v, b2); return __builtin_bit_cast(unsigned, b);
}
__device__ __forceinline__ float bf2f(unsigned short u) { return __uint_as_float(((unsigned)u) << 16); }
__device__ __forceinline__ u32x4 pack8(f32x4 a, f32x4 b) { u32x4 w; w.x = pk2(a[0], a[1]); w.y = pk2(a[2], a[3]); w.z = pk2(b[0], b[1]); w.w = pk2(b[2], b[3]); return w; }
__device__ __forceinline__ void unpack8(u32x4 w, f32x4& a, f32x4& b) {
    a[0] = __uint_as_float(w.x << 16); a[1] = __uint_as_float(w.x & 0xffff0000u); a[2] = __uint_as_float(w.y << 16); a[3] = __uint_as_float(w.y & 0xffff0000u);
    b[0] = __uint_as_float(w.z << 16); b[1] = __uint_as_float(w.z & 0xffff0000u); b[2] = __uint_as_float(w.w << 16); b[3] = __uint_as_float(w.w & 0xffff0000u);
}
__device__ __forceinline__ float sigmoidf_(float x) { return __builtin_amdgcn_rcpf(1.0f + __builtin_amdgcn_exp2f(-x * LOG2E)); }

namespace pg8 {
constexpr int BM = 256, BK = 64, HALF = 128, HTB = HALF * BK * 2, STAGE_BYTES = 8 * HTB, NXCD = 8, WGM = 8;
__host__ __device__ __forceinline__ int lds_byte(int r, int c) { const int st = (r >> 4) * 2 + (c >> 5), rr = r & 15, cc = c & 31, ob = rr * 64 + cc * 2; return st * 1024 + (ob ^ (((ob >> 9) & 1) << 5)); }
__host__ __device__ __forceinline__ void stage_rc(int b, int& R, int& C) { const int st = b / 1024, sb = b % 1024, swz = sb ^ (((sb >> 9) & 1) << 5); R = (st >> 1) * 16 + swz / 64; C = (st & 1) * 32 + (swz % 64) / 2; }
__host__ __device__ __forceinline__ int perm32(int rho) { const int n = rho >> 4, i = rho & 15; return 8 * (i >> 2) + 4 * n + (i & 3); }

struct Unit { int pm, pn, k0, nt, tag, first; };
struct Gemm { const bf16_t* A; const bf16_t* Bt; int lda, ldb; };

__device__ __forceinline__ void tile_order(int L, int nM, int nN, int& pm, int& pn) {
    const int nwg = nM * nN; int wgid = L;
    { const int q = nwg / NXCD, r = nwg % NXCD, xcd = wgid % NXCD, off = wgid / NXCD; wgid = (xcd < r ? xcd * (q + 1) : r * (q + 1) + (xcd - r) * q) + off; }
    const int nig = WGM * nN, gid = wgid / nig, fm = gid * WGM, gsz = (nM - fm) < WGM ? (nM - fm) : WGM;
    pm = fm + ((wgid % nig) % gsz); pn = (wgid % nig) / gsz;
}

template <class Epi, class Sched>
__device__ __forceinline__ void gemm_phase(LAS unsigned char* lds, const Gemm g, const Sched& S, const Epi& E) {
    const int tid = threadIdx.x, wid = __builtin_amdgcn_readfirstlane(tid >> 6), lane = tid & 63, wr = wid >> 2, wc = wid & 3, fr = lane & 15, fq = lane >> 4;
    unsigned voffA[2], voffB[2];
#pragma unroll
    for (int i = 0; i < 2; ++i) { int R, C; stage_rc(tid * 16 + i * 8192, R, C); const int Rb = (R & ~31) + perm32(R & 31);
        voffA[i] = (unsigned)(R * g.lda + C) * 2u; voffB[i] = (unsigned)(Rb * g.ldb + C) * 2u; }
    const size_t kstep = (size_t)(BK * 2);
    const size_t hstepA = (size_t)HALF * g.lda * 2, hstepB = (size_t)HALF * g.ldb * 2, tstepA = 2 * hstepA, tstepB = 2 * hstepB;
    const unsigned ldsw = (unsigned)wid * 1024u;
    const int aoff = lds_byte(wr * 64 + fr, fq * 8), boff = lds_byte(wc * 32 + fr, fq * 8);
#define PG8_SA(b, h) (((b) * 2 + (h)) * HTB)
#define PG8_SB(b, h) ((4 + (b) * 2 + (h)) * HTB)
#define PG8_STAGE(bufoff, gbase, voff) do { _Pragma("unroll") for (int _i = 0; _i < 2; ++_i) \
        __builtin_amdgcn_global_load_lds((const unsigned*)((const char*)(gbase) + (voff)[_i]), (LAS unsigned*)(lds + (bufoff) + ldsw + _i * 8192), 16, 0, 0); } while (0)
#define PG8_LDA(dst, b, h) do { _Pragma("unroll") for (int m = 0; m < 4; ++m) _Pragma("unroll") for (int k = 0; k < 2; ++k) dst[m][k] = *(const LAS bf16x8*)(lds + PG8_SA(b, h) + aoff + m * 2048 + k * 1024); } while (0)
#define PG8_LDB(dst, b, h) do { _Pragma("unroll") for (int n = 0; n < 2; ++n) _Pragma("unroll") for (int k = 0; k < 2; ++k) dst[n][k] = *(const LAS bf16x8*)(lds + PG8_SB(b, h) + boff + n * 2048 + k * 1024); } while (0)
#define PG8_MMA(ai, bj, At, Bt) do { __builtin_amdgcn_s_setprio(1); _Pragma("unroll") for (int m = 0; m < 4; ++m) _Pragma("unroll") for (int n = 0; n < 2; ++n) _Pragma("unroll") for (int k = 0; k < 2; ++k) \
        acc[ai][bj][m][n] = __builtin_amdgcn_mfma_f32_16x16x32_bf16(Bt[n][k], At[m][k], acc[ai][bj][m][n], 0, 0, 0); __builtin_amdgcn_s_setprio(0); } while (0)
#define PG8_WAIT_V(n) asm volatile("s_waitcnt vmcnt(" #n ")" ::: "memory")
#define PG8_WAIT_L(n) asm volatile("s_waitcnt lgkmcnt(" #n ")" ::: "memory")
#define PG8_BAR __builtin_amdgcn_s_barrier()
#define PG8_SCHED __builtin_amdgcn_sched_barrier(0)
    Unit cur, nxt; int ui = 0;
    if (!S.next(0, cur)) return;
    f32x4 acc[2][2][4][2];
#pragma unroll
    for (int a = 0; a < 2; ++a)
#pragma unroll
        for (int b = 0; b < 2; ++b)
#pragma unroll
            for (int m = 0; m < 4; ++m)
#pragma unroll
                for (int n = 0; n < 2; ++n) acc[a][b][m][n] = (f32x4){0.f, 0.f, 0.f, 0.f};
    bf16x8 At[4][2], B0[2][2], B1[2][2];
    const char* cA = (const char*)g.A + (size_t)cur.pm * tstepA + (size_t)cur.k0 * 2; const char* cB = (const char*)g.Bt + (size_t)cur.pn * tstepB + (size_t)cur.k0 * 2;
    PG8_STAGE(PG8_SB(0, 0), cB, voffB); PG8_STAGE(PG8_SB(0, 1), cB + hstepB, voffB); PG8_STAGE(PG8_SA(0, 0), cA, voffA); PG8_STAGE(PG8_SA(0, 1), cA + hstepA, voffA);
    if (wr == 1) PG8_BAR;
    PG8_WAIT_V(2); PG8_BAR;
    PG8_STAGE(PG8_SB(1, 0), cB + kstep, voffB); PG8_STAGE(PG8_SA(1, 0), cA + kstep, voffA); PG8_STAGE(PG8_SB(1, 1), cB + hstepB + kstep, voffB);
    PG8_WAIT_V(6); PG8_BAR;
    for (;;) {
        const bool has_next = S.next(ui + 1, nxt);
        const char* nA = has_next ? (const char*)g.A + (size_t)nxt.pm * tstepA + (size_t)nxt.k0 * 2 : cA; const char* nB = has_next ? (const char*)g.Bt + (size_t)nxt.pn * tstepB + (size_t)nxt.k0 * 2 : cB;
        const int nt = cur.nt;
        for (int t = 0; t < nt; t += 2) {
            const bool last = (t == nt - 2);
            const char* a1 = cA + (size_t)(t + 1) * kstep;
            const char* a2 = last ? nA : cA + (size_t)(t + 2) * kstep; const char* b2 = last ? nB : cB + (size_t)(t + 2) * kstep;
            const char* a3 = a2 + kstep; const char* b3 = b2 + kstep;
            PG8_LDB(B0, 0, 0); PG8_LDB(B1, 0, 1); PG8_SCHED; PG8_LDA(At, 0, 0); PG8_STAGE(PG8_SA(1, 1), a1 + hstepA, voffA);
            PG8_WAIT_V(8); PG8_WAIT_L(0); PG8_BAR; PG8_MMA(0, 0, At, B0); PG8_MMA(0, 1, At, B1); PG8_BAR; PG8_SCHED;
            PG8_LDA(At, 0, 1); PG8_STAGE(PG8_SB(0, 0), b2, voffB); PG8_STAGE(PG8_SB(0, 1), b2 + hstepB, voffB); PG8_STAGE(PG8_SA(0, 0), a2, voffA);
            PG8_WAIT_V(8); PG8_WAIT_L(0); PG8_BAR; PG8_MMA(1, 0, At, B0); PG8_MMA(1, 1, At, B1); PG8_BAR; PG8_SCHED;
            PG8_LDB(B0, 1, 0); PG8_LDB(B1, 1, 1); PG8_SCHED; PG8_LDA(At, 1, 0); PG8_STAGE(PG8_SA(0, 1), a2 + hstepA, voffA);
            PG8_WAIT_V(8); PG8_WAIT_L(0); PG8_BAR; PG8_MMA(0, 0, At, B0); PG8_MMA(0, 1, At, B1); PG8_BAR; PG8_SCHED;
            PG8_LDA(At, 1, 1); PG8_STAGE(PG8_SB(1, 0), b3, voffB); PG8_STAGE(PG8_SB(1, 1), b3 + hstepB, voffB); PG8_STAGE(PG8_SA(1, 0), a3, voffA);
            PG8_WAIT_V(8); PG8_WAIT_L(0); PG8_BAR; PG8_MMA(1, 0, At, B0); PG8_MMA(1, 1, At, B1); PG8_BAR; PG8_SCHED;
        }
        if (wr == 0) PG8_BAR;
        E(acc, cur, wr, wc, fr, fq);
        if (!has_next) break;
        if (nxt.first) {
#pragma unroll
            for (int a = 0; a < 2; ++a)
#pragma unroll
                for (int b = 0; b < 2; ++b)
#pragma unroll
                    for (int m = 0; m < 4; ++m)
#pragma unroll
                        for (int n = 0; n < 2; ++n) acc[a][b][m][n] = (f32x4){0.f, 0.f, 0.f, 0.f};
        }
        cur = nxt; cA = nA; cB = nB; ++ui;
        if (wr == 1) PG8_BAR;
    }
    PG8_WAIT_V(0);
    PG8_BAR;
#undef PG8_SA
#undef PG8_SB
#undef PG8_STAGE
#undef PG8_LDA
#undef PG8_LDB
#undef PG8_MMA
#undef PG8_WAIT_V
#undef PG8_WAIT_L
#undef PG8_BAR
#undef PG8_SCHED
}
}

typedef f32x4 Acc[2][2][4][2];

struct EpiP1 {
    bf16_t *QA, *KA, *VA, *QB, *KB, *VB, *QM, *KM, *VM; unsigned char* GATES8; float* SSQQ;
    const float *g_qA, *g_kA, *g_qB, *g_kB, *b_gate, *cosT, *sinT;

    __device__ __forceinline__ void norm64(Acc& acc, int rowbase, int wc, int fq, const float* gain, float scale, bool rope, bf16_t* base, int hpb, int h, int dl) const {
        const bool dorope = rope && fq < 2;
        const int db0 = dorope ? 4 * fq : 8 * fq, dn = dorope ? 8 : 4;
#pragma unroll
        for (int ai = 0; ai < 2; ++ai)
#pragma unroll
            for (int m = 0; m < 4; ++m) {
                const int mrow = rowbase + ai * 128 + m * 16, b = mrow >> 12, t = mrow & 4095;
                float ss = 0.f;
#pragma unroll
                for (int bj = 0; bj < 2; ++bj)
#pragma unroll
                    for (int n = 0; n < 2; ++n) { const f32x4 x = acc[ai][bj][m][n]; ss += (x[0] * x[0] + x[1] * x[1]) + (x[2] * x[2] + x[3] * x[3]); }
                ss += __shfl_xor(ss, 16); ss += __shfl_xor(ss, 32);
                const float rstd = __builtin_amdgcn_rsqf(ss * (1.0f / 64.0f) + EPS_) * scale;
                f32x4 y[2][2];
#pragma unroll
                for (int n = 0; n < 2; ++n) { y[0][n] = acc[ai][0][m][n] * rstd * *(const f32x4*)(gain + db0 + dn * n); y[1][n] = acc[ai][1][m][n] * rstd * *(const f32x4*)(gain + 32 + 8 * fq + 4 * n); }
                if (dorope) {
                    const f32x4 c4 = *(const f32x4*)(cosT + t * 8 + 4 * fq), s4 = *(const f32x4*)(sinT + t * 8 + 4 * fq);
                    const f32x4 x1 = y[0][0], x2 = y[0][1];
                    y[0][0] = x1 * c4 - x2 * s4; y[0][1] = x2 * c4 + x1 * s4;
                }
                const int r = t & ((1 << dl) - 1), j = t >> dl;
                const int R = ((b * hpb + h) << 12) + (r << (12 - dl)) + j;
                bf16_t* p = base + (size_t)(R >> 6) * 4096 + (R & 63) * 8 + fq * 512;
#pragma unroll
                for (int bj = 0; bj < 2; ++bj) *(u32x4*)(p + bj * 2048) = pack8(y[bj][0], y[bj][1]);
            }
    }
    __device__ __forceinline__ void v64(Acc& acc, int rowbase, int fq, bf16_t* base, int hpb, int h, int dl) const {
#pragma unroll
        for (int ai = 0; ai < 2; ++ai)
#pragma unroll
            for (int m = 0; m < 4; ++m) {
                const int mrow = rowbase + ai * 128 + m * 16, b = mrow >> 12, t = mrow & 4095;
                const int r = t & ((1 << dl) - 1), j = t >> dl;
                const int R = ((b * hpb + h) << 12) + (r << (12 - dl)) + j;
                bf16_t* p = base + (size_t)(R >> 6) * 4096 + (R & 63) * 32 + fq * 8;
#pragma unroll
                for (int bj = 0; bj < 2; ++bj) *(u32x4*)(p + bj * 2048) = pack8(acc[ai][bj][m][0], acc[ai][bj][m][1]);
            }
    }
    __device__ __forceinline__ void raw128(Acc& acc, int rowbase, int wc, int fq, bf16_t* base, int tl, int lg, bool isv, float* ssq) const {
#pragma unroll
        for (int ai = 0; ai < 2; ++ai)
#pragma unroll
            for (int m = 0; m < 4; ++m) {
                const int mrow = rowbase + ai * 128 + m * 16, b = mrow >> lg, t = mrow & ((1 << lg) - 1);
#pragma unroll
                for (int bj = 0; bj < 2; ++bj) {
                    if (ssq) {
                        const f32x4 x0 = acc[ai][bj][m][0], x1 = acc[ai][bj][m][1];
                        float ps = (x0[0] * x0[0] + x0[1] * x0[1]) + (x0[2] * x0[2] + x0[3] * x0[3]) + (x1[0] * x1[0] + x1[1] * x1[1]) + (x1[2] * x1[2] + x1[3] * x1[3]);
                        ps += __shfl_xor(ps, 16); ps += __shfl_xor(ps, 32);
                        if (fq == 0) atomicAdd(ssq + (size_t)mrow * 4 + 2 * tl + bj, ps);
                    }
                    const int R = ((b * 4 + 2 * tl + bj) << lg) + t;
                    bf16_t* p = isv ? base + (size_t)(R >> 6) * 8192 + wc * 2048 + (R & 63) * 32 + fq * 8
                                    : base + (size_t)(R >> 6) * 8192 + (4 * wc + fq) * 512 + (R & 63) * 8;
                    *(u32x4*)p = pack8(acc[ai][bj][m][0], acc[ai][bj][m][1]);
                }
            }
    }
    __device__ __forceinline__ void operator()(Acc& acc, const pg8::Unit& u, int wr, int wc, int fr_in, int fq_in) const {
        int fr = fr_in, fq = fq_in; asm volatile("" : "+v"(fr), "+v"(fq));
        const int pn = u.pn;
        const int rowbase = u.pm * 256 + wr * 64 + fr;
        if (pn < 15) {
            if (pn < 3)       norm64(acc, rowbase, wc, fq, g_qA, QSCALE, true, QA + (size_t)pn * M_ * 256, 4, wc, 2 * pn);
            else if (pn < 6)  norm64(acc, rowbase, wc, fq, g_kA, 1.0f, true, KA + (size_t)(pn - 3) * M_ * 256, 4, wc, 2 * (pn - 3));
            else if (pn < 9)  v64(acc, rowbase, fq, VA + (size_t)(pn - 6) * M_ * 256, 4, wc, 2 * (pn - 6));
            else if (pn < 11) norm64(acc, rowbase, wc, fq, g_qB, QSCALE, false, QB, 8, 4 * (pn - 9) + wc, 0);
            else if (pn < 13) norm64(acc, rowbase, wc, fq, g_kB, 1.0f, false, KB, 8, 4 * (pn - 11) + wc, 0);
            else              v64(acc, rowbase, fq, VB, 8, 4 * (pn - 13) + wc, 0);
        } else if (pn < 17) {
            raw128(acc, rowbase, wc, fq, QM, pn - 15, 12, false, SSQQ);
        } else if (pn < 29) {
            const int colt = (pn - 17) * 256 + wc * 32 + 8 * fq;
            f32x4 bv[2][2];
#pragma unroll
            for (int bj = 0; bj < 2; ++bj)
#pragma unroll
                for (int n = 0; n < 2; ++n) bv[bj][n] = *(const f32x4*)(b_gate + colt + bj * 128 + 4 * n);
            const int lane_ = fr + 16 * fq, wid_ = wr * 4 + wc;
#pragma unroll
            for (int ai = 0; ai < 2; ++ai)
#pragma unroll
                for (int m = 0; m < 4; ++m) {
                    u32x4 w;
#pragma unroll
                    for (int bj = 0; bj < 2; ++bj)
#pragma unroll
                        for (int n = 0; n < 2; ++n) {
                            const f32x4 v = acc[ai][bj][m][n] + bv[bj][n]; unsigned pk = 0;
#pragma unroll
                            for (int e = 0; e < 4; ++e) { unsigned q = (unsigned)(sigmoidf_(v[e]) * 255.0f + 0.5f); q = q < 1u ? 1u : q; pk |= q << (8 * e); }
                            w[bj * 2 + n] = pk;
                        }
                    *(u32x4*)(GATES8 + ((((((size_t)u.pm * 12 + (pn - 17)) * 2 + ai) * 4 + m) * 8 + wid_) * 64 + lane_) * 16) = w;
                }
        } else {
            const int rb = rowbase - M_;
            if (pn < 31) raw128(acc, rb, wc, fq, KM, pn - 29, 8, false, nullptr);
            else         raw128(acc, rb, wc, fq, VM, pn - 31, 8, true, nullptr);
        }
    }
};

struct EpiMerge {
    const unsigned char* GATES8; bf16_t* MERGED;
    __device__ __forceinline__ void operator()(Acc& acc, const pg8::Unit& u, int wr, int wc, int fr_in, int fq_in) const {
        int fr = fr_in, fq = fq_in; asm volatile("" : "+v"(fr), "+v"(fq));
        const int rowbase = u.pm * 256 + wr * 64 + fr, col = u.pn * 256 + wc * 32 + 8 * fq, br = u.tag;
        const int lane_ = fr + 16 * fq, wid_ = wr * 4 + wc;
#pragma unroll
        for (int ai = 0; ai < 2; ++ai)
#pragma unroll
            for (int m = 0; m < 4; ++m) {
                const size_t frag = (((size_t)ai * 4 + m) * 8 + wid_) * 64 + lane_;
                const u32x4 gn = *(const u32x4*)(GATES8 + ((((size_t)u.pm * 12 + br * 4 + u.pn) * 8) * 512 + frag) * 16);
                if (br < 2) {
                    const u32x4 gd = *(const u32x4*)(GATES8 + ((((size_t)u.pm * 12 + (br + 1) * 4 + u.pn) * 8) * 512 + frag) * 16);
#pragma unroll
                    for (int bj = 0; bj < 2; ++bj)
#pragma unroll
                        for (int n = 0; n < 2; ++n)
#pragma unroll
                            for (int e = 0; e < 4; ++e)
                                acc[ai][bj][m][n][e] *= (float)((gn[bj * 2 + n] >> (8 * e)) & 0xffu) * __builtin_amdgcn_rcpf((float)((gd[bj * 2 + n] >> (8 * e)) & 0xffu));
                } else {
                    const int row = rowbase + ai * 128 + m * 16;
#pragma unroll
                    for (int bj = 0; bj < 2; ++bj) {
                        f32x4 o[2];
#pragma unroll
                        for (int n = 0; n < 2; ++n)
#pragma unroll
                            for (int e = 0; e < 4; ++e) o[n][e] = acc[ai][bj][m][n][e] * ((float)((gn[bj * 2 + n] >> (8 * e)) & 0xffu) * (1.0f / 255.0f));
                        *(u32x4*)(MERGED + (size_t)row * 1024 + col + bj * 128) = pack8(o[0], o[1]);
                    }
                }
            }
    }
};
struct EpiOut {
    const float* X; float* OUT; bf16_t* X1B; float* SSQ;
    __device__ __forceinline__ void operator()(Acc& acc, const pg8::Unit& u, int wr, int wc, int fr_in, int fq_in) const {
        int fr = fr_in, fq = fq_in; asm volatile("" : "+v"(fr), "+v"(fq));
        const int rowbase = u.pm * 256 + wr * 64 + fr, col = u.pn * 256 + wc * 32 + 8 * fq;
#pragma unroll
        for (int ai = 0; ai < 2; ++ai)
#pragma unroll
            for (int m = 0; m < 4; ++m) {
                const int row = rowbase + ai * 128 + m * 16; const size_t off = (size_t)row * 1024 + col;
                float ss = 0.f;
#pragma unroll
                for (int bj = 0; bj < 2; ++bj) {
                    const f32x4 x0 = *(const f32x4*)(X + off + bj * 128), x1 = *(const f32x4*)(X + off + bj * 128 + 4);
                    const f32x4 v0 = acc[ai][bj][m][0] + x0, v1 = acc[ai][bj][m][1] + x1;
                    *(u32x4*)(X1B + off + bj * 128) = pack8(v0, v1);
                    ss += (v0[0] * v0[0] + v0[1] * v0[1]) + (v0[2] * v0[2] + v0[3] * v0[3]) + (v1[0] * v1[0] + v1[1] * v1[1]) + (v1[2] * v1[2] + v1[3] * v1[3]);
                }
                ss += __shfl_xor(ss, 16); ss += __shfl_xor(ss, 32);
                if (fq == 0) atomicAdd(SSQ + row, ss);
            }
    }
};
struct EpiUp {
    const float* SSQ; bf16_t* HMID;
    __device__ __forceinline__ void operator()(Acc& acc, const pg8::Unit& u, int wr, int wc, int fr_in, int fq_in) const {
        int fr = fr_in, fq = fq_in; asm volatile("" : "+v"(fr), "+v"(fq));
        const int rowbase = u.pm * 256 + wr * 64 + fr, col = u.pn * 256 + wc * 32 + 8 * fq;
#pragma unroll
        for (int ai = 0; ai < 2; ++ai)
#pragma unroll
            for (int m = 0; m < 4; ++m) {
                const int row = rowbase + ai * 128 + m * 16;
                const float rstd = __builtin_amdgcn_rsqf(SSQ[row] * (1.0f / 1024.0f) + EPS_);
#pragma unroll
                for (int bj = 0; bj < 2; ++bj) {
                    f32x4 v0 = acc[ai][bj][m][0] * rstd, v1 = acc[ai][bj][m][1] * rstd;
#pragma unroll
                    for (int e = 0; e < 4; ++e) { const float a = fmaxf(v0[e], 0.f), b = fmaxf(v1[e], 0.f); v0[e] = a * a; v1[e] = b * b; }
                    *(u32x4*)(HMID + (size_t)row * 4096 + col + bj * 128) = pack8(v0, v1);
                }
            }
    }
};
struct EpiDown {
    float* OUT; const bf16_t* X1B;
    __device__ __forceinline__ void operator()(Acc& acc, const pg8::Unit& u, int wr, int wc, int fr_in, int fq_in) const {
        int fr = fr_in, fq = fq_in; asm volatile("" : "+v"(fr), "+v"(fq));
        const int rowbase = u.pm * 256 + wr * 64 + fr, col = u.pn * 256 + wc * 32 + 8 * fq;
#pragma unroll
        for (int ai = 0; ai < 2; ++ai)
#pragma unroll
            for (int m = 0; m < 4; ++m) {
                const size_t off = (size_t)(rowbase + ai * 128 + m * 16) * 1024 + col;
#pragma unroll
                for (int bj = 0; bj < 2; ++bj) {
                    f32x4 x0, x1; unpack8(*(const u32x4*)(X1B + off + bj * 128), x0, x1);
                    *(f32x4*)(OUT + off + bj * 128) = acc[ai][bj][m][0] + x0; *(f32x4*)(OUT + off + bj * 128 + 4) = acc[ai][bj][m][1] + x1;
                }
            }
    }
};

struct SchedP1 { int G, c;
    __device__ __forceinline__ bool next(int i, pg8::Unit& u) const {
        const int L = i * G + c;
        if (L < 3712) pg8::tile_order(L, 128, 29, u.pm, u.pn);
        else if (L < 3744) { const int idx = L - 3712; u.pm = 128 + (idx >> 2); u.pn = 29 + (idx & 3); }
        else return false;
        u.k0 = 0; u.nt = 16; u.tag = 0; u.first = 1; return true; } };
struct SchedSimple { int G, c, nN, nt;
    __device__ __forceinline__ bool next(int i, pg8::Unit& u) const {
        const int L = i * G + c; if (L >= 128 * nN) return false;
        pg8::tile_order(L, 128, nN, u.pm, u.pn); u.k0 = 0; u.nt = nt; u.tag = 0; u.first = 1; return true; } };
struct SchedP3 { int G, c;
    __device__ __forceinline__ bool next(int i, pg8::Unit& u) const {
        const int ti = i / 3, br = i - 3 * ti; const int L = ti * G + c; if (L >= 512) return false;
        pg8::tile_order(L, 128, 4, u.pm, u.pn); u.k0 = (br == 0) ? 0 : (br == 1 ? 256 : 768); u.nt = (br == 0) ? 4 : 8; u.tag = br; u.first = (br == 0); return true; } };

__device__ __forceinline__ float max3f(float a, float b, float c) { float r; asm("v_max3_f32 %0, %1, %2, %3" : "=v"(r) : "v"(a), "v"(b), "v"(c)); return r; }
__device__ __forceinline__ float max2f(float a, float b) { float r; asm("v_max_f32_e32 %0, %1, %2" : "=v"(r) : "v"(a), "v"(b)); return r; }
__device__ __forceinline__ float halfmax(float m) { auto rr = __builtin_amdgcn_permlane32_swap(__float_as_uint(m), __float_as_uint(m), false, false); return max2f(__uint_as_float(rr[0]), __uint_as_float(rr[1])); }
__device__ __forceinline__ float halfsum(float m) { auto rr = __builtin_amdgcn_permlane32_swap(__float_as_uint(m), __float_as_uint(m), false, false); return __uint_as_float(rr[0]) + __uint_as_float(rr[1]); }
__device__ __forceinline__ float rowmax32(f32x16& p0, f32x16& p1) {
    asm volatile("s_nop 15\n\ts_nop 7" : "+v"(p0), "+v"(p1));
    float a = max3f(p0[0], p0[1], p1[0]), b = max3f(p0[2], p0[3], p1[1]); a = max3f(a, p1[2], p1[3]);
#pragma unroll
    for (int r = 4; r < 16; r += 4) { a = max3f(a, p0[r], p0[r + 1]); b = max3f(b, p0[r + 2], p0[r + 3]); a = max3f(a, p1[r], p1[r + 1]); b = max3f(b, p1[r + 2], p1[r + 3]); }
    return halfmax(max2f(a, b));
}

template <int D, int MODE>
__device__ __forceinline__ void attn_unit(LAS unsigned char* lds, const bf16_t* __restrict__ Qs, const bf16_t* __restrict__ Ks, const bf16_t* __restrict__ Vs,
                                          const float* __restrict__ c2s, int qblk, bf16_t* out, int opitch, int orow0, int odl, float* lse, int fox_lo, float smax) {
    constexpr int TB = 128 * D, NP = TB / 16 / 512, KS = D / 16, DB = D / 32, TE = 64 * D;
    constexpr int TPS = (D == 64) ? 2 : 1;
    constexpr int OFF_V = 2 * TPS * TB, OFF_C = 4 * TPS * TB, OFF_O = OFF_C + 2 * TPS * 256, PITCH = 2 * D + 16;
    const int tid = threadIdx.x, lane = tid & 63, wid = __builtin_amdgcn_readfirstlane(tid >> 6), r32 = lane & 31, hi = lane >> 5;
    const int jw = qblk * 256 + 32 * wid;
    int kt_lo = 0, kt_hi = 4;
    if (MODE == 0) { kt_lo = 4 * qblk - 2; if (kt_lo < 0) kt_lo = 0; kt_hi = 4 * qblk + 4; }
    if (MODE == 1) { kt_hi = 4 * qblk + 4; kt_lo = fox_lo; }
    const int ntile = kt_hi - kt_lo, nstep = (ntile + TPS - 1) / TPS;
#define KT(i) ((MODE == 1) ? (kt_hi - 1 - (i)) : (kt_lo + (i)))
    bf16x8 qf[KS];
    { const bf16_t* qp = Qs + (size_t)(jw >> 6) * TE + ((jw & 63) + r32) * 8 + hi * 512;
#pragma unroll
      for (int ks = 0; ks < KS; ++ks) qf[ks] = *(const bf16x8*)(qp + ks * 1024); }
    float cq = 0.f; if (MODE == 1) cq = c2s[jw + r32];
    float rq = 1.f; if (MODE == 2) rq = __builtin_amdgcn_rsqf(c2s[(size_t)(jw + r32) * 4] * (1.0f / 128.0f) + EPS_) * QSCALE_M;
    f32x16 o[DB];
#pragma unroll
    for (int d = 0; d < DB; ++d)
#pragma unroll
        for (int i = 0; i < 16; ++i) o[d][i] = 0.f;
    float mrun = (MODE == 1) ? 0.f : -1e30f, lrun = 0.f; bool started = false; (void)started;
    u32x4 kr[TPS][NP], vr[TPS][NP]; f32x4 cr[TPS];
#pragma unroll
    for (int sb = 0; sb < TPS; ++sb) cr[sb] = (f32x4){0.f, 0.f, 0.f, 0.f};
#define ATT_GLOAD(st_) do { _Pragma("unroll") for (int sb_ = 0; sb_ < TPS; ++sb_) { const int i_ = (st_) * TPS + sb_; if (i_ < ntile) { const int kt_ = KT(i_); \
        const u32x4* kp_ = (const u32x4*)(Ks + (size_t)kt_ * TE) + tid; const u32x4* vp_ = (const u32x4*)(Vs + (size_t)kt_ * TE) + tid; \
        _Pragma("unroll") for (int p_ = 0; p_ < NP; ++p_) { kr[sb_][p_] = kp_[p_ * 512]; vr[sb_][p_] = vp_[p_ * 512]; } \
        if (MODE == 1) { if (tid < 16) cr[sb_] = ((const f32x4*)(c2s + kt_ * 64))[tid]; } } } } while (0)
    constexpr int OFF_F = OFF_O + 8 * 32 * PITCH;
    if (MODE == 1) { if (lane == 0) ((LAS unsigned*)(lds + OFF_F))[wid] = 0u; }
    ATT_GLOAD(0);
    for (int st = 0; st < nstep; ++st) {
#pragma unroll
        for (int sb = 0; sb < TPS; ++sb) { const int slot = (st & 1) * TPS + sb;
          LAS u32x4* kd = (LAS u32x4*)(lds + slot * TB) + tid; LAS u32x4* vd = (LAS u32x4*)(lds + OFF_V + slot * TB) + tid;
#pragma unroll
          for (int p = 0; p < NP; ++p) { kd[p * 512] = kr[sb][p]; vd[p * 512] = vr[sb][p]; }
          if (MODE == 1) { if (tid < 16) ((LAS f32x4*)(lds + OFF_C + slot * 256))[tid] = cr[sb]; } }
        __syncthreads();
        if (MODE == 1) {
            const u32x4 f0 = ((const LAS u32x4*)(lds + OFF_F))[0], f1 = ((const LAS u32x4*)(lds + OFF_F))[1];
            if ((f0.x & f0.y & f0.z & f0.w & f1.x & f1.y & f1.z & f1.w) != 0u) break;
        }
        if (st + 1 < nstep) ATT_GLOAD(st + 1);
#pragma unroll
      for (int sb = 0; sb < TPS; ++sb) {
        const int it = st * TPS + sb; if (it >= ntile) break;
        const int kt = KT(it);
        const int buf = (st & 1) * TPS + sb;
        bool active = true;
        if (MODE == 0) active = (kt * 64 + 63 >= jw - 128) && (kt * 64 <= jw + 31);
        if (MODE == 1) {
            active = (kt * 64 <= jw + 31);
            if (active) { const float cend = ((const LAS float*)(lds + OFF_C + buf * 256))[63];
                active = !started || __builtin_amdgcn_ballot_w64(smax + cq - cend - mrun >= -135.0f) != 0;
                if (!active) { if (lane == 0) ((LAS unsigned*)(lds + OFF_F))[wid] = 1u; } }
        }
        if (active) {
            f32x16 s0, s1;
            if (MODE == 1) {
                const LAS f32x4* cb = (const LAS f32x4*)(lds + OFF_C + buf * 256);
                const float cqm = cq - mrun;
#pragma unroll
                for (int i4 = 0; i4 < 4; ++i4) { const f32x4 c0 = cb[2 * i4 + hi], c1 = cb[8 + 2 * i4 + hi];
#pragma unroll
                    for (int e = 0; e < 4; ++e) { s0[4 * i4 + e] = cqm - c0[e]; s1[4 * i4 + e] = cqm - c1[e]; } }
            } else {
#pragma unroll
                for (int i = 0; i < 16; ++i) { s0[i] = 0.f; s1[i] = 0.f; }
            }
            const LAS unsigned char* kb = lds + buf * TB + hi * 1024 + r32 * 16;
#pragma unroll
            for (int ks = 0; ks < KS; ++ks) {
                const bf16x8 a0 = *(const LAS bf16x8*)(kb + ks * 2048), a1 = *(const LAS bf16x8*)(kb + ks * 2048 + 512);
                s0 = __builtin_amdgcn_mfma_f32_32x32x16_bf16(a0, qf[ks], s0, 0, 0, 0);
                s1 = __builtin_amdgcn_mfma_f32_32x32x16_bf16(a1, qf[ks], s1, 0, 0, 0);
            }
            if (MODE == 2) {
#pragma unroll
                for (int i = 0; i < 16; ++i) { s0[i] *= rq; s1[i] *= rq; }
            }
            const int q = jw + r32, key0 = kt * 64 + 4 * hi;
            if (MODE == 0) {
#pragma unroll
                for (int i = 0; i < 16; ++i) { const int key = key0 + 8 * (i >> 2) + (i & 3);
                    if (key > q || key < q - 128) s0[i] = -INFINITY;
                    if (key + 32 > q || key + 32 < q - 128) s1[i] = -INFINITY; }
            }
            if (MODE == 1) {
                if (kt * 64 + 63 > jw) {
#pragma unroll
                    for (int i = 0; i < 16; ++i) { const int key = key0 + 8 * (i >> 2) + (i & 3);
                        if (key > q) s0[i] = -INFINITY;
                        if (key + 32 > q) s1[i] = -INFINITY; }
                }
            }
            const float mx = rowmax32(s0, s1);
            float rs = 0.f;
            if (MODE == 1) {
                if (!started) {
                    started = true; mrun = mx;
#pragma unroll
                    for (int i = 0; i < 16; ++i) { s0[i] -= mx; s1[i] -= mx; }
                } else if (__builtin_amdgcn_ballot_w64(mx > 0.f) != 0) {
                    const float dl = max2f(mx, 0.f), alpha = __builtin_amdgcn_exp2f(-dl);
                    mrun += dl; lrun *= alpha;
#pragma unroll
                    for (int i = 0; i < 16; ++i) { s0[i] -= dl; s1[i] -= dl; }
#pragma unroll
                    for (int d = 0; d < DB; ++d)
#pragma unroll
                        for (int i = 0; i < 16; ++i) o[d][i] *= alpha;
                }
#pragma unroll
                for (int i = 0; i < 16; ++i) { s0[i] = __builtin_amdgcn_exp2f(s0[i]); s1[i] = __builtin_amdgcn_exp2f(s1[i]); rs += s0[i] + s1[i]; }
            } else {
                const float mnew = max2f(mrun, mx);
                if (__builtin_amdgcn_ballot_w64(mnew > mrun) != 0) {
                    const float alpha = __builtin_amdgcn_exp2f(mrun - mnew);
                    lrun *= alpha;
#pragma unroll
                    for (int d = 0; d < DB; ++d)
#pragma unroll
                        for (int i = 0; i < 16; ++i) o[d][i] *= alpha;
                }
                mrun = mnew;
#pragma unroll
                for (int i = 0; i < 16; ++i) { s0[i] = __builtin_amdgcn_exp2f(s0[i] - mnew); s1[i] = __builtin_amdgcn_exp2f(s1[i] - mnew); rs += s0[i] + s1[i]; }
            }
            lrun += rs;
            u32x4 pw[4];
            pw[0] = (u32x4){pk2(s0[0], s0[1]), pk2(s0[2], s0[3]), pk2(s0[4], s0[5]), pk2(s0[6], s0[7])};
            pw[1] = (u32x4){pk2(s0[8], s0[9]), pk2(s0[10], s0[11]), pk2(s0[12], s0[13]), pk2(s0[14], s0[15])};
            pw[2] = (u32x4){pk2(s1[0], s1[1]), pk2(s1[2], s1[3]), pk2(s1[4], s1[5]), pk2(s1[6], s1[7])};
            pw[3] = (u32x4){pk2(s1[8], s1[9]), pk2(s1[10], s1[11]), pk2(s1[12], s1[13]), pk2(s1[14], s1[15])};
            const LAS unsigned char* vb = lds + OFF_V + buf * TB + ((lane >> 4) & 1) * 32 + (lane & 3) * 8 + (4 * hi + ((lane & 15) >> 2)) * 64;
#pragma unroll
            for (int d = 0; d < DB; ++d)
#pragma unroll
                for (int kk = 0; kk < 4; ++kk) {
                    typedef short v4i16_t __attribute__((ext_vector_type(4)));
                    const s16x4 lo = __builtin_bit_cast(s16x4, __builtin_amdgcn_ds_read_tr16_b64_v4i16((LAS v4i16_t*)(vb + d * 4096 + kk * 1024)));
                    const s16x4 hh = __builtin_bit_cast(s16x4, __builtin_amdgcn_ds_read_tr16_b64_v4i16((LAS v4i16_t*)(vb + d * 4096 + kk * 1024 + 512)));
                    const bf16x8 vf = (bf16x8){lo[0], lo[1], lo[2], lo[3], hh[0], hh[1], hh[2], hh[3]};
                    o[d] = __builtin_amdgcn_mfma_f32_32x32x16_bf16(vf, __builtin_bit_cast(bf16x8, pw[kk]), o[d], 0, 0, 0);
                }
        }
      }
    }
#undef ATT_GLOAD
#undef KT
    lrun = halfsum(lrun);
    const float inv = 1.0f / lrun;
    if (MODE == 0) { if (hi == 0) lse[(size_t)(orow0 + ((jw + r32) << odl)) * 4] = (mrun + __builtin_amdgcn_logf(lrun)) * LN2; }
    LAS unsigned char* stw = lds + OFF_O + wid * (32 * PITCH);
#pragma unroll
    for (int d = 0; d < DB; ++d)
#pragma unroll
        for (int i4 = 0; i4 < 4; ++i4) {
            u32x2 w; w.x = pk2(o[d][4 * i4] * inv, o[d][4 * i4 + 1] * inv); w.y = pk2(o[d][4 * i4 + 2] * inv, o[d][4 * i4 + 3] * inv);
            *(LAS u32x2*)(stw + r32 * PITCH + (32 * d + 8 * i4 + 4 * hi) * 2) = w;
        }
    constexpr int LPR = D / 8, RPI = 64 / LPR;
#pragma unroll
    for (int it = 0; it < 32 / RPI; ++it) {
        const int row = it * RPI + lane / LPR, ch = lane % LPR;
        const u32x4 v = *(const LAS u32x4*)(stw + row * PITCH + ch * 16);
        const int mrow = orow0 + ((jw + row) << odl);
        *(u32x4*)(out + (size_t)mrow * opitch + ch * 8) = v;
    }
    __syncthreads();
}

struct DilUnit { const bf16_t *Qs, *Ks, *Vs; bf16_t* out; float* lse; int qblk, orow0, odl; };
__device__ __forceinline__ void dil_decode(unsigned char* ws, bf16_t* DIL, float* LSE, int L, DilUnit& u) {
    const int gi = L / 512, rem = L % 512, bh = rem >> 4, rj = rem & 15, b = bh >> 2, h = bh & 3;
    const int dl = 2 * gi, qpb = 16 >> dl;
    const int r = rj / qpb; u.qblk = rj % qpb;
    const size_t Rs = ((size_t)(b * 4 + h) << 12) + ((size_t)r << (12 - dl));
    u.Qs = (const bf16_t*)(ws + WS_QA) + (size_t)gi * M_ * 256 + Rs * 64;
    u.Ks = (const bf16_t*)(ws + WS_KA) + (size_t)gi * M_ * 256 + Rs * 64;
    u.Vs = (const bf16_t*)(ws + WS_VA) + (size_t)gi * M_ * 256 + Rs * 64;
    u.out = DIL + (size_t)gi * M_ * 256 + h * 64; u.lse = LSE + (size_t)gi * M_ * 4 + h; u.orow0 = b * 4096 + r; u.odl = dl;
}
__device__ __forceinline__ void dil_phase(LAS unsigned char* lds, unsigned char* ws, bf16_t* DIL, float* LSE, int bx, int G) {
    constexpr int TB = 8192, TE = 4096, OFF_V = 6 * TB, OFF_O = 12 * TB, PITCH = 144;
    typedef short v4i16_t __attribute__((ext_vector_type(4)));
    int tid = threadIdx.x; asm volatile("" : "+v"(tid));
    const int lane = tid & 63, wid = __builtin_amdgcn_readfirstlane(tid >> 6), r32 = lane & 31, hi = lane >> 5;
    if (bx >= 1536) return;
    DilUnit cur, nxt; dil_decode(ws, DIL, LSE, bx, cur);
    u32x4 kr[6], vr[6]; bf16x8 qn[4];
#define DIL_LOAD(U) do { const int t0_ = 4 * (U).qblk - 2; \
        _Pragma("unroll") for (int s_ = 0; s_ < 6; ++s_) { if (t0_ + s_ >= 0) { kr[s_] = ((const u32x4*)((U).Ks + (size_t)(t0_ + s_) * TE))[tid]; vr[s_] = ((const u32x4*)((U).Vs + (size_t)(t0_ + s_) * TE))[tid]; } } \
        const int jw_ = (U).qblk * 256 + 32 * wid; const bf16_t* qp_ = (U).Qs + (size_t)(jw_ >> 6) * TE + ((jw_ & 63) + r32) * 8 + hi * 512; \
        _Pragma("unroll") for (int ks = 0; ks < 4; ++ks) qn[ks] = *(const bf16x8*)(qp_ + ks * 1024); } while (0)
#pragma unroll
    for (int s = 0; s < 6; ++s) { kr[s] = (u32x4){0u, 0u, 0u, 0u}; vr[s] = (u32x4){0u, 0u, 0u, 0u}; }
    DIL_LOAD(cur);
    for (int L = bx; L < 1536; L += G) {
        const bool has_next = (L + G < 1536);
        if (has_next) dil_decode(ws, DIL, LSE, L + G, nxt);
#pragma unroll
        for (int s = 0; s < 6; ++s) { ((LAS u32x4*)(lds + s * TB))[tid] = kr[s]; ((LAS u32x4*)(lds + OFF_V + s * TB))[tid] = vr[s]; }
        bf16x8 qf[4];
#pragma unroll
        for (int ks = 0; ks < 4; ++ks) qf[ks] = qn[ks];
        __syncthreads();
        if (has_next) DIL_LOAD(nxt);
        const int jw = cur.qblk * 256 + 32 * wid, q = jw + r32, t0 = 4 * cur.qblk - 2;
        int kfirst = (jw - 128) >> 6; if (kfirst < 0) kfirst = 0;
        const int klast = (jw + 31) >> 6;
        f32x16 o[2];
#pragma unroll
        for (int d = 0; d < 2; ++d)
#pragma unroll
            for (int i = 0; i < 16; ++i) o[d][i] = 0.f;
        float mrun = -1e30f, lrun = 0.f;
        for (int kt = kfirst; kt <= klast; ++kt) {
            const int slot = kt - t0;
            f32x16 s0, s1;
#pragma unroll
            for (int i = 0; i < 16; ++i) { s0[i] = 0.f; s1[i] = 0.f; }
            const LAS unsigned char* kb = lds + slot * TB + hi * 1024 + r32 * 16;
#pragma unroll
            for (int ks = 0; ks < 4; ++ks) {
                const bf16x8 a0 = *(const LAS bf16x8*)(kb + ks * 2048), a1 = *(const LAS bf16x8*)(kb + ks * 2048 + 512);
                s0 = __builtin_amdgcn_mfma_f32_32x32x16_bf16(a0, qf[ks], s0, 0, 0, 0);
                s1 = __builtin_amdgcn_mfma_f32_32x32x16_bf16(a1, qf[ks], s1, 0, 0, 0);
            }
            const int key0 = kt * 64 + 4 * hi;
#pragma unroll
            for (int i = 0; i < 16; ++i) { const int key = key0 + 8 * (i >> 2) + (i & 3);
                if (key > q || key < q - 128) s0[i] = -INFINITY;
                if (key + 32 > q || key + 32 < q - 128) s1[i] = -INFINITY; }
            const float mx = rowmax32(s0, s1);
            const float mnew = max2f(mrun, mx);
            if (__builtin_amdgcn_ballot_w64(mnew > mrun) != 0) {
                const float alpha = __builtin_amdgcn_exp2f(mrun - mnew);
                lrun *= alpha;
#pragma unroll
                for (int d = 0; d < 2; ++d)
#pragma unroll
                    for (int i = 0; i < 16; ++i) o[d][i] *= alpha;
            }
            mrun = mnew;
            float rs = 0.f;
#pragma unroll
            for (int i = 0; i < 16; ++i) { s0[i] = __builtin_amdgcn_exp2f(s0[i] - mnew); s1[i] = __builtin_amdgcn_exp2f(s1[i] - mnew); rs += s0[i] + s1[i]; }
            lrun += rs;
            u32x4 pw[4];
            pw[0] = (u32x4){pk2(s0[0], s0[1]), pk2(s0[2], s0[3]), pk2(s0[4], s0[5]), pk2(s0[6], s0[7])};
            pw[1] = (u32x4){pk2(s0[8], s0[9]), pk2(s0[10], s0[11]), pk2(s0[12], s0[13]), pk2(s0[14], s0[15])};
            pw[2] = (u32x4){pk2(s1[0], s1[1]), pk2(s1[2], s1[3]), pk2(s1[4], s1[5]), pk2(s1[6], s1[7])};
            pw[3] = (u32x4){pk2(s1[8], s1[9]), pk2(s1[10], s1[11]), pk2(s1[12], s1[13]), pk2(s1[14], s1[15])};
            const LAS unsigned char* vb = lds + OFF_V + slot * TB + ((lane >> 4) & 1) * 32 + (lane & 3) * 8 + (4 * hi + ((lane & 15) >> 2)) * 64;
#pragma unroll
            for (int d = 0; d < 2; ++d)
#pragma unroll
                for (int kk = 0; kk < 4; ++kk) {
                    const s16x4 lo = __builtin_bit_cast(s16x4, __builtin_amdgcn_ds_read_tr16_b64_v4i16((LAS v4i16_t*)(vb + d * 4096 + kk * 1024)));
                    const s16x4 hh = __builtin_bit_cast(s16x4, __builtin_amdgcn_ds_read_tr16_b64_v4i16((LAS v4i16_t*)(vb + d * 4096 + kk * 1024 + 512)));
                    const bf16x8 vf = (bf16x8){lo[0], lo[1], lo[2], lo[3], hh[0], hh[1], hh[2], hh[3]};
                    o[d] = __builtin_amdgcn_mfma_f32_32x32x16_bf16(vf, __builtin_bit_cast(bf16x8, pw[kk]), o[d], 0, 0, 0);
                }
        }
        lrun = halfsum(lrun);
        const float inv = 1.0f / lrun;
        if (hi == 0) cur.lse[(size_t)(cur.orow0 + ((jw + r32) << cur.odl)) * 4] = (mrun + __builtin_amdgcn_logf(lrun)) * LN2;
        LAS unsigned char* stw = lds + OFF_O + wid * (32 * PITCH);
#pragma unroll
        for (int d = 0; d < 2; ++d)
#pragma unroll
            for (int i4 = 0; i4 < 4; ++i4) {
                u32x2 w; w.x = pk2(o[d][4 * i4] * inv, o[d][4 * i4 + 1] * inv); w.y = pk2(o[d][4 * i4 + 2] * inv, o[d][4 * i4 + 3] * inv);
                *(LAS u32x2*)(stw + r32 * PITCH + (32 * d + 8 * i4 + 4 * hi) * 2) = w;
            }
#pragma unroll
        for (int it = 0; it < 4; ++it) {
            const int row = it * 8 + (lane >> 3), ch = lane & 7;
            const u32x4 v = *(const LAS u32x4*)(stw + row * PITCH + ch * 16);
            const int mrow = cur.orow0 + ((jw + row) << cur.odl);
            *(u32x4*)(cur.out + (size_t)mrow * 256 + ch * 8) = v;
        }
        __syncthreads();
        cur = nxt;
    }
#undef DIL_LOAD
}

__device__ __forceinline__ void memnorm_unit(LAS unsigned char* lds, bf16_t* tiles, const float* gain, const float* gain2, float scale) {
    int tid = threadIdx.x; asm volatile("" : "+v"(tid));
    const int lane = tid & 63, wid = tid >> 6;
    LAS float* part = (LAS float*)lds;
    u32x4 raw[4][2];
#pragma unroll
    for (int t = 0; t < 4; ++t) { raw[t][0] = *(const u32x4*)(tiles + (size_t)t * 8192 + (2 * wid) * 512 + lane * 8); raw[t][1] = *(const u32x4*)(tiles + (size_t)t * 8192 + (2 * wid + 1) * 512 + lane * 8); }
#pragma unroll
    for (int t = 0; t < 4; ++t) {
        f32x4 a0, a1, b0, b1; unpack8(raw[t][0], a0, a1); unpack8(raw[t][1], b0, b1);
        float ss = 0.f;
#pragma unroll
        for (int e = 0; e < 4; ++e) ss += a0[e] * a0[e] + a1[e] * a1[e] + b0[e] * b0[e] + b1[e] * b1[e];
        part[(t * 8 + wid) * 64 + lane] = ss;
    }
    __syncthreads();
    const f32x4 g0 = *(const f32x4*)(gain + 16 * wid) * *(const f32x4*)(gain2 + 16 * wid), g1 = *(const f32x4*)(gain + 16 * wid + 4) * *(const f32x4*)(gain2 + 16 * wid + 4),
                g2 = *(const f32x4*)(gain + 16 * wid + 8) * *(const f32x4*)(gain2 + 16 * wid + 8), g3 = *(const f32x4*)(gain + 16 * wid + 12) * *(const f32x4*)(gain2 + 16 * wid + 12);
#pragma unroll
    for (int t = 0; t < 4; ++t) {
        float tot = 0.f;
#pragma unroll
        for (int w = 0; w < 8; ++w) tot += part[(t * 8 + w) * 64 + lane];
        const float rstd = __builtin_amdgcn_rsqf(tot * (1.0f / 128.0f) + EPS_) * scale;
        f32x4 a0, a1, b0, b1; unpack8(raw[t][0], a0, a1); unpack8(raw[t][1], b0, b1);
        *(u32x4*)(tiles + (size_t)t * 8192 + (2 * wid) * 512 + lane * 8) = pack8(a0 * g0 * rstd, a1 * g1 * rstd);
        *(u32x4*)(tiles + (size_t)t * 8192 + (2 * wid + 1) * 512 + lane * 8) = pack8(b0 * g2 * rstd, b1 * g3 * rstd);
    }
    __syncthreads();
}

__device__ __forceinline__ void cumsum_unit(LAS unsigned char* lds, const float* logf, float* c2, int bh, const float* gq, const float* gk, int* lo_tab) {
    const int tid = threadIdx.x, lane = tid & 63, wid = tid >> 6, b = bh >> 3, h = bh & 7;
    LAS float* wt = (LAS float*)lds;
    LAS float* wstart = (LAS float*)(lds + 64); LAS float* wend = (LAS float*)(lds + 64 + 256);
    float v[8]; float run = 0.f;
#pragma unroll
    for (int k = 0; k < 8; ++k) { run += logf[(size_t)(b * 4096 + tid * 8 + k) * 8 + h]; v[k] = run; }
    float inc = run;
#pragma unroll
    for (int o = 1; o < 64; o <<= 1) { const float t = __shfl_up(inc, o); if (lane >= o) inc += t; }
    if (lane == 63) wt[wid] = inc;
    __syncthreads();
    float pre = inc - run;
    for (int w = 0; w < wid; ++w) pre += wt[w];
#pragma unroll
    for (int k = 0; k < 8; ++k) c2[(size_t)bh * 4096 + tid * 8 + k] = (pre + v[k]) * LOG2E;
    if ((tid & 7) == 0) wstart[tid >> 3] = (pre + v[0]) * LOG2E;
    if ((tid & 7) == 7) wend[tid >> 3] = (pre + v[7]) * LOG2E;
    __syncthreads();
    float gqm = 0.f, gkm = 0.f;
    for (int i = 0; i < 64; ++i) { gqm = fmaxf(gqm, fabsf(gq[i])); gkm = fmaxf(gkm, fabsf(gk[i])); }
    const float smax = 64.0f * QSCALE * gqm * gkm * 1.02f;
    if (tid < 16) {
        const float cq0 = wstart[4 * tid]; int lo = 0;
        while (lo < 4 * tid && smax + cq0 - wend[lo] + smax < -135.0f) ++lo;
        lo_tab[bh * 16 + tid] = lo;
    }
    if (bh == 0 && tid == 0) ((float*)lo_tab)[1024] = smax;
    __syncthreads();
}

__device__ __forceinline__ void merge_unit(const bf16_t* DIL, const float* LSE, bf16_t* Y, int u) {
    const int tid = threadIdx.x;
#pragma unroll
    for (int k = 0; k < 4; ++k) {
        const int it = tid + 512 * k, row = 64 * u + (it >> 5), c8 = it & 31, h = c8 >> 3;
        const float l0 = LSE[(size_t)row * 4 + h], l1 = LSE[(size_t)(M_ + row) * 4 + h], l2 = LSE[(size_t)(2 * M_ + row) * 4 + h];
        const float mx = fmaxf(l0, fmaxf(l1, l2));
        float w0 = __expf(l0 - mx), w1 = __expf(l1 - mx), w2 = __expf(l2 - mx);
        const float inv = 1.0f / (w0 + w1 + w2); w0 *= inv; w1 *= inv; w2 *= inv;
        f32x4 a0, a1, b0, b1, c0, c1;
        unpack8(*(const u32x4*)(DIL + (size_t)row * 256 + c8 * 8), a0, a1);
        unpack8(*(const u32x4*)(DIL + (size_t)(M_ + row) * 256 + c8 * 8), b0, b1);
        unpack8(*(const u32x4*)(DIL + (size_t)(2 * M_ + row) * 256 + c8 * 8), c0, c1);
        *(u32x4*)(Y + (size_t)row * 1280 + c8 * 8) = pack8(a0 * w0 + b0 * w1 + c0 * w2, a1 * w0 + b1 * w1 + c1 * w2);
    }
}

__device__ __forceinline__ float wave_sum(float v) {
#pragma unroll
    for (int o = 1; o < 64; o <<= 1) v += __shfl_xor(v, o);
    return v;
}
__device__ __forceinline__ void cat_src(const Params& P, int n, const float*& base, int& ld, int& col) {
    const int tile = n >> 8, c = n & 255, bj = c >> 7, wc = (c >> 5) & 3, j = c & 31;
    if (tile < 15) {
        int colbase, head; bool rope = false;
        if (tile < 3) { colbase = 0; head = tile * 4 + wc; rope = true; }
        else if (tile < 6) { colbase = 768; head = (tile - 3) * 4 + wc; rope = true; }
        else if (tile < 9) { colbase = 1536; head = (tile - 6) * 4 + wc; }
        else if (tile < 11) { colbase = 2304; head = (tile - 9) * 4 + wc; }
        else if (tile < 13) { colbase = 2816; head = (tile - 11) * 4 + wc; }
        else { colbase = 3328; head = (tile - 13) * 4 + wc; }
        const int p = 32 * bj + j; const int d = (rope && p < 16) ? ((p & 3) + 4 * ((p >> 3) & 1) + 8 * ((p >> 2) & 1)) : p;
        base = P.in[3]; ld = 4360; col = colbase + head * 64 + d;
    } else if (tile < 17) { base = P.in[3]; ld = 4360; col = 3848 + (2 * (tile - 15) + bj) * 128 + 32 * wc + j; }
    else if (tile < 29) { base = P.in[13]; ld = 3072; col = n - 4352; }
    else if (tile < 31) { base = P.in[10]; ld = 1024; col = (2 * (tile - 29) + bj) * 128 + 32 * wc + j; }
    else { base = P.in[10]; ld = 1024; col = 512 + (2 * (tile - 31) + bj) * 128 + 32 * wc + j; }
}
__device__ __forceinline__ void transpose_item(const float* srcp  , int ldsrc, int k0, const float* kscale, bf16_t* dst, int ldd, int drow0, int dcol0,
                                               LAS float* scr, int lane) {
    float tv[32];
#pragma unroll
    for (int i = 0; i < 32; ++i) { const int kk = 2 * i + (lane >> 5); tv[i] = srcp[(size_t)(k0 + kk) * ldsrc]; }
    if (kscale) {
#pragma unroll
        for (int i = 0; i < 32; ++i) tv[i] *= kscale[k0 + 2 * i + (lane >> 5)];
    }
#pragma unroll
    for (int i = 0; i < 32; ++i) scr[(2 * i + (lane >> 5)) * 33 + (lane & 31)] = tv[i];
    asm volatile("s_waitcnt lgkmcnt(0)" ::: "memory");
    const int c = lane & 7;
#pragma unroll
    for (int jx = 0; jx < 4; ++jx) { const int n = (lane >> 3) + 8 * jx; const LAS float* s = scr + (8 * c) * 33 + n;
        u32x4 o; o.x = pk2(s[0 * 33], s[1 * 33]); o.y = pk2(s[2 * 33], s[3 * 33]); o.z = pk2(s[4 * 33], s[5 * 33]); o.w = pk2(s[6 * 33], s[7 * 33]);
        *(u32x4*)(dst + (size_t)(drow0 + n) * ldd + dcol0 + k0 + 8 * c) = o; }
    asm volatile("s_waitcnt lgkmcnt(0)" ::: "memory");
}

constexpr int TR_I_CAT = 16 * 264, TR_NITEMS = TR_I_CAT + 4 * 32 + 8 * 32 + 8 * 32 + 16 * 32 + 16 * 128 + 64 * 32;
__device__ __forceinline__ void weight_transposes(const Params& P, LAS float* scr, int lane, int widx, int nw, int item_lo, int item_hi) {
    unsigned char* ws = P.ws;
    constexpr int I_CAT = 16 * 264, I_BA = 4 * 32, I_BB = 8 * 32, I_BM = 8 * 32, I_OUT = 16 * 32, I_UP = 16 * 128, I_DN = 64 * 32;
    bf16_t* WCAT = (bf16_t*)(ws + WS_WCAT); bf16_t* WBR = (bf16_t*)(ws + WS_WBR); bf16_t* WOUT = (bf16_t*)(ws + WS_WOUT); bf16_t* WUP = (bf16_t*)(ws + WS_WUP); bf16_t* WDN = (bf16_t*)(ws + WS_WDN);
    for (int it = item_lo + widx; it < item_hi; it += nw) {
        int r = it;
        if (r < I_CAT) { const int kb = r / 264, nb = r % 264; const float* base; int ld, col; cat_src(P, nb * 32 + (lane & 31), base, ld, col);
            transpose_item(base + col, ld, kb * 64, nullptr, WCAT, 1024, nb * 32, 0, scr, lane); continue; }
        r -= I_CAT;
        if (r < I_BA) { const int kb = r / 32, nb = r % 32; transpose_item(P.in[15] + nb * 32 + (lane & 31), 1024, kb * 64, nullptr, WBR, 1280, nb * 32, 0, scr, lane); continue; }
        r -= I_BA;
        if (r < I_BB) { const int kb = r / 32, nb = r % 32; transpose_item(P.in[16] + nb * 32 + (lane & 31), 1024, kb * 64, nullptr, WBR, 1280, nb * 32, 256, scr, lane); continue; }
        r -= I_BB;
        if (r < I_BM) { const int kb = r / 32, nb = r % 32; transpose_item(P.in[17] + nb * 32 + (lane & 31), 1024, kb * 64, nullptr, WBR, 1280, nb * 32, 768, scr, lane); continue; }
        r -= I_BM;
        if (r < I_OUT) { const int kb = r / 32, nb = r % 32; transpose_item(P.in[18] + nb * 32 + (lane & 31), 1024, kb * 64, nullptr, WOUT, 1024, nb * 32, 0, scr, lane); continue; }
        r -= I_OUT;
        if (r < I_UP) { const int kb = r / 128, nb = r % 128; transpose_item(P.in[20] + nb * 32 + (lane & 31), 4096, kb * 64, P.in[19], WUP, 1024, nb * 32, 0, scr, lane); continue; }
        r -= I_UP;
        { const int kb = r / 32, nb = r % 32; transpose_item(P.in[21] + nb * 32 + (lane & 31), 1024, kb * 64, nullptr, WDN, 4096, nb * 32, 0, scr, lane); }
    }
}

__device__ __forceinline__ void p0_prologue(const Params& P, LAS unsigned char* lds, int vcu, int G) {
    const int tid = threadIdx.x, lane = tid & 63, wave = tid >> 6;
    unsigned char* ws = P.ws;
    const float* w_in = P.in[3];
    LAS float* wfl = (LAS float*)(lds + 73728);
    { float wv[16], gv[16];
#pragma unroll
      for (int j = 0; j < 16; ++j) { const int i = tid + 512 * j, k = i >> 3, c = i & 7; wv[j] = w_in[(size_t)k * 4360 + 3840 + c]; gv[j] = P.in[2][k]; }
#pragma unroll
      for (int j = 0; j < 16; ++j) { const int i = tid + 512 * j, k = i >> 3, c = i & 7; wfl[c * 1024 + k] = wv[j] * gv[j]; } }
    const int gtid = vcu * 512 + tid, GT = G * 512;
    { float* ssq = (float*)(ws + WS_SSQ); for (int i = gtid; i < M_; i += GT) ssq[i] = 0.f;
      float* ssqq = (float*)(ws + WS_SSQQ); for (int i = gtid; i < M_ * 4; i += GT) ssqq[i] = 0.f; }
    { float* cosT = (float*)(ws + WS_COS); float* sinT = (float*)(ws + WS_SIN);
      for (int i = gtid; i < 4096 * 8; i += GT) { const int t = i >> 3, f = i & 7; const float inv = powf(500000.0f, -(float)(2 * f) / 16.0f); const float ang = (float)t * inv; cosT[i] = cosf(ang); sinT[i] = sinf(ang); } }
    LAS float* scr = (LAS float*)(lds + wave * 8448);
    const int gw = vcu * 8 + wave, NGW = G * 8;
    weight_transposes(P, scr, lane, gw, NGW, 0, TR_I_CAT);
    __syncthreads();
    bf16_t* AALL = (bf16_t*)P.out;
    float* logf = (float*)(ws + WS_LOGF);
    const float* bfv = P.in[4];
    constexpr int RB = 2;
    for (int base = gw * RB; base < M_ + 2048; base += NGW * RB) {
        const bool ismem = base >= M_;
        const float* xb = ismem ? P.in[1] + (size_t)(base - M_) * 1024 : P.in[0] + (size_t)base * 1024;
        const float* gp = ismem ? P.in[9] : P.in[2];
        f32x4 v[RB][4];
#pragma unroll
        for (int r = 0; r < RB; ++r)
#pragma unroll
            for (int j = 0; j < 4; ++j) v[r][j] = ((const f32x4*)(xb + (size_t)r * 1024))[lane + 64 * j];
        float ssq[RB], red[RB];
#pragma unroll
        for (int r = 0; r < RB; ++r) { float s = 0.f;
#pragma unroll
            for (int j = 0; j < 4; ++j) s += (v[r][j][0] * v[r][j][0] + v[r][j][1] * v[r][j][1]) + (v[r][j][2] * v[r][j][2] + v[r][j][3] * v[r][j][3]);
            ssq[r] = s; red[r] = 0.f; }
        if (!ismem) {
            float a[RB][8];
#pragma unroll
            for (int c = 0; c < 8; ++c) {
                f32x4 w[4];
#pragma unroll
                for (int j = 0; j < 4; ++j) w[j] = ((const LAS f32x4*)(wfl + c * 1024))[lane + 64 * j];
#pragma unroll
                for (int r = 0; r < RB; ++r) { float t = 0.f;
#pragma unroll
                    for (int j = 0; j < 4; ++j) t += (v[r][j][0] * w[j][0] + v[r][j][1] * w[j][1]) + (v[r][j][2] * w[j][2] + v[r][j][3] * w[j][3]);
                    a[r][c] = t; }
            }
#pragma unroll
            for (int r = 0; r < RB; ++r) {
                float b4[4], b2[2];
#pragma unroll
                for (int i = 0; i < 4; ++i) { const float keep = (lane & 32) ? a[r][i + 4] : a[r][i], send = (lane & 32) ? a[r][i] : a[r][i + 4]; b4[i] = keep + __shfl_xor(send, 32); }
#pragma unroll
                for (int i = 0; i < 2; ++i) { const float keep = (lane & 16) ? b4[i + 2] : b4[i], send = (lane & 16) ? b4[i] : b4[i + 2]; b2[i] = keep + __shfl_xor(send, 16); }
                { const float keep = (lane & 8) ? b2[1] : b2[0], send = (lane & 8) ? b2[0] : b2[1]; red[r] = keep + __shfl_xor(send, 8); }
            }
#pragma unroll
            for (int o = 4; o >= 1; o >>= 1)
#pragma unroll
                for (int r = 0; r < RB; ++r) red[r] += __shfl_xor(red[r], o);
        }
#pragma unroll
        for (int o = 1; o < 64; o <<= 1)
#pragma unroll
            for (int r = 0; r < RB; ++r) ssq[r] += __shfl_xor(ssq[r], o);
#pragma unroll
        for (int r = 0; r < RB; ++r) {
            const float rstd = 1.0f / sqrtf(ssq[r] * (1.0f / 1024.0f) + EPS_);
#pragma unroll
            for (int j = 0; j < 4; ++j) { const f32x4 g = ((const f32x4*)gp)[lane + 64 * j]; const f32x4 y = v[r][j] * rstd * g;
                u32x2 w; w.x = pk2(y[0], y[1]); w.y = pk2(y[2], y[3]); ((u32x2*)(AALL + (size_t)(base + r) * 1024))[lane + 64 * j] = w; }
            if (!ismem && (lane & 7) == 0) { const int c = lane >> 3; const float z = red[r] * rstd + bfv[c]; logf[(size_t)(base + r) * 8 + c] = fminf(z, 0.f) - log1pf(expf(-fabsf(z))); }
        }
    }
}


#define XB_TMO      128
#define XB_XCNT(j)  (256  + 64 * (j))
#define XB_XSUB(j)  (1280 + 64 * (j))
#define XB_XGEN(j)  (2304 + 64 * (j))
#define XB_TOP      3328
#define XB_TOPGEN   3392
#define XCD_BAR_WORDS 3456
#define XB_SPIN_CAP (1u << 20)
__device__ __forceinline__ unsigned xb_ld(unsigned* p)              { return __hip_atomic_load(p, __ATOMIC_RELAXED, __HIP_MEMORY_SCOPE_AGENT); }
__device__ __forceinline__ unsigned xb_add(unsigned* p, unsigned v) { return __hip_atomic_fetch_add(p, v, __ATOMIC_RELAXED, __HIP_MEMORY_SCOPE_AGENT); }
__device__ __forceinline__ unsigned xb_xcc_id() { return (unsigned)__builtin_amdgcn_s_getreg((3 << 11) | 20) & 0xFu; }
#define XB_SPIN(cond, bar) do { unsigned _sp = 0; while (cond) { __builtin_amdgcn_s_sleep(1); \
    if ((++_sp & 255u) == 0u) { if (xb_ld(&(bar)[XB_TMO])) break; if (_sp > XB_SPIN_CAP) { atomicAdd(&(bar)[XB_TMO], 1u); break; } } } } while (0)
struct XcdBarrier { unsigned* bar; unsigned x; volatile LAS unsigned* st; };
__device__ __forceinline__ XcdBarrier xcd_barrier_post(unsigned* bar, volatile LAS unsigned* st) {
    XcdBarrier b; b.bar = bar; b.x = xb_xcc_id(); b.st = st;
    if (threadIdx.x == 0) (void)xb_add(&bar[XB_XCNT(b.x)], 1u);
    return b;
}
__device__ __forceinline__ void xcd_barrier_complete(unsigned* bar, unsigned x, unsigned& nloc, unsigned& nx) {
    const unsigned G = gridDim.x * gridDim.y * gridDim.z;
    unsigned sum, cnt, mine, sp = 0u;
    for (;;) {
        sum = 0u; cnt = 0u; mine = 0u;
#pragma unroll
        for (unsigned j = 0; j < 16; ++j) { const unsigned c = xb_ld(&bar[XB_XCNT(j)]); sum += c; cnt += (c > 0u) ? 1u : 0u; mine = (j == x) ? c : mine; }
        if (sum == G) break;
        __builtin_amdgcn_s_sleep(1);
        if ((++sp & 255u) == 0u) { if (xb_ld(&bar[XB_TMO])) break; if (sp > XB_SPIN_CAP) { atomicAdd(&bar[XB_TMO], 1u); break; } }
    }
    nloc = mine > 0u ? mine : 1u; nx = cnt > 0u ? cnt : 1u;
}
__device__ __forceinline__ void xcd_barrier(const XcdBarrier& b) {
    asm volatile("s_waitcnt vmcnt(0)" ::: "memory");
    __syncthreads();
    if (threadIdx.x == 0) {
        unsigned* bar = b.bar;
        __builtin_amdgcn_s_waitcnt(0);
        unsigned nloc = b.st[0], nx = b.st[1];
        if (nloc == 0u) { xcd_barrier_complete(bar, b.x, nloc, nx); b.st[0] = nloc; b.st[1] = nx; }
        const unsigned old = xb_add(&bar[XB_XSUB(b.x)], 1u);
        const unsigned gen = old / nloc;
        if (old + 1u == (gen + 1u) * nloc) {
            __builtin_amdgcn_fence(__ATOMIC_RELEASE, "agent");
            asm volatile("s_waitcnt vmcnt(0)" ::: "memory");
            const unsigned og = xb_add(&bar[XB_TOP], 1u);
            const unsigned tg = og / nx;
            if (og + 1u == (tg + 1u) * nx) xb_add(&bar[XB_TOPGEN], 1u);
            else XB_SPIN(xb_ld(&bar[XB_TOPGEN]) == tg, bar);
            __builtin_amdgcn_fence(__ATOMIC_ACQUIRE, "agent");
            xb_add(&bar[XB_XGEN(b.x)], 1u);
            asm volatile("s_waitcnt vmcnt(0)" ::: "memory");
        } else {
            XB_SPIN(xb_ld(&bar[XB_XGEN(b.x)]) == gen, bar);
            __builtin_amdgcn_fence(__ATOMIC_ACQUIRE, "agent");
            asm volatile("s_waitcnt vmcnt(0)" ::: "memory");
        }
    }
    __syncthreads();
}

__global__ void __launch_bounds__(512, 2) mk_fwd(Params P) {
    extern __shared__ __attribute__((aligned(16))) unsigned char lds_raw[];
    LAS unsigned char* lds = (LAS unsigned char*)lds_raw;
    const int G = gridDim.x, bx = blockIdx.x;
    const int vcu = (G % 8 == 0) ? (bx % 8) * (G / 8) + bx / 8 : bx;
    unsigned char* ws = P.ws;
    const int lo = P.ph_lo, hi = P.ph_hi;
#ifndef PHASE_MASK
#define PHASE_MASK 255
#endif
#define IN(k) (((PHASE_MASK >> (k)) & 1) && lo <= (k) && (k) < hi)
#define SEAM(k) do { if (IN(k) && IN((k) + 1)) { if ((k) == 0) cg::this_grid().sync(); else xcd_barrier(xbar); } } while (0)
    volatile LAS unsigned* xst = (volatile LAS unsigned*)(lds + LDS_BYTES - 64);
    if (threadIdx.x < 2) xst[threadIdx.x] = 0u;
    __syncthreads();
    XcdBarrier xbar; xbar.bar = (unsigned*)(ws + WS_BAR); xbar.x = 0; xbar.st = xst;
    if (hi - lo > 1) xbar = xcd_barrier_post((unsigned*)(ws + WS_BAR), xst);
    bf16_t* AALL = (bf16_t*)P.out;
    bf16_t* DIL = (bf16_t*)((unsigned char*)P.out + DO_DIL);
    bf16_t* Y = (bf16_t*)((unsigned char*)P.out + DO_Y);
    float* LSE = (float*)(ws + WS_LSE);
    float* C2 = (float*)(ws + WS_C2);

    if (IN(0)) { p0_prologue(P, lds, vcu, G); }
    SEAM(0);
    if (IN(1)) {
        if (G >= 224 && bx >= G - 64) cumsum_unit(lds, (const float*)(ws + WS_LOGF), C2, bx - (G - 64), P.in[7], P.in[8], (int*)(ws + WS_LO));
        pg8::Gemm g{AALL, (const bf16_t*)(ws + WS_WCAT), 1024, 1024};
        SchedP1 S{G, bx};
        EpiP1 E{(bf16_t*)(ws + WS_QA), (bf16_t*)(ws + WS_KA), (bf16_t*)(ws + WS_VA), (bf16_t*)(ws + WS_QB), (bf16_t*)(ws + WS_KB), (bf16_t*)(ws + WS_VB), (bf16_t*)(ws + WS_QM),
                (bf16_t*)(ws + WS_KM), (bf16_t*)(ws + WS_VM), (unsigned char*)(ws + WS_GATES), (float*)(ws + WS_SSQQ), P.in[5], P.in[6], P.in[7], P.in[8], P.in[14], (const float*)(ws + WS_COS), (const float*)(ws + WS_SIN)};
        pg8::gemm_phase<EpiP1, SchedP1>(lds, g, S, E);
        {
            const int maxu = (3744 + G - 1) / G; int first_short = 3744 - (maxu - 1) * G; if (first_short >= G) first_short = 0;
            if (bx >= first_short) {
                const int tid_ = threadIdx.x, wave_ = tid_ >> 6, lane_ = tid_ & 63;
                weight_transposes(P, (LAS float*)(lds + wave_ * 8448), lane_, (bx - first_short) * 8 + wave_, (G - first_short) * 8, TR_I_CAT, TR_NITEMS);
            }
        }
    }
    SEAM(1);
    if (IN(2)) {
        dil_phase(lds, ws, DIL, LSE, bx, G);
        for (int L = bx; L < 32 + 64; L += G) {
            if (L < 32) {
                memnorm_unit(lds, (bf16_t*)(ws + WS_KM) + (size_t)L * 4 * 8192, P.in[12], P.in[11], 1.0f);
            } else if (G < 224) {
                cumsum_unit(lds, (const float*)(ws + WS_LOGF), C2, L - 32, P.in[7], P.in[8], (int*)(ws + WS_LO));
            }
        }
    }
    SEAM(2);
    if (IN(3)) {
        const int* LO = (const int*)(ws + WS_LO); const float smax_fox = ((const float*)LO)[1024];
        for (int i = 0;; ++i) {
            const int L = (i & 1) ? i * G + (G - 1 - bx) : i * G + bx;
            if (i * G >= 2048) break;
            if (L >= 2048) continue;
            if (L < 1024) {
                const int qblk = 15 - (L >> 6), bh = L & 63, b = bh >> 3, h = bh & 7;
                const size_t Rs = (size_t)bh << 12;
                attn_unit<64, 1>(lds, (const bf16_t*)(ws + WS_QB) + Rs * 64, (const bf16_t*)(ws + WS_KB) + Rs * 64, (const bf16_t*)(ws + WS_VB) + Rs * 64, C2 + Rs, qblk,
                                 Y + 256 + h * 64, 1280, b * 4096, 0, nullptr, LO[bh * 16 + qblk], smax_fox);
            } else if (L < 1536) {
                const int u = L - 1024, bh = u >> 4, qblk = u & 15, b = bh >> 2, h = bh & 3;
                attn_unit<128, 2>(lds, (const bf16_t*)(ws + WS_QM) + ((size_t)bh << 12) * 128, (const bf16_t*)(ws + WS_KM) + ((size_t)bh << 8) * 128, (const bf16_t*)(ws + WS_VM) + ((size_t)bh << 8) * 128,
                                  (const float*)(ws + WS_SSQQ) + (size_t)b * 4096 * 4 + h, qblk, Y + 768 + h * 128, 1280, b * 4096, 0, nullptr, 0, 0.f);
            } else {
                merge_unit(DIL, LSE, Y, L - 1536);
            }
        }
    }
    SEAM(3);
    if (IN(4)) {
        pg8::Gemm g{Y, (const bf16_t*)(ws + WS_WBR), 1280, 1280};
        SchedP3 S{G, bx};
        EpiMerge E{(const unsigned char*)(ws + WS_GATES), (bf16_t*)(ws + WS_MERGED)};
        pg8::gemm_phase<EpiMerge, SchedP3>(lds, g, S, E);
    }
    SEAM(4);
    if (IN(5)) {
        pg8::Gemm g{(const bf16_t*)(ws + WS_MERGED), (const bf16_t*)(ws + WS_WOUT), 1024, 1024};
        SchedSimple S{G, bx, 4, 16};
        EpiOut E{P.in[0], P.out, (bf16_t*)(ws + WS_X1B), (float*)(ws + WS_SSQ)};
        pg8::gemm_phase<EpiOut, SchedSimple>(lds, g, S, E);
    }
    SEAM(5);
    if (IN(6)) {
        pg8::Gemm g{(const bf16_t*)(ws + WS_X1B), (const bf16_t*)(ws + WS_WUP), 1024, 1024};
        SchedSimple S{G, bx, 16, 16};
        EpiUp E{(const float*)(ws + WS_SSQ), (bf16_t*)(ws + WS_HMID)};
        pg8::gemm_phase<EpiUp, SchedSimple>(lds, g, S, E);
    }
    SEAM(6);
    if (IN(7)) {
        pg8::Gemm g{(const bf16_t*)(ws + WS_HMID), (const bf16_t*)(ws + WS_WDN), 4096, 4096};
        SchedSimple S{G, bx, 4, 64};
        EpiDown E{P.out, (const bf16_t*)(ws + WS_X1B)};
        pg8::gemm_phase<EpiDown, SchedSimple>(lds, g, S, E);
    }
#undef IN
#undef SEAM
}

extern "C" void kernel_launch(void* const* d_in, const int* in_sizes, int n_in, void* d_out, int out_size, void* d_ws, size_t ws_size, hipStream_t stream) {
    static int grid = 0;
    if (grid == 0) {
        if (n_in != 22 || in_sizes[0] != M_ * DM || out_size != M_ * DM || ws_size < WS_END) {
            fprintf(stderr, "kernel_launch: unexpected shapes (n_in %d, in0 %d, out %d, ws %zu); nothing launched\n", n_in, n_in > 0 ? in_sizes[0] : -1, out_size, ws_size); grid = -1; return; }
        int dev = 0, cus = 0, per_cu = 0;
        if (hipGetDevice(&dev) != hipSuccess || hipDeviceGetAttribute(&cus, hipDeviceAttributeMultiprocessorCount, dev) != hipSuccess) { grid = -1; return; }
        if (hipFuncSetAttribute((const void*)mk_fwd, hipFuncAttributeMaxDynamicSharedMemorySize, LDS_BYTES) != hipSuccess) { fprintf(stderr, "kernel_launch: hipFuncSetAttribute failed\n"); grid = -1; return; }
        if (hipOccupancyMaxActiveBlocksPerMultiprocessor(&per_cu, (const void*)mk_fwd, 512, LDS_BYTES) != hipSuccess || per_cu < 1) { fprintf(stderr, "kernel_launch: occupancy query gave %d\n", per_cu); (void)hipGetLastError(); grid = -1; return; }
        grid = cus * 1;
    }
    if (grid < 0) return;
    if (hipMemsetAsync((char*)d_ws + WS_BAR, 0, WS_BAR_BYTES, stream) != hipSuccess) { fprintf(stderr, "kernel_launch: hipMemsetAsync failed\n"); return; }
    Params p{};
    for (int i = 0; i < 22; ++i) p.in[i] = (const float*)d_in[i];
    p.out = (float*)d_out; p.ws = (unsigned char*)d_ws;
#if MK_MULTI
    for (int ph = 0; ph < NPH; ++ph) { p.ph_lo = ph; p.ph_hi = ph + 1; hipLaunchKernelGGL(mk_fwd, dim3(grid), dim3(512), LDS_BYTES, stream, p); }
#else
    p.ph_lo = 0; p.ph_hi = NPH;
    void* args[] = {&p};
    hipError_t e = hipLaunchCooperativeKernel((const void*)mk_fwd, dim3(grid), dim3(512), args, LDS_BYTES, stream);
    if (e != hipSuccess) fprintf(stderr, "cooperative launch failed: %s (grid %d)\n", hipGetErrorString(e), grid);
#endif
}
```

```cpp
#include <hip/hip_runtime.h>
#include <hip/hip_cooperative_groups.h>
#include <cstdio>
#include <cstdint>
namespace cg = cooperative_groups;

#ifndef MK_MULTI
#define MK_MULTI 0
#endif

#define LAS __attribute__((address_space(3)))
typedef unsigned short bf16_t;
typedef short bf16x8 __attribute__((ext_vector_type(8)));
typedef short s16x4 __attribute__((ext_vector_type(4)));
typedef float f32x4 __attribute__((ext_vector_type(4)));
typedef float f32x16 __attribute__((ext_vector_type(16)));
typedef unsigned u32x4 __attribute__((ext_vector_type(4)));
typedef unsigned u32x2 __attribute__((ext_vector_type(2)));

constexpr int B_ = 8, T_ = 4096, DM = 1024, M_ = B_ * T_;
constexpr int NPH = 8;
constexpr float EPS_ = 1e-6f;
constexpr float LOG2E = 1.4426950408889634f, LN2 = 0.6931471805599453f;
constexpr float QSCALE = 0.125f * LOG2E;
constexpr float QSCALE_M = 0.08838834764831845f * LOG2E;

constexpr size_t MiB = 1u << 20;
constexpr size_t WS_SSQ = 0, WS_COS = 256 * 1024, WS_SIN = 384 * 1024, WS_BAR = 512 * 1024, WS_BAR_BYTES = 16384, WS_QCTR = WS_BAR + 15 * 1024;
constexpr size_t WS_LOGF = 1 * MiB, WS_C2 = 2 * MiB, WS_LSE = 3 * MiB, WS_LO = 4 * MiB + 768 * 1024;
constexpr size_t WS_WCAT = 5 * MiB, WS_WBR = 22 * MiB, WS_WOUT = 25 * MiB, WS_WUP = 27 * MiB, WS_WDN = 35 * MiB;
constexpr size_t WS_KM = 43 * MiB, WS_VM = 45 * MiB, WS_SSQQ = 47 * MiB;
constexpr size_t WS_QA = 48 * MiB, WS_KA = 96 * MiB, WS_VA = 144 * MiB, WS_QB = 192 * MiB, WS_KB = 224 * MiB, WS_VB = 256 * MiB, WS_QM = 288 * MiB;
constexpr size_t WS_GATES = 320 * MiB, WS_END = 512 * MiB;
constexpr size_t WS_MERGED = 48 * MiB, WS_X1B = 320 * MiB, WS_HMID = 48 * MiB;
constexpr size_t DO_DIL = 0, DO_Y = 48 * MiB;
constexpr int LDS_BYTES = 147456;

struct Params { const float* in[22]; float* out; unsigned char* ws; int ph_lo, ph_hi; };

__device__ __forceinline__ unsigned pk2(float lo, float hi) {
    typedef float f2 __attribute__((ext_vector_type(2))); typedef __bf16 b2 __attribute__((ext_vector_type(2)));
    f2 v = {lo, hi}; b2 b = __builtin_convertvector(v, b2); return __builtin_bit_cast(unsigned, b);
}
__device__ __forceinline__ float bf2f(unsigned short u) { return __uint_as_float(((unsigned)u) << 16); }
__device__ __forceinline__ u32x4 pack8(f32x4 a, f32x4 b) { u32x4 w; w.x = pk2(a[0], a[1]); w.y = pk2(a[2], a[3]); w.z = pk2(b[0], b[1]); w.w = pk2(b[2], b[3]); return w; }
__device__ __forceinline__ void unpack8(u32x4 w, f32x4& a, f32x4& b) {
    a[0] = __uint_as_float(w.x << 16); a[1] = __uint_as_float(w.x & 0xffff0000u); a[2] = __uint_as_float(w.y << 16); a[3] = __uint_as_float(w.y & 0xffff0000u);
    b[0] = __uint_as_float(w.z << 16); b[1] = __uint_as_float(w.z & 0xffff0000u); b[2] = __uint_as_float(w.w << 16); b[3] = __uint_as_float(w.w & 0xffff0000u);
}
__device__ __forceinline__ float sigmoidf_(float x) { return __builtin_amdgcn_rcpf(1.0f + __builtin_amdgcn_exp2f(-x * LOG2E)); }

namespace pg8 {
constexpr int BM = 256, BK = 64, HALF = 128, HTB = HALF * BK * 2, STAGE_BYTES = 8 * HTB, NXCD = 8, WGM = 8;
__host__ __device__ __forceinline__ int lds_byte(int r, int c) { const int st = (r >> 4) * 2 + (c >> 5), rr = r & 15, cc = c & 31, ob = rr * 64 + cc * 2; return st * 1024 + (ob ^ (((ob >> 9) & 1) << 5)); }
__host__ __device__ __forceinline__ void stage_rc(int b, int& R, int& C) { const int st = b / 1024, sb = b % 1024, swz = sb ^ (((sb >> 9) & 1) << 5); R = (st >> 1) * 16 + swz / 64; C = (st & 1) * 32 + (swz % 64) / 2; }
__host__ __device__ __forceinline__ int perm32(int rho) { const int n = rho >> 4, i = rho & 15; return 8 * (i >> 2) + 4 * n + (i & 3); }

struct Unit { int pm, pn, k0, nt, tag, first; };
struct Gemm { const bf16_t* A; const bf16_t* Bt; int lda, ldb; };

__device__ __forceinline__ void tile_order(int L, int nM, int nN, int& pm, int& pn) {
    const int nwg = nM * nN; int wgid = L;
    { const int q = nwg / NXCD, r = nwg % NXCD, xcd = wgid % NXCD, off = wgid / NXCD; wgid = (xcd < r ? xcd * (q + 1) : r * (q + 1) + (xcd - r) * q) + off; }
    const int nig = WGM * nN, gid = wgid / nig, fm = gid * WGM, gsz = (nM - fm) < WGM ? (nM - fm) : WGM;
    pm = fm + ((wgid % nig) % gsz); pn = (wgid % nig) / gsz;
}

template <class Epi, class Sched>
__device__ __forceinline__ void gemm_phase(LAS unsigned char* lds, const Gemm g, const Sched& S, const Epi& E) {
    const int tid = threadIdx.x, wid = __builtin_amdgcn_readfirstlane(tid >> 6), lane = tid & 63, wr = wid >> 2, wc = wid & 3, fr = lane & 15, fq = lane >> 4;
    unsigned voffA[2], voffB[2];
#pragma unroll
    for (int i = 0; i < 2; ++i) { int R, C; stage_rc(tid * 16 + i * 8192, R, C); const int Rb = (R & ~31) + perm32(R & 31);
        voffA[i] = (unsigned)(R * g.lda + C) * 2u; voffB[i] = (unsigned)(Rb * g.ldb + C) * 2u; }
    const size_t kstep = (size_t)(BK * 2);
    const size_t hstepA = (size_t)HALF * g.lda * 2, hstepB = (size_t)HALF * g.ldb * 2, tstepA = 2 * hstepA, tstepB = 2 * hstepB;
    const unsigned ldsw = (unsigned)wid * 1024u;
    const int aoff = lds_byte(wr * 64 + fr, fq * 8), boff = lds_byte(wc * 32 + fr, fq * 8);
#define PG8_SA(b, h) (((b) * 2 + (h)) * HTB)
#define PG8_SB(b, h) ((4 + (b) * 2 + (h)) * HTB)
#define PG8_STAGE(bufoff, gbase, voff) do { _Pragma("unroll") for (int _i = 0; _i < 2; ++_i) \
        __builtin_amdgcn_global_load_lds((const unsigned*)((const char*)(gbase) + (voff)[_i]), (LAS unsigned*)(lds + (bufoff) + ldsw + _i * 8192), 16, 0, 0); } while (0)
#define PG8_LDA(dst, b, h) do { _Pragma("unroll") for (int m = 0; m < 4; ++m) _Pragma("unroll") for (int k = 0; k < 2; ++k) dst[m][k] = *(const LAS bf16x8*)(lds + PG8_SA(b, h) + aoff + m * 2048 + k * 1024); } while (0)
#define PG8_LDB(dst, b, h) do { _Pragma("unroll") for (int n = 0; n < 2; ++n) _Pragma("unroll") for (int k = 0; k < 2; ++k) dst[n][k] = *(const LAS bf16x8*)(lds + PG8_SB(b, h) + boff + n * 2048 + k * 1024); } while (0)
#define PG8_MMA(ai, bj, At, Bt) do { __builtin_amdgcn_s_setprio(1); _Pragma("unroll") for (int m = 0; m < 4; ++m) _Pragma("unroll") for (int n = 0; n < 2; ++n) _Pragma("unroll") for (int k = 0; k < 2; ++k) \
        acc[ai][bj][m][n] = __builtin_amdgcn_mfma_f32_16x16x32_bf16(Bt[n][k], At[m][k], acc[ai][bj][m][n], 0, 0, 0); __builtin_amdgcn_s_setprio(0); } while (0)
#define PG8_WAIT_V(n) asm volatile("s_waitcnt vmcnt(" #n ")" ::: "memory")
#define PG8_WAIT_L(n) asm volatile("s_waitcnt lgkmcnt(" #n ")" ::: "memory")
#define PG8_BAR __builtin_amdgcn_s_barrier()
#define PG8_SCHED __builtin_amdgcn_sched_barrier(0)
    Unit cur, nxt; int ui = 0;
    if (!S.next(0, cur)) return;
    f32x4 acc[2][2][4][2];
#pragma unroll
    for (int a = 0; a < 2; ++a)
#pragma unroll
        for (int b = 0; b < 2; ++b)
#pragma unroll
            for (int m = 0; m < 4; ++m)
#pragma unroll
                for (int n = 0; n < 2; ++n) acc[a][b][m][n] = (f32x4){0.f, 0.f, 0.f, 0.f};
    bf16x8 At[4][2], B0[2][2], B1[2][2];
    const char* cA = (const char*)g.A + (size_t)cur.pm * tstepA + (size_t)cur.k0 * 2; const char* cB = (const char*)g.Bt + (size_t)cur.pn * tstepB + (size_t)cur.k0 * 2;
    PG8_STAGE(PG8_SB(0, 0), cB, voffB); PG8_STAGE(PG8_SB(0, 1), cB + hstepB, voffB); PG8_STAGE(PG8_SA(0, 0), cA, voffA); PG8_STAGE(PG8_SA(0, 1), cA + hstepA, voffA);
    if (wr == 1) PG8_BAR;
    PG8_WAIT_V(2); PG8_BAR;
    PG8_STAGE(PG8_SB(1, 0), cB + kstep, voffB); PG8_STAGE(PG8_SA(1, 0), cA + kstep, voffA); PG8_STAGE(PG8_SB(1, 1), cB + hstepB + kstep, voffB);
    PG8_WAIT_V(6); PG8_BAR;
    for (;;) {
        const bool has_next = S.next(ui + 1, nxt);
        const char* nA = has_next ? (const char*)g.A + (size_t)nxt.pm * tstepA + (size_t)nxt.k0 * 2 : cA; const char* nB = has_next ? (const char*)g.Bt + (size_t)nxt.pn * tstepB + (size_t)nxt.k0 * 2 : cB;
        const int nt = cur.nt;
        for (int t = 0; t < nt; t += 2) {
            const bool last = (t == nt - 2);
            const char* a1 = cA + (size_t)(t + 1) * kstep;
            const char* a2 = last ? nA : cA + (size_t)(t + 2) * kstep; const char* b2 = last ? nB : cB + (size_t)(t + 2) * kstep;
            const char* a3 = a2 + kstep; const char* b3 = b2 + kstep;
            PG8_LDB(B0, 0, 0); PG8_LDB(B1, 0, 1); PG8_SCHED; PG8_LDA(At, 0, 0); PG8_STAGE(PG8_SA(1, 1), a1 + hstepA, voffA);
            PG8_WAIT_V(8); PG8_WAIT_L(0); PG8_BAR; PG8_MMA(0, 0, At, B0); PG8_MMA(0, 1, At, B1); PG8_BAR; PG8_SCHED;
            PG8_LDA(At, 0, 1); PG8_STAGE(PG8_SB(0, 0), b2, voffB); PG8_STAGE(PG8_SB(0, 1), b2 + hstepB, voffB); PG8_STAGE(PG8_SA(0, 0), a2, voffA);
            PG8_WAIT_V(8); PG8_WAIT_L(0); PG8_BAR; PG8_MMA(1, 0, At, B0); PG8_MMA(1, 1, At, B1); PG8_BAR; PG8_SCHED;
            PG8_LDB(B0, 1, 0); PG8_LDB(B1, 1, 1); PG8_SCHED; PG8_LDA(At, 1, 0); PG8_STAGE(PG8_SA(0, 1), a2 + hstepA, voffA);
            PG8_WAIT_V(8); PG8_WAIT_L(0); PG8_BAR; PG8_MMA(0, 0, At, B0); PG8_MMA(0, 1, At, B1); PG8_BAR; PG8_SCHED;
            PG8_LDA(At, 1, 1); PG8_STAGE(PG8_SB(1, 0), b3, voffB); PG8_STAGE(PG8_SB(1, 1), b3 + hstepB, voffB); PG8_STAGE(PG8_SA(1, 0), a3, voffA);
            PG8_WAIT_V(8); PG8_WAIT_L(0); PG8_BAR; PG8_MMA(1, 0, At, B0); PG8_MMA(1, 1, At, B1); PG8_BAR; PG8_SCHED;
        }
        if (wr == 0) PG8_BAR;
        E(acc, cur, wr, wc, fr, fq);
        if (!has_next) break;
        if (nxt.first) {
#pragma unroll
            for (int a = 0; a < 2; ++a)
#pragma unroll
                for (int b = 0; b < 2; ++b)
#pragma unroll
                    for (int m = 0; m < 4; ++m)
#pragma unroll
                        for (int n = 0; n < 2; ++n) acc[a][b][m][n] = (f32x4){0.f, 0.f, 0.f, 0.f};
        }
        cur = nxt; cA = nA; cB = nB; ++ui;
        if (wr == 1) PG8_BAR;
    }
    PG8_WAIT_V(0);
    PG8_BAR;
#undef PG8_SA
#undef PG8_SB
#undef PG8_STAGE
#undef PG8_LDA
#undef PG8_LDB
#undef PG8_MMA
#undef PG8_WAIT_V
#undef PG8_WAIT_L
#undef PG8_BAR
#undef PG8_SCHED
}
}

typedef f32x4 Acc[2][2][4][2];

struct EpiP1 {
    bf16_t *QA, *KA, *VA, *QB, *KB, *VB, *QM, *KM, *VM; unsigned char* GATES8; float* SSQQ;
    const float *g_qA, *g_kA, *g_qB, *g_kB, *b_gate, *cosT, *sinT;

    __device__ __forceinline__ void norm64(Acc& acc, int rowbase, int wc, int fq, const float* gain, float scale, bool rope, bf16_t* base, int hpb, int h, int dl) const {
        const bool dorope = rope && fq < 2;
        const int db0 = dorope ? 4 * fq : 8 * fq, dn = dorope ? 8 : 4;
#pragma unroll
        for (int ai = 0; ai < 2; ++ai)
#pragma unroll
            for (int m = 0; m < 4; ++m) {
                const int mrow = rowbase + ai * 128 + m * 16, b = mrow >> 12, t = mrow & 4095;
                float ss = 0.f;
#pragma unroll
                for (int bj = 0; bj < 2; ++bj)
#pragma unroll
                    for (int n = 0; n < 2; ++n) { const f32x4 x = acc[ai][bj][m][n]; ss += (x[0] * x[0] + x[1] * x[1]) + (x[2] * x[2] + x[3] * x[3]); }
                ss += __shfl_xor(ss, 16); ss += __shfl_xor(ss, 32);
                const float rstd = __builtin_amdgcn_rsqf(ss * (1.0f / 64.0f) + EPS_) * scale;
                f32x4 y[2][2];
#pragma unroll
                for (int n = 0; n < 2; ++n) { y[0][n] = acc[ai][0][m][n] * rstd * *(const f32x4*)(gain + db0 + dn * n); y[1][n] = acc[ai][1][m][n] * rstd * *(const f32x4*)(gain + 32 + 8 * fq + 4 * n); }
                if (dorope) {
                    const f32x4 c4 = *(const f32x4*)(cosT + t * 8 + 4 * fq), s4 = *(const f32x4*)(sinT + t * 8 + 4 * fq);
                    const f32x4 x1 = y[0][0], x2 = y[0][1];
                    y[0][0] = x1 * c4 - x2 * s4; y[0][1] = x2 * c4 + x1 * s4;
                }
                const int r = t & ((1 << dl) - 1), j = t >> dl;
                const int R = ((b * hpb + h) << 12) + (r << (12 - dl)) + j;
                bf16_t* p = base + (size_t)(R >> 6) * 4096 + (R & 63) * 8 + fq * 512;
#pragma unroll
                for (int bj = 0; bj < 2; ++bj) *(u32x4*)(p + bj * 2048) = pack8(y[bj][0], y[bj][1]);
            }
    }
    __device__ __forceinline__ void v64(Acc& acc, int rowbase, int fq, bf16_t* base, int hpb, int h, int dl) const {
#pragma unroll
        for (int ai = 0; ai < 2; ++ai)
#pragma unroll
            for (int m = 0; m < 4; ++m) {
                const int mrow = rowbase + ai * 128 + m * 16, b = mrow >> 12, t = mrow & 4095;
                const int r = t & ((1 << dl) - 1), j = t >> dl;
                const int R = ((b * hpb + h) << 12) + (r << (12 - dl)) + j;
                bf16_t* p = base + (size_t)(R >> 6) * 4096 + (R & 63) * 32 + fq * 8;
#pragma unroll
                for (int bj = 0; bj < 2; ++bj) *(u32x4*)(p + bj * 2048) = pack8(acc[ai][bj][m][0], acc[ai][bj][m][1]);
            }
    }
    __device__ __forceinline__ void raw128(Acc& acc, int rowbase, int wc, int fq, bf16_t* base, int tl, int lg, bool isv, float* ssq) const {
#pragma unroll
        for (int ai = 0; ai < 2; ++ai)
#pragma unroll
            for (int m = 0; m < 4; ++m) {
                const int mrow = rowbase + ai * 128 + m * 16, b = mrow >> lg, t = mrow & ((1 << lg) - 1);
#pragma unroll
                for (int bj = 0; bj < 2; ++bj) {
                    if (ssq) {
                        const f32x4 x0 = acc[ai][bj][m][0], x1 = acc[ai][bj][m][1];
                        float ps = (x0[0] * x0[0] + x0[1] * x0[1]) + (x0[2] * x0[2] + x0[3] * x0[3]) + (x1[0] * x1[0] + x1[1] * x1[1]) + (x1[2] * x1[2] + x1[3] * x1[3]);
                        ps += __shfl_xor(ps, 16); ps += __shfl_xor(ps, 32);
                        if (fq == 0) atomicAdd(ssq + (size_t)mrow * 4 + 2 * tl + bj, ps);
                    }
                    const int R = ((b * 4 + 2 * tl + bj) << lg) + t;
                    bf16_t* p = isv ? base + (size_t)(R >> 6) * 8192 + wc * 2048 + (R & 63) * 32 + fq * 8
                                    : base + (size_t)(R >> 6) * 8192 + (4 * wc + fq) * 512 + (R & 63) * 8;
                    *(u32x4*)p = pack8(acc[ai][bj][m][0], acc[ai][bj][m][1]);
                }
            }
    }
    __device__ __forceinline__ void operator()(Acc& acc, const pg8::Unit& u, int wr, int wc, int fr_in, int fq_in) const {
        int fr = fr_in, fq = fq_in; asm volatile("" : "+v"(fr), "+v"(fq));
        const int pn = u.pn;
        const int rowbase = u.pm * 256 + wr * 64 + fr;
        if (pn < 15) {
            if (pn < 3)       norm64(acc, rowbase, wc, fq, g_qA, QSCALE, true, QA + (size_t)pn * M_ * 256, 4, wc, 2 * pn);
            else if (pn < 6)  norm64(acc, rowbase, wc, fq, g_kA, 1.0f, true, KA + (size_t)(pn - 3) * M_ * 256, 4, wc, 2 * (pn - 3));
            else if (pn < 9)  v64(acc, rowbase, fq, VA + (size_t)(pn - 6) * M_ * 256, 4, wc, 2 * (pn - 6));
            else if (pn < 11) norm64(acc, rowbase, wc, fq, g_qB, QSCALE, false, QB, 8, 4 * (pn - 9) + wc, 0);
            else if (pn < 13) norm64(acc, rowbase, wc, fq, g_kB, 1.0f, false, KB, 8, 4 * (pn - 11) + wc, 0);
            else              v64(acc, rowbase, fq, VB, 8, 4 * (pn - 13) + wc, 0);
        } else if (pn < 17) {
            raw128(acc, rowbase, wc, fq, QM, pn - 15, 12, false, SSQQ);
        } else if (pn < 29) {
            const int colt = (pn - 17) * 256 + wc * 32 + 8 * fq;
            f32x4 bv[2][2];
#pragma unroll
            for (int bj = 0; bj < 2; ++bj)
#pragma unroll
                for (int n = 0; n < 2; ++n) bv[bj][n] = *(const f32x4*)(b_gate + colt + bj * 128 + 4 * n);
            const int lane_ = fr + 16 * fq, wid_ = wr * 4 + wc;
#pragma unroll
            for (int ai = 0; ai < 2; ++ai)
#pragma unroll
                for (int m = 0; m < 4; ++m) {
                    u32x4 w;
#pragma unroll
                    for (int bj = 0; bj < 2; ++bj)
#pragma unroll
                        for (int n = 0; n < 2; ++n) {
                            const f32x4 v = acc[ai][bj][m][n] + bv[bj][n]; unsigned pk = 0;
#pragma unroll
                            for (int e = 0; e < 4; ++e) { unsigned q = (unsigned)(sigmoidf_(v[e]) * 255.0f + 0.5f); q = q < 1u ? 1u : q; pk |= q << (8 * e); }
                            w[bj * 2 + n] = pk;
                        }
                    *(u32x4*)(GATES8 + ((((((size_t)u.pm * 12 + (pn - 17)) * 2 + ai) * 4 + m) * 8 + wid_) * 64 + lane_) * 16) = w;
                }
        } else {
            const int rb = rowbase - M_;
            if (pn < 31) raw128(acc, rb, wc, fq, KM, pn - 29, 8, false, nullptr);
            else         raw128(acc, rb, wc, fq, VM, pn - 31, 8, true, nullptr);
        }
    }
};

struct EpiMerge {
    const unsigned char* GATES8; bf16_t* MERGED;
    __device__ __forceinline__ void operator()(Acc& acc, const pg8::Unit& u, int wr, int wc, int fr_in, int fq_in) const {
        int fr = fr_in, fq = fq_in; asm volatile("" : "+v"(fr), "+v"(fq));
        const int rowbase = u.pm * 256 + wr * 64 + fr, col = u.pn * 256 + wc * 32 + 8 * fq, br = u.tag;
        const int lane_ = fr + 16 * fq, wid_ = wr * 4 + wc;
#pragma unroll
        for (int ai = 0; ai < 2; ++ai)
#pragma unroll
            for (int m = 0; m < 4; ++m) {
                const size_t frag = (((size_t)ai * 4 + m) * 8 + wid_) * 64 + lane_;
                const u32x4 gn = *(const u32x4*)(GATES8 + ((((size_t)u.pm * 12 + br * 4 + u.pn) * 8) * 512 + frag) * 16);
                if (br < 2) {
                    const u32x4 gd = *(const u32x4*)(GATES8 + ((((size_t)u.pm * 12 + (br + 1) * 4 + u.pn) * 8) * 512 + frag) * 16);
#pragma unroll
                    for (int bj = 0; bj < 2; ++bj)
#pragma unroll
                        for (int n = 0; n < 2; ++n)
#pragma unroll
                            for (int e = 0; e < 4; ++e)
                                acc[ai][bj][m][n][e] *= (float)((gn[bj * 2 + n] >> (8 * e)) & 0xffu) * __builtin_amdgcn_rcpf((float)((gd[bj * 2 + n] >> (8 * e)) & 0xffu));
                } else {
                    const int row = rowbase + ai * 128 + m * 16;
#pragma unroll
                    for (int bj = 0; bj < 2; ++bj) {
                        f32x4 o[2];
#pragma unroll
                        for (int n = 0; n < 2; ++n)
#pragma unroll
                            for (int e = 0; e < 4; ++e) o[n][e] = acc[ai][bj][m][n][e] * ((float)((gn[bj * 2 + n] >> (8 * e)) & 0xffu) * (1.0f / 255.0f));
                        *(u32x4*)(MERGED + (size_t)row * 1024 + col + bj * 128) = pack8(o[0], o[1]);
                    }
                }
            }
    }
};
struct EpiOut {
    const float* X; float* OUT; bf16_t* X1B; float* SSQ;
    __device__ __forceinline__ void operator()(Acc& acc, const pg8::Unit& u, int wr, int wc, int fr_in, int fq_in) const {
        int fr = fr_in, fq = fq_in; asm volatile("" : "+v"(fr), "+v"(fq));
        const int rowbase = u.pm * 256 + wr * 64 + fr, col = u.pn * 256 + wc * 32 + 8 * fq;
#pragma unroll
        for (int ai = 0; ai < 2; ++ai)
#pragma unroll
            for (int m = 0; m < 4; ++m) {
                const int row = rowbase + ai * 128 + m * 16; const size_t off = (size_t)row * 1024 + col;
                float ss = 0.f;
#pragma unroll
                for (int bj = 0; bj < 2; ++bj) {
                    const f32x4 x0 = *(const f32x4*)(X + off + bj * 128), x1 = *(const f32x4*)(X + off + bj * 128 + 4);
                    const f32x4 v0 = acc[ai][bj][m][0] + x0, v1 = acc[ai][bj][m][1] + x1;
                    *(u32x4*)(X1B + off + bj * 128) = pack8(v0, v1);
                    ss += (v0[0] * v0[0] + v0[1] * v0[1]) + (v0[2] * v0[2] + v0[3] * v0[3]) + (v1[0] * v1[0] + v1[1] * v1[1]) + (v1[2] * v1[2] + v1[3] * v1[3]);
                }
                ss += __shfl_xor(ss, 16); ss += __shfl_xor(ss, 32);
                if (fq == 0) atomicAdd(SSQ + row, ss);
            }
    }
};
struct EpiUp {
    const float* SSQ; bf16_t* HMID;
    __device__ __forceinline__ void operator()(Acc& acc, const pg8::Unit& u, int wr, int wc, int fr_in, int fq_in) const {
        int fr = fr_in, fq = fq_in; asm volatile("" : "+v"(fr), "+v"(fq));
        const int rowbase = u.pm * 256 + wr * 64 + fr, col = u.pn * 256 + wc * 32 + 8 * fq;
#pragma unroll
        for (int ai = 0; ai < 2; ++ai)
#pragma unroll
            for (int m = 0; m < 4; ++m) {
                const int row = rowbase + ai * 128 + m * 16;
                const float rstd = __builtin_amdgcn_rsqf(SSQ[row] * (1.0f / 1024.0f) + EPS_);
#pragma unroll
                for (int bj = 0; bj < 2; ++bj) {
                    f32x4 v0 = acc[ai][bj][m][0] * rstd, v1 = acc[ai][bj][m][1] * rstd;
#pragma unroll
                    for (int e = 0; e < 4; ++e) { const float a = fmaxf(v0[e], 0.f), b = fmaxf(v1[e], 0.f); v0[e] = a * a; v1[e] = b * b; }
                    *(u32x4*)(HMID + (size_t)row * 4096 + col + bj * 128) = pack8(v0, v1);
                }
            }
    }
};
struct EpiDown {
    float* OUT; const bf16_t* X1B;
    __device__ __forceinline__ void operator()(Acc& acc, const pg8::Unit& u, int wr, int wc, int fr_in, int fq_in) const {
        int fr = fr_in, fq = fq_in; asm volatile("" : "+v"(fr), "+v"(fq));
        const int rowbase = u.pm * 256 + wr * 64 + fr, col = u.pn * 256 + wc * 32 + 8 * fq;
#pragma unroll
        for (int ai = 0; ai < 2; ++ai)
#pragma unroll
            for (int m = 0; m < 4; ++m) {
                const size_t off = (size_t)(rowbase + ai * 128 + m * 16) * 1024 + col;
#pragma unroll
                for (int bj = 0; bj < 2; ++bj) {
                    f32x4 x0, x1; unpack8(*(const u32x4*)(X1B + off + bj * 128), x0, x1);
                    *(f32x4*)(OUT + off + bj * 128) = acc[ai][bj][m][0] + x0; *(f32x4*)(OUT + off + bj * 128 + 4) = acc[ai][bj][m][1] + x1;
                }
            }
    }
};

struct SchedP1 { int G, c;
    __device__ __forceinline__ bool next(int i, pg8::Unit& u) const {
        const int L = i * G + c;
        if (L < 3712) pg8::tile_order(L, 128, 29, u.pm, u.pn);
        else if (L < 3744) { const int idx = L - 3712; u.pm = 128 + (idx >> 2); u.pn = 29 + (idx & 3); }
        else return false;
        u.k0 = 0; u.nt = 16; u.tag = 0; u.first = 1; return true; } };
struct SchedSimple { int G, c, nN, nt;
    __device__ __forceinline__ bool next(int i, pg8::Unit& u) const {
        const int L = i * G + c; if (L >= 128 * nN) return false;
        pg8::tile_order(L, 128, nN, u.pm, u.pn); u.k0 = 0; u.nt = nt; u.tag = 0; u.first = 1; return true; } };
struct SchedP3 { int G, c;
    __device__ __forceinline__ bool next(int i, pg8::Unit& u) const {
        const int ti = i / 3, br = i - 3 * ti; const int L = ti * G + c; if (L >= 512) return false;
        pg8::tile_order(L, 128, 4, u.pm, u.pn); u.k0 = (br == 0) ? 0 : (br == 1 ? 256 : 768); u.nt = (br == 0) ? 4 : 8; u.tag = br; u.first = (br == 0); return true; } };

__device__ __forceinline__ float max3f(float a, float b, float c) { float r; asm("v_max3_f32 %0, %1, %2, %3" : "=v"(r) : "v"(a), "v"(b), "v"(c)); return r; }
__device__ __forceinline__ float max2f(float a, float b) { float r; asm("v_max_f32_e32 %0, %1, %2" : "=v"(r) : "v"(a), "v"(b)); return r; }
__device__ __forceinline__ float halfmax(float m) { auto rr = __builtin_amdgcn_permlane32_swap(__float_as_uint(m), __float_as_uint(m), false, false); return max2f(__uint_as_float(rr[0]), __uint_as_float(rr[1])); }
__device__ __forceinline__ float halfsum(float m) { auto rr = __builtin_amdgcn_permlane32_swap(__float_as_uint(m), __float_as_uint(m), false, false); return __uint_as_float(rr[0]) + __uint_as_float(rr[1]); }
__device__ __forceinline__ float rowmax32(f32x16& p0, f32x16& p1) {
    asm volatile("s_nop 15\n\ts_nop 7" : "+v"(p0), "+v"(p1));
    float a = max3f(p0[0], p0[1], p1[0]), b = max3f(p0[2], p0[3], p1[1]); a = max3f(a, p1[2], p1[3]);
#pragma unroll
    for (int r = 4; r < 16; r += 4) { a = max3f(a, p0[r], p0[r + 1]); b = max3f(b, p0[r + 2], p0[r + 3]); a = max3f(a, p1[r], p1[r + 1]); b = max3f(b, p1[r + 2], p1[r + 3]); }
    return halfmax(max2f(a, b));
}

template <int D, int MODE>
__device__ __forceinline__ void attn_unit(LAS unsigned char* lds, const bf16_t* __restrict__ Qs, const bf16_t* __restrict__ Ks, const bf16_t* __restrict__ Vs,
                                          const float* __restrict__ c2s, int qblk, bf16_t* out, int opitch, int orow0, int odl, float* lse, int fox_lo, float smax) {
    constexpr int TB = 128 * D, NP = TB / 16 / 512, KS = D / 16, DB = D / 32, TE = 64 * D;
    constexpr int TPS = (D == 64) ? 2 : 1;
    constexpr int OFF_V = 2 * TPS * TB, OFF_C = 4 * TPS * TB, OFF_O = OFF_C + 2 * TPS * 256, PITCH = 2 * D + 16;
    const int tid = threadIdx.x, lane = tid & 63, wid = __builtin_amdgcn_readfirstlane(tid >> 6), r32 = lane & 31, hi = lane >> 5;
    const int jw = qblk * 256 + 32 * wid;
    int kt_lo = 0, kt_hi = 4;
    if (MODE == 0) { kt_lo = 4 * qblk - 2; if (kt_lo < 0) kt_lo = 0; kt_hi = 4 * qblk + 4; }
    if (MODE == 1) { kt_hi = 4 * qblk + 4; kt_lo = fox_lo; }
    const int ntile = kt_hi - kt_lo, nstep = (ntile + TPS - 1) / TPS;
#define KT(i) ((MODE == 1) ? (kt_hi - 1 - (i)) : (kt_lo + (i)))
    bf16x8 qf[KS];
    { const bf16_t* qp = Qs + (size_t)(jw >> 6) * TE + ((jw & 63) + r32) * 8 + hi * 512;
#pragma unroll
      for (int ks = 0; ks < KS; ++ks) qf[ks] = *(const bf16x8*)(qp + ks * 1024); }
    float cq = 0.f; if (MODE == 1) cq = c2s[jw + r32];
    float rq = 1.f; if (MODE == 2) rq = __builtin_amdgcn_rsqf(c2s[(size_t)(jw + r32) * 4] * (1.0f / 128.0f) + EPS_) * QSCALE_M;
    f32x16 o[DB];
#pragma unroll
    for (int d = 0; d < DB; ++d)
#pragma unroll
        for (int i = 0; i < 16; ++i) o[d][i] = 0.f;
    float mrun = (MODE == 1) ? 0.f : -1e30f, lrun = 0.f; bool started = false; (void)started;
    u32x4 kr[TPS][NP], vr[TPS][NP]; f32x4 cr[TPS];
#pragma unroll
    for (int sb = 0; sb < TPS; ++sb) cr[sb] = (f32x4){0.f, 0.f, 0.f, 0.f};
#define ATT_GLOAD(st_) do { _Pragma("unroll") for (int sb_ = 0; sb_ < TPS; ++sb_) { const int i_ = (st_) * TPS + sb_; if (i_ < ntile) { const int kt_ = KT(i_); \
        const u32x4* kp_ = (const u32x4*)(Ks + (size_t)kt_ * TE) + tid; const u32x4* vp_ = (const u32x4*)(Vs + (size_t)kt_ * TE) + tid; \
        _Pragma("unroll") for (int p_ = 0; p_ < NP; ++p_) { kr[sb_][p_] = kp_[p_ * 512]; vr[sb_][p_] = vp_[p_ * 512]; } \
        if (MODE == 1) { if (tid < 16) cr[sb_] = ((const f32x4*)(c2s + kt_ * 64))[tid]; } } } } while (0)
    constexpr int OFF_F = OFF_O + 8 * 32 * PITCH;
    if (MODE == 1) { if (lane == 0) ((LAS unsigned*)(lds + OFF_F))[wid] = 0u; }
    ATT_GLOAD(0);
    for (int st = 0; st < nstep; ++st) {
#pragma unroll
        for (int sb = 0; sb < TPS; ++sb) { const int slot = (st & 1) * TPS + sb;
          LAS u32x4* kd = (LAS u32x4*)(lds + slot * TB) + tid; LAS u32x4* vd = (LAS u32x4*)(lds + OFF_V + slot * TB) + tid;
#pragma unroll
          for (int p = 0; p < NP; ++p) { kd[p * 512] = kr[sb][p]; vd[p * 512] = vr[sb][p]; }
          if (MODE == 1) { if (tid < 16) ((LAS f32x4*)(lds + OFF_C + slot * 256))[tid] = cr[sb]; } }
        __syncthreads();
        if (MODE == 1) {
            const u32x4 f0 = ((const LAS u32x4*)(lds + OFF_F))[0], f1 = ((const LAS u32x4*)(lds + OFF_F))[1];
            if ((f0.x & f0.y & f0.z & f0.w & f1.x & f1.y & f1.z & f1.w) != 0u) break;
        }
        if (st + 1 < nstep) ATT_GLOAD(st + 1);
#pragma unroll
      for (int sb = 0; sb < TPS; ++sb) {
        const int it = st * TPS + sb; if (it >= ntile) break;
        const int kt = KT(it);
        const int buf = (st & 1) * TPS + sb;
        bool active = true;
        if (MODE == 0) active = (kt * 64 + 63 >= jw - 128) && (kt * 64 <= jw + 31);
        if (MODE == 1) {
            active = (kt * 64 <= jw + 31);
            if (active) { const float cend = ((const LAS float*)(lds + OFF_C + buf * 256))[63];
                active = !started || __builtin_amdgcn_ballot_w64(smax + cq - cend - mrun >= -135.0f) != 0;
                if (!active) { if (lane == 0) ((LAS unsigned*)(lds + OFF_F))[wid] = 1u; } }
        }
        if (active) {
            f32x16 s0, s1;
            if (MODE == 1) {
                const LAS f32x4* cb = (const LAS f32x4*)(lds + OFF_C + buf * 256);
                const float cqm = cq - mrun;
#pragma unroll
                for (int i4 = 0; i4 < 4; ++i4) { const f32x4 c0 = cb[2 * i4 + hi], c1 = cb[8 + 2 * i4 + hi];
#pragma unroll
                    for (int e = 0; e < 4; ++e) { s0[4 * i4 + e] = cqm - c0[e]; s1[4 * i4 + e] = cqm - c1[e]; } }
            } else {
#pragma unroll
                for (int i = 0; i < 16; ++i) { s0[i] = 0.f; s1[i] = 0.f; }
            }
            const LAS unsigned char* kb = lds + buf * TB + hi * 1024 + r32 * 16;
#pragma unroll
            for (int ks = 0; ks < KS; ++ks) {
                const bf16x8 a0 = *(const LAS bf16x8*)(kb + ks * 2048), a1 = *(const LAS bf16x8*)(kb + ks * 2048 + 512);
                s0 = __builtin_amdgcn_mfma_f32_32x32x16_bf16(a0, qf[ks], s0, 0, 0, 0);
                s1 = __builtin_amdgcn_mfma_f32_32x32x16_bf16(a1, qf[ks], s1, 0, 0, 0);
            }
            if (MODE == 2) {
#pragma unroll
                for (int i = 0; i < 16; ++i) { s0[i] *= rq; s1[i] *= rq; }
            }
            const int q = jw + r32, key0 = kt * 64 + 4 * hi;
            if (MODE == 0) {
#pragma unroll
                for (int i = 0; i < 16; ++i) { const int key = key0 + 8 * (i >> 2) + (i & 3);
                    if (key > q || key < q - 128) s0[i] = -INFINITY;
                    if (key + 32 > q || key + 32 < q - 128) s1[i] = -INFINITY; }
            }
            if (MODE == 1) {
                if (kt * 64 + 63 > jw) {
#pragma unroll
                    for (int i = 0; i < 16; ++i) { const int key = key0 + 8 * (i >> 2) + (i & 3);
                        if (key > q) s0[i] = -INFINITY;
                        if (key + 32 > q) s1[i] = -INFINITY; }
                }
            }
            const float mx = rowmax32(s0, s1);
            float rs = 0.f;
            if (MODE == 1) {
                if (!started) {
                    started = true; mrun = mx;
#pragma unroll
                    for (int i = 0; i < 16; ++i) { s0[i] -= mx; s1[i] -= mx; }
                } else if (__builtin_amdgcn_ballot_w64(mx > 0.f) != 0) {
                    const float dl = max2f(mx, 0.f), alpha = __builtin_amdgcn_exp2f(-dl);
                    mrun += dl; lrun *= alpha;
#pragma unroll
                    for (int i = 0; i < 16; ++i) { s0[i] -= dl; s1[i] -= dl; }
#pragma unroll
                    for (int d = 0; d < DB; ++d)
#pragma unroll
                        for (int i = 0; i < 16; ++i) o[d][i] *= alpha;
                }
#pragma unroll
                for (int i = 0; i < 16; ++i) { s0[i] = __builtin_amdgcn_exp2f(s0[i]); s1[i] = __builtin_amdgcn_exp2f(s1[i]); rs += s0[i] + s1[i]; }
            } else {
                const float mnew = max2f(mrun, mx);
                if (__builtin_amdgcn_ballot_w64(mnew > mrun) != 0) {
                    const float alpha = __builtin_amdgcn_exp2f(mrun - mnew);
                    lrun *= alpha;
#pragma unroll
                    for (int d = 0; d < DB; ++d)
#pragma unroll
                        for (int i = 0; i < 16; ++i) o[d][i] *= alpha;
                }
                mrun = mnew;
#pragma unroll
                for (int i = 0; i < 16; ++i) { s0[i] = __builtin_amdgcn_exp2f(s0[i] - mnew); s1[i] = __builtin_amdgcn_exp2f(s1[i] - mnew); rs += s0[i] + s1[i]; }
            }
            lrun += rs;
            u32x4 pw[4];
            pw[0] = (u32x4){pk2(s0[0], s0[1]), pk2(s0[2], s0[3]), pk2(s0[4], s0[5]), pk2(s0[6], s0[7])};
            pw[1] = (u32x4){pk2(s0[8], s0[9]), pk2(s0[10], s0[11]), pk2(s0[12], s0[13]), pk2(s0[14], s0[15])};
            pw[2] = (u32x4){pk2(s1[0], s1[1]), pk2(s1[2], s1[3]), pk2(s1[4], s1[5]), pk2(s1[6], s1[7])};
            pw[3] = (u32x4){pk2(s1[8], s1[9]), pk2(s1[10], s1[11]), pk2(s1[12], s1[13]), pk2(s1[14], s1[15])};
            const LAS unsigned char* vb = lds + OFF_V + buf * TB + ((lane >> 4) & 1) * 32 + (lane & 3) * 8 + (4 * hi + ((lane & 15) >> 2)) * 64;
#pragma unroll
            for (int d = 0; d < DB; ++d)
#pragma unroll
                for (int kk = 0; kk < 4; ++kk) {
                    typedef short v4i16_t __attribute__((ext_vector_type(4)));
                    const s16x4 lo = __builtin_bit_cast(s16x4, __builtin_amdgcn_ds_read_tr16_b64_v4i16((LAS v4i16_t*)(vb + d * 4096 + kk * 1024)));
                    const s16x4 hh = __builtin_bit_cast(s16x4, __builtin_amdgcn_ds_read_tr16_b64_v4i16((LAS v4i16_t*)(vb + d * 4096 + kk * 1024 + 512)));
                    const bf16x8 vf = (bf16x8){lo[0], lo[1], lo[2], lo[3], hh[0], hh[1], hh[2], hh[3]};
                    o[d] = __builtin_amdgcn_mfma_f32_32x32x16_bf16(vf, __builtin_bit_cast(bf16x8, pw[kk]), o[d], 0, 0, 0);
                }
        }
      }
    }
#undef ATT_GLOAD
#undef KT
    lrun = halfsum(lrun);
    const float inv = 1.0f / lrun;
    if (MODE == 0) { if (hi == 0) lse[(size_t)(orow0 + ((jw + r32) << odl)) * 4] = (mrun + __builtin_amdgcn_logf(lrun)) * LN2; }
    LAS unsigned char* stw = lds + OFF_O + wid * (32 * PITCH);
#pragma unroll
    for (int d = 0; d < DB; ++d)
#pragma unroll
        for (int i4 = 0; i4 < 4; ++i4) {
            u32x2 w; w.x = pk2(o[d][4 * i4] * inv, o[d][4 * i4 + 1] * inv); w.y = pk2(o[d][4 * i4 + 2] * inv, o[d][4 * i4 + 3] * inv);
            *(LAS u32x2*)(stw + r32 * PITCH + (32 * d + 8 * i4 + 4 * hi) * 2) = w;
        }
    constexpr int LPR = D / 8, RPI = 64 / LPR;
#pragma unroll
    for (int it = 0; it < 32 / RPI; ++it) {
        const int row = it * RPI + lane / LPR, ch = lane % LPR;
        const u32x4 v = *(const LAS u32x4*)(stw + row * PITCH + ch * 16);
        const int mrow = orow0 + ((jw + row) << odl);
        *(u32x4*)(out + (size_t)mrow * opitch + ch * 8) = v;
    }
    __syncthreads();
}

struct DilUnit { const bf16_t *Qs, *Ks, *Vs; bf16_t* out; float* lse; int qblk, orow0, odl; };
__device__ __forceinline__ void dil_decode(unsigned char* ws, bf16_t* DIL, float* LSE, int L, DilUnit& u) {
    const int gi = L / 512, rem = L % 512, bh = rem >> 4, rj = rem & 15, b = bh >> 2, h = bh & 3;
    const int dl = 2 * gi, qpb = 16 >> dl;
    const int r = rj / qpb; u.qblk = rj % qpb;
    const size_t Rs = ((size_t)(b * 4 + h) << 12) + ((size_t)r << (12 - dl));
    u.Qs = (const bf16_t*)(ws + WS_QA) + (size_t)gi * M_ * 256 + Rs * 64;
    u.Ks = (const bf16_t*)(ws + WS_KA) + (size_t)gi * M_ * 256 + Rs * 64;
    u.Vs = (const bf16_t*)(ws + WS_VA) + (size_t)gi * M_ * 256 + Rs * 64;
    u.out = DIL + (size_t)gi * M_ * 256 + h * 64; u.lse = LSE + (size_t)gi * M_ * 4 + h; u.orow0 = b * 4096 + r; u.odl = dl;
}
__device__ __forceinline__ void dil_phase(LAS unsigned char* lds, unsigned char* ws, bf16_t* DIL, float* LSE, int bx, int G) {
    constexpr int TB = 8192, TE = 4096, OFF_V = 6 * TB, OFF_O = 12 * TB, PITCH = 144;
    typedef short v4i16_t __attribute__((ext_vector_type(4)));
    int tid = threadIdx.x; asm volatile("" : "+v"(tid));
    const int lane = tid & 63, wid = __builtin_amdgcn_readfirstlane(tid >> 6), r32 = lane & 31, hi = lane >> 5;
    if (bx >= 1536) return;
    DilUnit cur, nxt; dil_decode(ws, DIL, LSE, bx, cur);
    u32x4 kr[6], vr[6]; bf16x8 qn[4];
#define DIL_LOAD(U) do { const int t0_ = 4 * (U).qblk - 2; \
        _Pragma("unroll") for (int s_ = 0; s_ < 6; ++s_) { if (t0_ + s_ >= 0) { kr[s_] = ((const u32x4*)((U).Ks + (size_t)(t0_ + s_) * TE))[tid]; vr[s_] = ((const u32x4*)((U).Vs + (size_t)(t0_ + s_) * TE))[tid]; } } \
        const int jw_ = (U).qblk * 256 + 32 * wid; const bf16_t* qp_ = (U).Qs + (size_t)(jw_ >> 6) * TE + ((jw_ & 63) + r32) * 8 + hi * 512; \
        _Pragma("unroll") for (int ks = 0; ks < 4; ++ks) qn[ks] = *(const bf16x8*)(qp_ + ks * 1024); } while (0)
#pragma unroll
    for (int s = 0; s < 6; ++s) { kr[s] = (u32x4){0u, 0u, 0u, 0u}; vr[s] = (u32x4){0u, 0u, 0u, 0u}; }
    DIL_LOAD(cur);
    for (int L = bx; L < 1536; L += G) {
        const bool has_next = (L + G < 1536);
        if (has_next) dil_decode(ws, DIL, LSE, L + G, nxt);
#pragma unroll
        for (int s = 0; s < 6; ++s) { ((LAS u32x4*)(lds + s * TB))[tid] = kr[s]; ((LAS u32x4*)(lds + OFF_V + s * TB))[tid] = vr[s]; }
        bf16x8 qf[4];
#pragma unroll
        for (int ks = 0; ks < 4; ++ks) qf[ks] = qn[ks];
        __syncthreads();
        if (has_next) DIL_LOAD(nxt);
        const int jw = cur.qblk * 256 + 32 * wid, q = jw + r32, t0 = 4 * cur.qblk - 2;
        int kfirst = (jw - 128) >> 6; if (kfirst < 0) kfirst = 0;
        const int klast = (jw + 31) >> 6;
        f32x16 o[2];
#pragma unroll
        for (int d = 0; d < 2; ++d)
#pragma unroll
            for (int i = 0; i < 16; ++i) o[d][i] = 0.f;
        float mrun = -1e30f, lrun = 0.f;
        for (int kt = kfirst; kt <= klast; ++kt) {
            const int slot = kt - t0;
            f32x16 s0, s1;
#pragma unroll
            for (int i = 0; i < 16; ++i) { s0[i] = 0.f; s1[i] = 0.f; }
            const LAS unsigned char* kb = lds + slot * TB + hi * 1024 + r32 * 16;
#pragma unroll
            for (int ks = 0; ks < 4; ++ks) {
                const bf16x8 a0 = *(const LAS bf16x8*)(kb + ks * 2048), a1 = *(const LAS bf16x8*)(kb + ks * 2048 + 512);
                s0 = __builtin_amdgcn_mfma_f32_32x32x16_bf16(a0, qf[ks], s0, 0, 0, 0);
                s1 = __builtin_amdgcn_mfma_f32_32x32x16_bf16(a1, qf[ks], s1, 0, 0, 0);
            }
            const int key0 = kt * 64 + 4 * hi;
#pragma unroll
            for (int i = 0; i < 16; ++i) { const int key = key0 + 8 * (i >> 2) + (i & 3);
                if (key > q || key < q - 128) s0[i] = -INFINITY;
                if (key + 32 > q || key + 32 < q - 128) s1[i] = -INFINITY; }
            const float mx = rowmax32(s0, s1);
            const float mnew = max2f(mrun, mx);
            if (__builtin_amdgcn_ballot_w64(mnew > mrun) != 0) {
                const float alpha = __builtin_amdgcn_exp2f(mrun - mnew);
                lrun *= alpha;
#pragma unroll
                for (int d = 0; d < 2; ++d)
#pragma unroll
                    for (int i = 0; i < 16; ++i) o[d][i] *= alpha;
            }
            mrun = mnew;
            float rs = 0.f;
#pragma unroll
            for (int i = 0; i < 16; ++i) { s0[i] = __builtin_amdgcn_exp2f(s0[i] - mnew); s1[i] = __builtin_amdgcn_exp2f(s1[i] - mnew); rs += s0[i] + s1[i]; }
            lrun += rs;
            u32x4 pw[4];
            pw[0] = (u32x4){pk2(s0[0], s0[1]), pk2(s0[2], s0[3]), pk2(s0[4], s0[5]), pk2(s0[6], s0[7])};
            pw[1] = (u32x4){pk2(s0[8], s0[9]), pk2(s0[10], s0[11]), pk2(s0[12], s0[13]), pk2(s0[14], s0[15])};
            pw[2] = (u32x4){pk2(s1[0], s1[1]), pk2(s1[2], s1[3]), pk2(s1[4], s1[5]), pk2(s1[6], s1[7])};
            pw[3] = (u32x4){pk2(s1[8], s1[9]), pk2(s1[10], s1[11]), pk2(s1[12], s1[13]), pk2(s1[14], s1[15])};
            const LAS unsigned char* vb = lds + OFF_V + slot * TB + ((lane >> 4) & 1) * 32 + (lane & 3) * 8 + (4 * hi + ((lane & 15) >> 2)) * 64;
#pragma unroll
            for (int d = 0; d < 2; ++d)
#pragma unroll
                for (int kk = 0; kk < 4; ++kk) {
                    const s16x4 lo = __builtin_bit_cast(s16x4, __builtin_amdgcn_ds_read_tr16_b64_v4i16((LAS v4i16_t*)(vb + d * 4096 + kk * 1024)));
                    const s16x4 hh = __builtin_bit_cast(s16x4, __builtin_amdgcn_ds_read_tr16_b64_v4i16((LAS v4i16_t*)(vb + d * 4096 + kk * 1024 + 512)));
                    const bf16x8 vf = (bf16x8){lo[0], lo[1], lo[2], lo[3], hh[0], hh[1], hh[2], hh[3]};
                    o[d] = __builtin_amdgcn_mfma_f32_32x32x16_bf16(vf, __builtin_bit_cast(bf16x8, pw[kk]), o[d], 0, 0, 0);
                }
        }
        lrun = halfsum(lrun);
        const float inv = 1.0f / lrun;
        if (hi == 0) cur.lse[(size_t)(cur.orow0 + ((jw + r32) << cur.odl)) * 4] = (mrun + __builtin_amdgcn_logf(lrun)) * LN2;
        LAS unsigned char* stw = lds + OFF_O + wid * (32 * PITCH);
#pragma unroll
        for (int d = 0; d < 2; ++d)
#pragma unroll
            for (int i4 = 0; i4 < 4; ++i4) {
                u32x2 w; w.x = pk2(o[d][4 * i4] * inv, o[d][4 * i4 + 1] * inv); w.y = pk2(o[d][4 * i4 + 2] * inv, o[d][4 * i4 + 3] * inv);
                *(LAS u32x2*)(stw + r32 * PITCH + (32 * d + 8 * i4 + 4 * hi) * 2) = w;
            }
#pragma unroll
        for (int it = 0; it < 4; ++it) {
            const int row = it * 8 + (lane >> 3), ch = lane & 7;
            const u32x4 v = *(const LAS u32x4*)(stw + row * PITCH + ch * 16);
            const int mrow = cur.orow0 + ((jw + row) << cur.odl);
            *(u32x4*)(cur.out + (size_t)mrow * 256 + ch * 8) = v;
        }
        __syncthreads();
        cur = nxt;
    }
#undef DIL_LOAD
}

__device__ __forceinline__ void memnorm_unit(LAS unsigned char* lds, bf16_t* tiles, const float* gain, const float* gain2, float scale) {
    int tid = threadIdx.x; asm volatile("" : "+v"(tid));
    const int lane = tid & 63, wid = tid >> 6;
    LAS float* part = (LAS float*)lds;
    u32x4 raw[4][2];
#pragma unroll
    for (int t = 0; t < 4; ++t) { raw[t][0] = *(const u32x4*)(tiles + (size_t)t * 8192 + (2 * wid) * 512 + lane * 8); raw[t][1] = *(const u32x4*)(tiles + (size_t)t * 8192 + (2 * wid + 1) * 512 + lane * 8); }
#pragma unroll
    for (int t = 0; t < 4; ++t) {
        f32x4 a0, a1, b0, b1; unpack8(raw[t][0], a0, a1); unpack8(raw[t][1], b0, b1);
        float ss = 0.f;
#pragma unroll
        for (int e = 0; e < 4; ++e) ss += a0[e] * a0[e] + a1[e] * a1[e] + b0[e] * b0[e] + b1[e] * b1[e];
        part[(t * 8 + wid) * 64 + lane] = ss;
    }
    __syncthreads();
    const f32x4 g0 = *(const f32x4*)(gain + 16 * wid) * *(const f32x4*)(gain2 + 16 * wid), g1 = *(const f32x4*)(gain + 16 * wid + 4) * *(const f32x4*)(gain2 + 16 * wid + 4),
                g2 = *(const f32x4*)(gain + 16 * wid + 8) * *(const f32x4*)(gain2 + 16 * wid + 8), g3 = *(const f32x4*)(gain + 16 * wid + 12) * *(const f32x4*)(gain2 + 16 * wid + 12);
#pragma unroll
    for (int t = 0; t < 4; ++t) {
        float tot = 0.f;
#pragma unroll
        for (int w = 0; w < 8; ++w) tot += part[(t * 8 + w) * 64 + lane];
        const float rstd = __builtin_amdgcn_rsqf(tot * (1.0f / 128.0f) + EPS_) * scale;
        f32x4 a0, a1, b0, b1; unpack8(raw[t][0], a0, a1); unpack8(raw[t][1], b0, b1);
        *(u32x4*)(tiles + (size_t)t * 8192 + (2 * wid) * 512 + lane * 8) = pack8(a0 * g0 * rstd, a1 * g1 * rstd);
        *(u32x4*)(tiles + (size_t)t * 8192 + (2 * wid + 1) * 512 + lane * 8) = pack8(b0 * g2 * rstd, b1 * g3 * rstd);
    }
    __syncthreads();
}

__device__ __forceinline__ void cumsum_unit(LAS unsigned char* lds, const float* logf, float* c2, int bh, const float* gq, const float* gk, int* lo_tab) {
    const int tid = threadIdx.x, lane = tid & 63, wid = tid >> 6, b = bh >> 3, h = bh & 7;
    LAS float* wt = (LAS float*)lds;
    LAS float* wstart = (LAS float*)(lds + 64); LAS float* wend = (LAS float*)(lds + 64 + 256);
    float v[8]; float run = 0.f;
#pragma unroll
    for (int k = 0; k < 8; ++k) { run += logf[(size_t)(b * 4096 + tid * 8 + k) * 8 + h]; v[k] = run; }
    float inc = run;
#pragma unroll
    for (int o = 1; o < 64; o <<= 1) { const float t = __shfl_up(inc, o); if (lane >= o) inc += t; }
    if (lane == 63) wt[wid] = inc;
    __syncthreads();
    float pre = inc - run;
    for (int w = 0; w < wid; ++w) pre += wt[w];
#pragma unroll
    for (int k = 0; k < 8; ++k) c2[(size_t)bh * 4096 + tid * 8 + k] = (pre + v[k]) * LOG2E;
    if ((tid & 7) == 0) wstart[tid >> 3] = (pre + v[0]) * LOG2E;
    if ((tid & 7) == 7) wend[tid >> 3] = (pre + v[7]) * LOG2E;
    __syncthreads();
    float gqm = 0.f, gkm = 0.f;
    for (int i = 0; i < 64; ++i) { gqm = fmaxf(gqm, fabsf(gq[i])); gkm = fmaxf(gkm, fabsf(gk[i])); }
    const float smax = 64.0f * QSCALE * gqm * gkm * 1.02f;
    if (tid < 16) {
        const float cq0 = wstart[4 * tid]; int lo = 0;
        while (lo < 4 * tid && smax + cq0 - wend[lo] + smax < -135.0f) ++lo;
        lo_tab[bh * 16 + tid] = lo;
    }
    if (bh == 0 && tid == 0) ((float*)lo_tab)[1024] = smax;
    __syncthreads();
}

__device__ __forceinline__ void merge_unit(const bf16_t* DIL, const float* LSE, bf16_t* Y, int u) {
    const int tid = threadIdx.x;
#pragma unroll
    for (int k = 0; k < 4; ++k) {
        const int it = tid + 512 * k, row = 64 * u + (it >> 5), c8 = it & 31, h = c8 >> 3;
        const float l0 = LSE[(size_t)row * 4 + h], l1 = LSE[(size_t)(M_ + row) * 4 + h], l2 = LSE[(size_t)(2 * M_ + row) * 4 + h];
        const float mx = fmaxf(l0, fmaxf(l1, l2));
        float w0 = __expf(l0 - mx), w1 = __expf(l1 - mx), w2 = __expf(l2 - mx);
        const float inv = 1.0f / (w0 + w1 + w2); w0 *= inv; w1 *= inv; w2 *= inv;
        f32x4 a0, a1, b0, b1, c0, c1;
        unpack8(*(const u32x4*)(DIL + (size_t)row * 256 + c8 * 8), a0, a1);
        unpack8(*(const u32x4*)(DIL + (size_t)(M_ + row) * 256 + c8 * 8), b0, b1);
        unpack8(*(const u32x4*)(DIL + (size_t)(2 * M_ + row) * 256 + c8 * 8), c0, c1);
        *(u32x4*)(Y + (size_t)row * 1280 + c8 * 8) = pack8(a0 * w0 + b0 * w1 + c0 * w2, a1 * w0 + b1 * w1 + c1 * w2);
    }
}

__device__ __forceinline__ float wave_sum(float v) {
#pragma unroll
    for (int o = 1; o < 64; o <<= 1) v += __shfl_xor(v, o);
    return v;
}
__device__ __forceinline__ void cat_src(const Params& P, int n, const float*& base, int& ld, int& col) {
    const int tile = n >> 8, c = n & 255, bj = c >> 7, wc = (c >> 5) & 3, j = c & 31;
    if (tile < 15) {
        int colbase, head; bool rope = false;
        if (tile < 3) { colbase = 0; head = tile * 4 + wc; rope = true; }
        else if (tile < 6) { colbase = 768; head = (tile - 3) * 4 + wc; rope = true; }
        else if (tile < 9) { colbase = 1536; head = (tile - 6) * 4 + wc; }
        else if (tile < 11) { colbase = 2304; head = (tile - 9) * 4 + wc; }
        else if (tile < 13) { colbase = 2816; head = (tile - 11) * 4 + wc; }
        else { colbase = 3328; head = (tile - 13) * 4 + wc; }
        const int p = 32 * bj + j; const int d = (rope && p < 16) ? ((p & 3) + 4 * ((p >> 3) & 1) + 8 * ((p >> 2) & 1)) : p;
        base = P.in[3]; ld = 4360; col = colbase + head * 64 + d;
    } else if (tile < 17) { base = P.in[3]; ld = 4360; col = 3848 + (2 * (tile - 15) + bj) * 128 + 32 * wc + j; }
    else if (tile < 29) { base = P.in[13]; ld = 3072; col = n - 4352; }
    else if (tile < 31) { base = P.in[10]; ld = 1024; col = (2 * (tile - 29) + bj) * 128 + 32 * wc + j; }
    else { base = P.in[10]; ld = 1024; col = 512 + (2 * (tile - 31) + bj) * 128 + 32 * wc + j; }
}
__device__ __forceinline__ void transpose_item(const float* srcp  , int ldsrc, int k0, const float* kscale, bf16_t* dst, int ldd, int drow0, int dcol0,
                                               LAS float* scr, int lane) {
    float tv[32];
#pragma unroll
    for (int i = 0; i < 32; ++i) { const int kk = 2 * i + (lane >> 5); tv[i] = srcp[(size_t)(k0 + kk) * ldsrc]; }
    if (kscale) {
#pragma unroll
        for (int i = 0; i < 32; ++i) tv[i] *= kscale[k0 + 2 * i + (lane >> 5)];
    }
#pragma unroll
    for (int i = 0; i < 32; ++i) scr[(2 * i + (lane >> 5)) * 33 + (lane & 31)] = tv[i];
    asm volatile("s_waitcnt lgkmcnt(0)" ::: "memory");
    const int c = lane & 7;
#pragma unroll
    for (int jx = 0; jx < 4; ++jx) { const int n = (lane >> 3) + 8 * jx; const LAS float* s = scr + (8 * c) * 33 + n;
        u32x4 o; o.x = pk2(s[0 * 33], s[1 * 33]); o.y = pk2(s[2 * 33], s[3 * 33]); o.z = pk2(s[4 * 33], s[5 * 33]); o.w = pk2(s[6 * 33], s[7 * 33]);
        *(u32x4*)(dst + (size_t)(drow0 + n) * ldd + dcol0 + k0 + 8 * c) = o; }
    asm volatile("s_waitcnt lgkmcnt(0)" ::: "memory");
}

constexpr int TR_I_CAT = 16 * 264, TR_NITEMS = TR_I_CAT + 4 * 32 + 8 * 32 + 8 * 32 + 16 * 32 + 16 * 128 + 64 * 32;
__device__ __forceinline__ void weight_transposes(const Params& P, LAS float* scr, int lane, int widx, int nw, int item_lo, int item_hi) {
    unsigned char* ws = P.ws;
    constexpr int I_CAT = 16 * 264, I_BA = 4 * 32, I_BB = 8 * 32, I_BM = 8 * 32, I_OUT = 16 * 32, I_UP = 16 * 128, I_DN = 64 * 32;
    bf16_t* WCAT = (bf16_t*)(ws + WS_WCAT); bf16_t* WBR = (bf16_t*)(ws + WS_WBR); bf16_t* WOUT = (bf16_t*)(ws + WS_WOUT); bf16_t* WUP = (bf16_t*)(ws + WS_WUP); bf16_t* WDN = (bf16_t*)(ws + WS_WDN);
    for (int it = item_lo + widx; it < item_hi; it += nw) {
        int r = it;
        if (r < I_CAT) { const int kb = r / 264, nb = r % 264; const float* base; int ld, col; cat_src(P, nb * 32 + (lane & 31), base, ld, col);
            transpose_item(base + col, ld, kb * 64, nullptr, WCAT, 1024, nb * 32, 0, scr, lane); continue; }
        r -= I_CAT;
        if (r < I_BA) { const int kb = r / 32, nb = r % 32; transpose_item(P.in[15] + nb * 32 + (lane & 31), 1024, kb * 64, nullptr, WBR, 1280, nb * 32, 0, scr, lane); continue; }
        r -= I_BA;
        if (r < I_BB) { const int kb = r / 32, nb = r % 32; transpose_item(P.in[16] + nb * 32 + (lane & 31), 1024, kb * 64, nullptr, WBR, 1280, nb * 32, 256, scr, lane); continue; }
        r -= I_BB;
        if (r < I_BM) { const int kb = r / 32, nb = r % 32; transpose_item(P.in[17] + nb * 32 + (lane & 31), 1024, kb * 64, nullptr, WBR, 1280, nb * 32, 768, scr, lane); continue; }
        r -= I_BM;
        if (r < I_OUT) { const int kb = r / 32, nb = r % 32; transpose_item(P.in[18] + nb * 32 + (lane & 31), 1024, kb * 64, nullptr, WOUT, 1024, nb * 32, 0, scr, lane); continue; }
        r -= I_OUT;
        if (r < I_UP) { const int kb = r / 128, nb = r % 128; transpose_item(P.in[20] + nb * 32 + (lane & 31), 4096, kb * 64, P.in[19], WUP, 1024, nb * 32, 0, scr, lane); continue; }
        r -= I_UP;
        { const int kb = r / 32, nb = r % 32; transpose_item(P.in[21] + nb * 32 + (lane & 31), 1024, kb * 64, nullptr, WDN, 4096, nb * 32, 0, scr, lane); }
    }
}

__device__ __forceinline__ void p0_prologue(const Params& P, LAS unsigned char* lds, int vcu, int G) {
    const int tid = threadIdx.x, lane = tid & 63, wave = tid >> 6;
    unsigned char* ws = P.ws;
    const float* w_in = P.in[3];
    LAS float* wfl = (LAS float*)(lds + 73728);
    { float wv[16], gv[16];
#pragma unroll
      for (int j = 0; j < 16; ++j) { const int i = tid + 512 * j, k = i >> 3, c = i & 7; wv[j] = w_in[(size_t)k * 4360 + 3840 + c]; gv[j] = P.in[2][k]; }
#pragma unroll
      for (int j = 0; j < 16; ++j) { const int i = tid + 512 * j, k = i >> 3, c = i & 7; wfl[c * 1024 + k] = wv[j] * gv[j]; } }
    const int gtid = vcu * 512 + tid, GT = G * 512;
    { float* ssq = (float*)(ws + WS_SSQ); for (int i = gtid; i < M_; i += GT) ssq[i] = 0.f;
      float* ssqq = (float*)(ws + WS_SSQQ); for (int i = gtid; i < M_ * 4; i += GT) ssqq[i] = 0.f; }
    { float* cosT = (float*)(ws + WS_COS); float* sinT = (float*)(ws + WS_SIN);
      for (int i = gtid; i < 4096 * 8; i += GT) { const int t = i >> 3, f = i & 7; const float inv = powf(500000.0f, -(float)(2 * f) / 16.0f); const float ang = (float)t * inv; cosT[i] = cosf(ang); sinT[i] = sinf(ang); } }
    LAS float* scr = (LAS float*)(lds + wave * 8448);
    const int gw = vcu * 8 + wave, NGW = G * 8;
    weight_transposes(P, scr, lane, gw, NGW, 0, TR_I_CAT);
    __syncthreads();
    bf16_t* AALL = (bf16_t*)P.out;
    float* logf = (float*)(ws + WS_LOGF);
    const float* bfv = P.in[4];
    constexpr int RB = 2;
    for (int base = gw * RB; base < M_ + 2048; base += NGW * RB) {
        const bool ismem = base >= M_;
        const float* xb = ismem ? P.in[1] + (size_t)(base - M_) * 1024 : P.in[0] + (size_t)base * 1024;
        const float* gp = ismem ? P.in[9] : P.in[2];
        f32x4 v[RB][4];
#pragma unroll
        for (int r = 0; r < RB; ++r)
#pragma unroll
            for (int j = 0; j < 4; ++j) v[r][j] = ((const f32x4*)(xb + (size_t)r * 1024))[lane + 64 * j];
        float ssq[RB], red[RB];
#pragma unroll
        for (int r = 0; r < RB; ++r) { float s = 0.f;
#pragma unroll
            for (int j = 0; j < 4; ++j) s += (v[r][j][0] * v[r][j][0] + v[r][j][1] * v[r][j][1]) + (v[r][j][2] * v[r][j][2] + v[r][j][3] * v[r][j][3]);
            ssq[r] = s; red[r] = 0.f; }
        if (!ismem) {
            float a[RB][8];
#pragma unroll
            for (int c = 0; c < 8; ++c) {
                f32x4 w[4];
#pragma unroll
                for (int j = 0; j < 4; ++j) w[j] = ((const LAS f32x4*)(wfl + c * 1024))[lane + 64 * j];
#pragma unroll
                for (int r = 0; r < RB; ++r) { float t = 0.f;
#pragma unroll
                    for (int j = 0; j < 4; ++j) t += (v[r][j][0] * w[j][0] + v[r][j][1] * w[j][1]) + (v[r][j][2] * w[j][2] + v[r][j][3] * w[j][3]);
                    a[r][c] = t; }
            }
#pragma unroll
            for (int r = 0; r < RB; ++r) {
                float b4[4], b2[2];
#pragma unroll
                for (int i = 0; i < 4; ++i) { const float keep = (lane & 32) ? a[r][i + 4] : a[r][i], send = (lane & 32) ? a[r][i] : a[r][i + 4]; b4[i] = keep + __shfl_xor(send, 32); }
#pragma unroll
                for (int i = 0; i < 2; ++i) { const float keep = (lane & 16) ? b4[i + 2] : b4[i], send = (lane & 16) ? b4[i] : b4[i + 2]; b2[i] = keep + __shfl_xor(send, 16); }
                { const float keep = (lane & 8) ? b2[1] : b2[0], send = (lane & 8) ? b2[0] : b2[1]; red[r] = keep + __shfl_xor(send, 8); }
            }
#pragma unroll
            for (int o = 4; o >= 1; o >>= 1)
#pragma unroll
                for (int r = 0; r < RB; ++r) red[r] += __shfl_xor(red[r], o);
        }
#pragma unroll
        for (int o = 1; o < 64; o <<= 1)
#pragma unroll
            for (int r = 0; r < RB; ++r) ssq[r] += __shfl_xor(ssq[r], o);
#pragma unroll
        for (int r = 0; r < RB; ++r) {
            const float rstd = 1.0f / sqrtf(ssq[r] * (1.0f / 1024.0f) + EPS_);
#pragma unroll
            for (int j = 0; j < 4; ++j) { const f32x4 g = ((const f32x4*)gp)[lane + 64 * j]; const f32x4 y = v[r][j] * rstd * g;
                u32x2 w; w.x = pk2(y[0], y[1]); w.y = pk2(y[2], y[3]); ((u32x2*)(AALL + (size_t)(base + r) * 1024))[lane + 64 * j] = w; }
            if (!ismem && (lane & 7) == 0) { const int c = lane >> 3; const float z = red[r] * rstd + bfv[c]; logf[(size_t)(base + r) * 8 + c] = fminf(z, 0.f) - log1pf(expf(-fabsf(z))); }
        }
    }
}


#define XB_TMO      128
#define XB_XCNT(j)  (256  + 64 * (j))
#define XB_XSUB(j)  (1280 + 64 * (j))
#define XB_XGEN(j)  (2304 + 64 * (j))
#define XB_TOP      3328
#define XB_TOPGEN   3392
#define XCD_BAR_WORDS 3456
#define XB_SPIN_CAP (1u << 20)
__device__ __forceinline__ unsigned xb_ld(unsigned* p)              { return __hip_atomic_load(p, __ATOMIC_RELAXED, __HIP_MEMORY_SCOPE_AGENT); }
__device__ __forceinline__ unsigned xb_add(unsigned* p, unsigned v) { return __hip_atomic_fetch_add(p, v, __ATOMIC_RELAXED, __HIP_MEMORY_SCOPE_AGENT); }
__device__ __forceinline__ unsigned xb_xcc_id() { return (unsigned)__builtin_amdgcn_s_getreg((3 << 11) | 20) & 0xFu; }
#define XB_SPIN(cond, bar) do { unsigned _sp = 0; while (cond) { __builtin_amdgcn_s_sleep(1); \
    if ((++_sp & 255u) == 0u) { if (xb_ld(&(bar)[XB_TMO])) break; if (_sp > XB_SPIN_CAP) { atomicAdd(&(bar)[XB_TMO], 1u); break; } } } } while (0)
struct XcdBarrier { unsigned* bar; unsigned x; volatile LAS unsigned* st; };
__device__ __forceinline__ XcdBarrier xcd_barrier_post(unsigned* bar, volatile LAS unsigned* st) {
    XcdBarrier b; b.bar = bar; b.x = xb_xcc_id(); b.st = st;
    if (threadIdx.x == 0) (void)xb_add(&bar[XB_XCNT(b.x)], 1u);
    return b;
}
__device__ __forceinline__ void xcd_barrier_complete(unsigned* bar, unsigned x, unsigned& nloc, unsigned& nx) {
    const unsigned G = gridDim.x * gridDim.y * gridDim.z;
    unsigned sum, cnt, mine, sp = 0u;
    for (;;) {
        sum = 0u; cnt = 0u; mine = 0u;
#pragma unroll
        for (unsigned j = 0; j < 16; ++j) { const unsigned c = xb_ld(&bar[XB_XCNT(j)]); sum += c; cnt += (c > 0u) ? 1u : 0u; mine = (j == x) ? c : mine; }
        if (sum == G) break;
        __builtin_amdgcn_s_sleep(1);
        if ((++sp & 255u) == 0u) { if (xb_ld(&bar[XB_TMO])) break; if (sp > XB_SPIN_CAP) { atomicAdd(&bar[XB_TMO], 1u); break; } }
    }
    nloc = mine > 0u ? mine : 1u; nx = cnt > 0u ? cnt : 1u;
}
__device__ __forceinline__ void xcd_barrier(const XcdBarrier& b) {
    asm volatile("s_waitcnt vmcnt(0)" ::: "memory");
    __syncthreads();
    if (threadIdx.x == 0) {
        unsigned* bar = b.bar;
        __builtin_amdgcn_s_waitcnt(0);
        unsigned nloc = b.st[0], nx = b.st[1];
        if (nloc == 0u) { xcd_barrier_complete(bar, b.x, nloc, nx); b.st[0] = nloc; b.st[1] = nx; }
        const unsigned old = xb_add(&bar[XB_XSUB(b.x)], 1u);
        const unsigned gen = old / nloc;
        if (old + 1u == (gen + 1u) * nloc) {
            __builtin_amdgcn_fence(__ATOMIC_RELEASE, "agent");
            asm volatile("s_waitcnt vmcnt(0)" ::: "memory");
            const unsigned og = xb_add(&bar[XB_TOP], 1u);
            const unsigned tg = og / nx;
            if (og + 1u == (tg + 1u) * nx) xb_add(&bar[XB_TOPGEN], 1u);
            else XB_SPIN(xb_ld(&bar[XB_TOPGEN]) == tg, bar);
            __builtin_amdgcn_fence(__ATOMIC_ACQUIRE, "agent");
            xb_add(&bar[XB_XGEN(b.x)], 1u);
            asm volatile("s_waitcnt vmcnt(0)" ::: "memory");
        } else {
            XB_SPIN(xb_ld(&bar[XB_XGEN(b.x)]) == gen, bar);
            __builtin_amdgcn_fence(__ATOMIC_ACQUIRE, "agent");
            asm volatile("s_waitcnt vmcnt(0)" ::: "memory");
        }
    }
    __syncthreads();
}

__global__ void __launch_bounds__(512, 2) mk_fwd(Params P) {
    extern __shared__ __attribute__((aligned(16))) unsigned char lds_raw[];
    LAS unsigned char* lds = (LAS unsigned char*)lds_raw;
    const int G = gridDim.x, bx = blockIdx.x;
    const int vcu = (G % 8 == 0) ? (bx % 8) * (G / 8) + bx / 8 : bx;
    unsigned char* ws = P.ws;
    const int lo = P.ph_lo, hi = P.ph_hi;
#ifndef PHASE_MASK
#define PHASE_MASK 255
#endif
#define IN(k) (((PHASE_MASK >> (k)) & 1) && lo <= (k) && (k) < hi)
#define SEAM(k) do { if (IN(k) && IN((k) + 1)) { if ((k) == 0) cg::this_grid().sync(); else xcd_barrier(xbar); } } while (0)
    volatile LAS unsigned* xst = (volatile LAS unsigned*)(lds + LDS_BYTES - 64);
    if (threadIdx.x < 2) xst[threadIdx.x] = 0u;
    __syncthreads();
    XcdBarrier xbar; xbar.bar = (unsigned*)(ws + WS_BAR); xbar.x = 0; xbar.st = xst;
    if (hi - lo > 1) xbar = xcd_barrier_post((unsigned*)(ws + WS_BAR), xst);
    bf16_t* AALL = (bf16_t*)P.out;
    bf16_t* DIL = (bf16_t*)((unsigned char*)P.out + DO_DIL);
    bf16_t* Y = (bf16_t*)((unsigned char*)P.out + DO_Y);
    float* LSE = (float*)(ws + WS_LSE);
    float* C2 = (float*)(ws + WS_C2);

    if (IN(0)) { p0_prologue(P, lds, vcu, G); }
    SEAM(0);
    if (IN(1)) {
        if (G >= 224 && bx >= G - 64) cumsum_unit(lds, (const float*)(ws + WS_LOGF), C2, bx - (G - 64), P.in[7], P.in[8], (int*)(ws + WS_LO));
        pg8::Gemm g{AALL, (const bf16_t*)(ws + WS_WCAT), 1024, 1024};
        SchedP1 S{G, bx};
        EpiP1 E{(bf16_t*)(ws + WS_QA), (bf16_t*)(ws + WS_KA), (bf16_t*)(ws + WS_VA), (bf16_t*)(ws + WS_QB), (bf16_t*)(ws + WS_KB), (bf16_t*)(ws + WS_VB), (bf16_t*)(ws + WS_QM),
                (bf16_t*)(ws + WS_KM), (bf16_t*)(ws + WS_VM), (unsigned char*)(ws + WS_GATES), (float*)(ws + WS_SSQQ), P.in[5], P.in[6], P.in[7], P.in[8], P.in[14], (const float*)(ws + WS_COS), (const float*)(ws + WS_SIN)};
        pg8::gemm_phase<EpiP1, SchedP1>(lds, g, S, E);
        {
            const int maxu = (3744 + G - 1) / G; int first_short = 3744 - (maxu - 1) * G; if (first_short >= G) first_short = 0;
            if (bx >= first_short) {
                const int tid_ = threadIdx.x, wave_ = tid_ >> 6, lane_ = tid_ & 63;
                weight_transposes(P, (LAS float*)(lds + wave_ * 8448), lane_, (bx - first_short) * 8 + wave_, (G - first_short) * 8, TR_I_CAT, TR_NITEMS);
            }
        }
    }
    SEAM(1);
    if (IN(2)) {
        dil_phase(lds, ws, DIL, LSE, bx, G);
        for (int L = bx; L < 32 + 64; L += G) {
            if (L < 32) {
                memnorm_unit(lds, (bf16_t*)(ws + WS_KM) + (size_t)L * 4 * 8192, P.in[12], P.in[11], 1.0f);
            } else if (G < 224) {
                cumsum_unit(lds, (const float*)(ws + WS_LOGF), C2, L - 32, P.in[7], P.in[8], (int*)(ws + WS_LO));
            }
        }
    }
    SEAM(2);
    if (IN(3)) {
        const int* LO = (const int*)(ws + WS_LO); const float smax_fox = ((const float*)LO)[1024];
        unsigned* qctr = (unsigned*)(ws + WS_QCTR);
        volatile LAS int* qslot = (volatile LAS int*)(lds + LDS_BYTES - 128);
        for (;;) {
            if (threadIdx.x == 0) *qslot = (int)__hip_atomic_fetch_add(qctr, 1u, __ATOMIC_RELAXED, __HIP_MEMORY_SCOPE_AGENT);
            __syncthreads();
            const int L = __builtin_amdgcn_readfirstlane(*qslot);
            __syncthreads();
            if (L >= 2048) break;
            if (L < 1024) {
                const int qblk = 15 - (L >> 6), bh = L & 63, b = bh >> 3, h = bh & 7;
                const size_t Rs = (size_t)bh << 12;
                attn_unit<64, 1>(lds, (const bf16_t*)(ws + WS_QB) + Rs * 64, (const bf16_t*)(ws + WS_KB) + Rs * 64, (const bf16_t*)(ws + WS_VB) + Rs * 64, C2 + Rs, qblk,
                                 Y + 256 + h * 64, 1280, b * 4096, 0, nullptr, LO[bh * 16 + qblk], smax_fox);
            } else if (L < 1536) {
                const int u = L - 1024, bh = u >> 4, qblk = u & 15, b = bh >> 2, h = bh & 3;
                attn_unit<128, 2>(lds, (const bf16_t*)(ws + WS_QM) + ((size_t)bh << 12) * 128, (const bf16_t*)(ws + WS_KM) + ((size_t)bh << 8) * 128, (const bf16_t*)(ws + WS_VM) + ((size_t)bh << 8) * 128,
                                  (const float*)(ws + WS_SSQQ) + (size_t)b * 4096 * 4 + h, qblk, Y + 768 + h * 128, 1280, b * 4096, 0, nullptr, 0, 0.f);
            } else {
                merge_unit(DIL, LSE, Y, L - 1536);
            }
        }
    }
    SEAM(3);
    if (IN(4)) {
        pg8::Gemm g{Y, (const bf16_t*)(ws + WS_WBR), 1280, 1280};
        SchedP3 S{G, bx};
        EpiMerge E{(const unsigned char*)(ws + WS_GATES), (bf16_t*)(ws + WS_MERGED)};
        pg8::gemm_phase<EpiMerge, SchedP3>(lds, g, S, E);
    }
    SEAM(4);
    if (IN(5)) {
        pg8::Gemm g{(const bf16_t*)(ws + WS_MERGED), (const bf16_t*)(ws + WS_WOUT), 1024, 1024};
        SchedSimple S{G, bx, 4, 16};
        EpiOut E{P.in[0], P.out, (bf16_t*)(ws + WS_X1B), (float*)(ws + WS_SSQ)};
        pg8::gemm_phase<EpiOut, SchedSimple>(lds, g, S, E);
    }
    SEAM(5);
    if (IN(6)) {
        pg8::Gemm g{(const bf16_t*)(ws + WS_X1B), (const bf16_t*)(ws + WS_WUP), 1024, 1024};
        SchedSimple S{G, bx, 16, 16};
        EpiUp E{(const float*)(ws + WS_SSQ), (bf16_t*)(ws + WS_HMID)};
        pg8::gemm_phase<EpiUp, SchedSimple>(lds, g, S, E);
    }
    SEAM(6);
    if (IN(7)) {
        pg8::Gemm g{(const bf16_t*)(ws + WS_HMID), (const bf16_t*)(ws + WS_WDN), 4096, 4096};
        SchedSimple S{G, bx, 4, 64};
        EpiDown E{P.out, (const bf16_t*)(ws + WS_X1B)};
        pg8::gemm_phase<EpiDown, SchedSimple>(lds, g, S, E);
    }
#undef IN
#undef SEAM
}

extern "C" void kernel_launch(void* const* d_in, const int* in_sizes, int n_in, void* d_out, int out_size, void* d_ws, size_t ws_size, hipStream_t stream) {
    static int grid = 0;
    if (grid == 0) {
        if (n_in != 22 || in_sizes[0] != M_ * DM || out_size != M_ * DM || ws_size < WS_END) {
            fprintf(stderr, "kernel_launch: unexpected shapes (n_in %d, in0 %d, out %d, ws %zu); nothing launched\n", n_in, n_in > 0 ? in_sizes[0] : -1, out_size, ws_size); grid = -1; return; }
        int dev = 0, cus = 0, per_cu = 0;
        if (hipGetDevice(&dev) != hipSuccess || hipDeviceGetAttribute(&cus, hipDeviceAttributeMultiprocessorCount, dev) != hipSuccess) { grid = -1; return; }
        if (hipFuncSetAttribute((const void*)mk_fwd, hipFuncAttributeMaxDynamicSharedMemorySize, LDS_BYTES) != hipSuccess) { fprintf(stderr, "kernel_launch: hipFuncSetAttribute failed\n"); grid = -1; return; }
        if (hipOccupancyMaxActiveBlocksPerMultiprocessor(&per_cu, (const void*)mk_fwd, 512, LDS_BYTES) != hipSuccess || per_cu < 1) { fprintf(stderr, "kernel_launch: occupancy query gave %d\n", per_cu); (void)hipGetLastError(); grid = -1; return; }
        grid = cus * 1;
    }
    if (grid < 0) return;
    if (hipMemsetAsync((char*)d_ws + WS_BAR, 0, WS_BAR_BYTES, stream) != hipSuccess) { fprintf(stderr, "kernel_launch: hipMemsetAsync failed\n"); return; }
    Params p{};
    for (int i = 0; i < 22; ++i) p.in[i] = (const float*)d_in[i];
    p.out = (float*)d_out; p.ws = (unsigned char*)d_ws;
#if MK_MULTI
    for (int ph = 0; ph < NPH; ++ph) { p.ph_lo = ph; p.ph_hi = ph + 1; hipLaunchKernelGGL(mk_fwd, dim3(grid), dim3(512), LDS_BYTES, stream, p); }
#else
    p.ph_lo = 0; p.ph_hi = NPH;
    void* args[] = {&p};
    hipError_t e = hipLaunchCooperativeKernel((const void*)mk_fwd, dim3(grid), dim3(512), args, LDS_BYTES, stream);
    if (e != hipSuccess) fprintf(stderr, "cooperative launch failed: %s (grid %d)\n", hipGetErrorString(e), grid);
#endif
}
```

```cpp
#include <hip/hip_runtime.h>
#include <hip/hip_cooperative_groups.h>
#include <cstdio>
#include <cstdint>
namespace cg = cooperative_groups;

#ifndef MK_MULTI
#define MK_MULTI 0
#endif

#define LAS __attribute__((address_space(3)))
typedef unsigned short bf16_t;
typedef short bf16x8 __attribute__((ext_vector_type(8)));
typedef short s16x4 __attribute__((ext_vector_type(4)));
typedef float f32x4 __attribute__((ext_vector_type(4)));
typedef float f32x16 __attribute__((ext_vector_type(16)));
typedef unsigned u32x4 __attribute__((ext_vector_type(4)));
typedef unsigned u32x2 __attribute__((ext_vector_type(2)));

constexpr int B_ = 8, T_ = 4096, DM = 1024, M_ = B_ * T_;
constexpr int NPH = 8;
constexpr float EPS_ = 1e-6f;
constexpr float LOG2E = 1.4426950408889634f, LN2 = 0.6931471805599453f;
constexpr float QSCALE = 0.125f * LOG2E;
constexpr float QSCALE_M = 0.08838834764831845f * LOG2E;

constexpr size_t MiB = 1u << 20;
constexpr size_t WS_SSQ = 0, WS_COS = 256 * 1024, WS_SIN = 384 * 1024, WS_BAR = 512 * 1024, WS_BAR_BYTES = 16384, WS_QCTR = WS_BAR + 15 * 1024;
constexpr size_t WS_LOGF = 1 * MiB, WS_C2 = 2 * MiB, WS_LSE = 3 * MiB, WS_LO = 4 * MiB + 768 * 1024;
constexpr size_t WS_WCAT = 5 * MiB, WS_WBR = 22 * MiB, WS_WOUT = 25 * MiB, WS_WUP = 27 * MiB, WS_WDN = 35 * MiB;
constexpr size_t WS_KM = 43 * MiB, WS_VM = 45 * MiB, WS_SSQQ = 47 * MiB;
constexpr size_t WS_QA = 48 * MiB, WS_KA = 96 * MiB, WS_VA = 144 * MiB, WS_QB = 192 * MiB, WS_KB = 224 * MiB, WS_VB = 256 * MiB, WS_QM = 288 * MiB;
constexpr size_t WS_GATES = 320 * MiB, WS_END = 512 * MiB;
constexpr size_t WS_MERGED = 48 * MiB, WS_X1B = 320 * MiB, WS_HMID = 48 * MiB;
constexpr size_t DO_DIL = 0, DO_Y = 48 * MiB;
constexpr int LDS_BYTES = 147456;

struct Params { const float* in[22]; float* out; unsigned char* ws; int ph_lo, ph_hi; };

__device__ __forceinline__ unsigned pk2(float lo, float hi) {
    typedef float f2 __attribute__((ext_vector_type(2))); typedef __bf16 b2 __attribute__((ext_vector_type(2)));
    f2 v = {lo, hi}; b2 b = __builtin_convertvector(v, b2); return __builtin_bit_cast(unsigned, b);
}
__device__ __forceinline__ float bf2f(unsigned short u) { return __uint_as_float(((unsigned)u) << 16); }
__device__ __forceinline__ u32x4 pack8(f32x4 a, f32x4 b) { u32x4 w; w.x = pk2(a[0], a[1]); w.y = pk2(a[2], a[3]); w.z = pk2(b[0], b[1]); w.w = pk2(b[2], b[3]); return w; }
__device__ __forceinline__ void unpack8(u32x4 w, f32x4& a, f32x4& b) {
    a[0] = __uint_as_float(w.x << 16); a[1] = __uint_as_float(w.x & 0xffff0000u); a[2] = __uint_as_float(w.y << 16); a[3] = __uint_as_float(w.y & 0xffff0000u);
    b[0] = __uint_as_float(w.z << 16); b[1] = __uint_as_float(w.z & 0xffff0000u); b[2] = __uint_as_float(w.w << 16); b[3] = __uint_as_float(w.w & 0xffff0000u);
}
__device__ __forceinline__ float sigmoidf_(float x) { return __builtin_amdgcn_rcpf(1.0f + __builtin_amdgcn_exp2f(-x * LOG2E)); }

namespace pg8 {
constexpr int BM = 256, BK = 64, HALF = 128, HTB = HALF * BK * 2, STAGE_BYTES = 8 * HTB, NXCD = 8, WGM = 8;
__host__ __device__ __forceinline__ int lds_byte(int r, int c) { const int st = (r >> 4) * 2 + (c >> 5), rr = r & 15, cc = c & 31, ob = rr * 64 + cc * 2; return st * 1024 + (ob ^ (((ob >> 9) & 1) << 5)); }
__host__ __device__ __forceinline__ void stage_rc(int b, int& R, int& C) { const int st = b / 1024, sb = b % 1024, swz = sb ^ (((sb >> 9) & 1) << 5); R = (st >> 1) * 16 + swz / 64; C = (st & 1) * 32 + (swz % 64) / 2; }
__host__ __device__ __forceinline__ int perm32(int rho) { const int n = rho >> 4, i = rho & 15; return 8 * (i >> 2) + 4 * n + (i & 3); }

struct Unit { int pm, pn, k0, nt, tag, first; };
struct Gemm { const bf16_t* A; const bf16_t* Bt; int lda, ldb; };

__device__ __forceinline__ void tile_order(int L, int nM, int nN, int& pm, int& pn) {
    const int nwg = nM * nN; int wgid = L;
    { const int q = nwg / NXCD, r = nwg % NXCD, xcd = wgid % NXCD, off = wgid / NXCD; wgid = (xcd < r ? xcd * (q + 1) : r * (q + 1) + (xcd - r) * q) + off; }
    const int nig = WGM * nN, gid = wgid / nig, fm = gid * WGM, gsz = (nM - fm) < WGM ? (nM - fm) : WGM;
    pm = fm + ((wgid % nig) % gsz); pn = (wgid % nig) / gsz;
}

template <class Epi, class Sched>
__device__ __forceinline__ void gemm_phase(LAS unsigned char* lds, const Gemm g, const Sched& S, const Epi& E) {
    const int tid = threadIdx.x, wid = __builtin_amdgcn_readfirstlane(tid >> 6), lane = tid & 63, wr = wid >> 2, wc = wid & 3, fr = lane & 15, fq = lane >> 4;
    unsigned voffA[2], voffB[2];
#pragma unroll
    for (int i = 0; i < 2; ++i) { int R, C; stage_rc(tid * 16 + i * 8192, R, C); const int Rb = (R & ~31) + perm32(R & 31);
        voffA[i] = (unsigned)(R * g.lda + C) * 2u; voffB[i] = (unsigned)(Rb * g.ldb + C) * 2u; }
    const size_t kstep = (size_t)(BK * 2);
    const size_t hstepA = (size_t)HALF * g.lda * 2, hstepB = (size_t)HALF * g.ldb * 2, tstepA = 2 * hstepA, tstepB = 2 * hstepB;
    const unsigned ldsw = (unsigned)wid * 1024u;
    const int aoff = lds_byte(wr * 64 + fr, fq * 8), boff = lds_byte(wc * 32 + fr, fq * 8);
#define PG8_SA(b, h) (((b) * 2 + (h)) * HTB)
#define PG8_SB(b, h) ((4 + (b) * 2 + (h)) * HTB)
#define PG8_STAGE(bufoff, gbase, voff) do { _Pragma("unroll") for (int _i = 0; _i < 2; ++_i) \
        __builtin_amdgcn_global_load_lds((const unsigned*)((const char*)(gbase) + (voff)[_i]), (LAS unsigned*)(lds + (bufoff) + ldsw + _i * 8192), 16, 0, 0); } while (0)
#define PG8_LDA(dst, b, h) do { _Pragma("unroll") for (int m = 0; m < 4; ++m) _Pragma("unroll") for (int k = 0; k < 2; ++k) dst[m][k] = *(const LAS bf16x8*)(lds + PG8_SA(b, h) + aoff + m * 2048 + k * 1024); } while (0)
#define PG8_LDB(dst, b, h) do { _Pragma("unroll") for (int n = 0; n < 2; ++n) _Pragma("unroll") for (int k = 0; k < 2; ++k) dst[n][k] = *(const LAS bf16x8*)(lds + PG8_SB(b, h) + boff + n * 2048 + k * 1024); } while (0)
#define PG8_MMA(ai, bj, At, Bt) do { __builtin_amdgcn_s_setprio(1); _Pragma("unroll") for (int m = 0; m < 4; ++m) _Pragma("unroll") for (int n = 0; n < 2; ++n) _Pragma("unroll") for (int k = 0; k < 2; ++k) \
        acc[ai][bj][m][n] = __builtin_amdgcn_mfma_f32_16x16x32_bf16(Bt[n][k], At[m][k], acc[ai][bj][m][n], 0, 0, 0); __builtin_amdgcn_s_setprio(0); } while (0)
#define PG8_WAIT_V(n) asm volatile("s_waitcnt vmcnt(" #n ")" ::: "memory")
#define PG8_WAIT_L(n) asm volatile("s_waitcnt lgkmcnt(" #n ")" ::: "memory")
#define PG8_BAR __builtin_amdgcn_s_barrier()
#define PG8_SCHED __builtin_amdgcn_sched_barrier(0)
    Unit cur, nxt; int ui = 0;
    if (!S.next(0, cur)) return;
    f32x4 acc[2][2][4][2];
#pragma unroll
    for (int a = 0; a < 2; ++a)
#pragma unroll
        for (int b = 0; b < 2; ++b)
#pragma unroll
            for (int m = 0; m < 4; ++m)
#pragma unroll
                for (int n = 0; n < 2; ++n) acc[a][b][m][n] = (f32x4){0.f, 0.f, 0.f, 0.f};
    bf16x8 At[4][2], B0[2][2], B1[2][2];
    const char* cA = (const char*)g.A + (size_t)cur.pm * tstepA + (size_t)cur.k0 * 2; const char* cB = (const char*)g.Bt + (size_t)cur.pn * tstepB + (size_t)cur.k0 * 2;
    PG8_STAGE(PG8_SB(0, 0), cB, voffB); PG8_STAGE(PG8_SB(0, 1), cB + hstepB, voffB); PG8_STAGE(PG8_SA(0, 0), cA, voffA); PG8_STAGE(PG8_SA(0, 1), cA + hstepA, voffA);
    if (wr == 1) PG8_BAR;
    PG8_WAIT_V(2); PG8_BAR;
    PG8_STAGE(PG8_SB(1, 0), cB + kstep, voffB); PG8_STAGE(PG8_SA(1, 0), cA + kstep, voffA); PG8_STAGE(PG8_SB(1, 1), cB + hstepB + kstep, voffB);
    PG8_WAIT_V(6); PG8_BAR;
    for (;;) {
        const bool has_next = S.next(ui + 1, nxt);
        const char* nA = has_next ? (const char*)g.A + (size_t)nxt.pm * tstepA + (size_t)nxt.k0 * 2 : cA; const char* nB = has_next ? (const char*)g.Bt + (size_t)nxt.pn * tstepB + (size_t)nxt.k0 * 2 : cB;
        const int nt = cur.nt;
        for (int t = 0; t < nt; t += 2) {
            const bool last = (t == nt - 2);
            const char* a1 = cA + (size_t)(t + 1) * kstep;
            const char* a2 = last ? nA : cA + (size_t)(t + 2) * kstep; const char* b2 = last ? nB : cB + (size_t)(t + 2) * kstep;
            const char* a3 = a2 + kstep; const char* b3 = b2 + kstep;
            PG8_LDB(B0, 0, 0); PG8_LDB(B1, 0, 1); PG8_SCHED; PG8_LDA(At, 0, 0); PG8_STAGE(PG8_SA(1, 1), a1 + hstepA, voffA);
            PG8_WAIT_V(8); PG8_WAIT_L(0); PG8_BAR; PG8_MMA(0, 0, At, B0); PG8_MMA(0, 1, At, B1); PG8_BAR; PG8_SCHED;
            PG8_LDA(At, 0, 1); PG8_STAGE(PG8_SB(0, 0), b2, voffB); PG8_STAGE(PG8_SB(0, 1), b2 + hstepB, voffB); PG8_STAGE(PG8_SA(0, 0), a2, voffA);
            PG8_WAIT_V(8); PG8_WAIT_L(0); PG8_BAR; PG8_MMA(1, 0, At, B0); PG8_MMA(1, 1, At, B1); PG8_BAR; PG8_SCHED;
            PG8_LDB(B0, 1, 0); PG8_LDB(B1, 1, 1); PG8_SCHED; PG8_LDA(At, 1, 0); PG8_STAGE(PG8_SA(0, 1), a2 + hstepA, voffA);
            PG8_WAIT_V(8); PG8_WAIT_L(0); PG8_BAR; PG8_MMA(0, 0, At, B0); PG8_MMA(0, 1, At, B1); PG8_BAR; PG8_SCHED;
            PG8_LDA(At, 1, 1); PG8_STAGE(PG8_SB(1, 0), b3, voffB); PG8_STAGE(PG8_SB(1, 1), b3 + hstepB, voffB); PG8_STAGE(PG8_SA(1, 0), a3, voffA);
            PG8_WAIT_V(8); PG8_WAIT_L(0); PG8_BAR; PG8_MMA(1, 0, At, B0); PG8_MMA(1, 1, At, B1); PG8_BAR; PG8_SCHED;
        }
        if (wr == 0) PG8_BAR;
        E(acc, cur, wr, wc, fr, fq);
        if (!has_next) break;
        if (nxt.first) {
#pragma unroll
            for (int a = 0; a < 2; ++a)
#pragma unroll
                for (int b = 0; b < 2; ++b)
#pragma unroll
                    for (int m = 0; m < 4; ++m)
#pragma unroll
                        for (int n = 0; n < 2; ++n) acc[a][b][m][n] = (f32x4){0.f, 0.f, 0.f, 0.f};
        }
        cur = nxt; cA = nA; cB = nB; ++ui;
        if (wr == 1) PG8_BAR;
    }
    PG8_WAIT_V(0);
    PG8_BAR;
#undef PG8_SA
#undef PG8_SB
#undef PG8_STAGE
#undef PG8_LDA
#undef PG8_LDB
#undef PG8_MMA
#undef PG8_WAIT_V
#undef PG8_WAIT_L
#undef PG8_BAR
#undef PG8_SCHED
}
}

typedef f32x4 Acc[2][2][4][2];

struct EpiP1 {
    bf16_t *QA, *KA, *VA, *QB, *KB, *VB, *QM, *KM, *VM; unsigned char* GATES8; float* SSQQ;
    const float *g_qA, *g_kA, *g_qB, *g_kB, *b_gate, *cosT, *sinT;

    __device__ __forceinline__ void norm64(Acc& acc, int rowbase, int wc, int fq, const float* gain, float scale, bool rope, bf16_t* base, int hpb, int h, int dl) const {
        const bool dorope = rope && fq < 2;
        const int db0 = dorope ? 4 * fq : 8 * fq, dn = dorope ? 8 : 4;
#pragma unroll
        for (int ai = 0; ai < 2; ++ai)
#pragma unroll
            for (int m = 0; m < 4; ++m) {
                const int mrow = rowbase + ai * 128 + m * 16, b = mrow >> 12, t = mrow & 4095;
                float ss = 0.f;
#pragma unroll
                for (int bj = 0; bj < 2; ++bj)
#pragma unroll
                    for (int n = 0; n < 2; ++n) { const f32x4 x = acc[ai][bj][m][n]; ss += (x[0] * x[0] + x[1] * x[1]) + (x[2] * x[2] + x[3] * x[3]); }
                ss += __shfl_xor(ss, 16); ss += __shfl_xor(ss, 32);
                const float rstd = __builtin_amdgcn_rsqf(ss * (1.0f / 64.0f) + EPS_) * scale;
                f32x4 y[2][2];
#pragma unroll
                for (int n = 0; n < 2; ++n) { y[0][n] = acc[ai][0][m][n] * rstd * *(const f32x4*)(gain + db0 + dn * n); y[1][n] = acc[ai][1][m][n] * rstd * *(const f32x4*)(gain + 32 + 8 * fq + 4 * n); }
                if (dorope) {
                    const f32x4 c4 = *(const f32x4*)(cosT + t * 8 + 4 * fq), s4 = *(const f32x4*)(sinT + t * 8 + 4 * fq);
                    const f32x4 x1 = y[0][0], x2 = y[0][1];
                    y[0][0] = x1 * c4 - x2 * s4; y[0][1] = x2 * c4 + x1 * s4;
                }
                const int r = t & ((1 << dl) - 1), j = t >> dl;
                const int R = ((b * hpb + h) << 12) + (r << (12 - dl)) + j;
                bf16_t* p = base + (size_t)(R >> 6) * 4096 + (R & 63) * 8 + fq * 512;
#pragma unroll
                for (int bj = 0; bj < 2; ++bj) *(u32x4*)(p + bj * 2048) = pack8(y[bj][0], y[bj][1]);
            }
    }
    __device__ __forceinline__ void v64(Acc& acc, int rowbase, int fq, bf16_t* base, int hpb, int h, int dl) const {
#pragma unroll
        for (int ai = 0; ai < 2; ++ai)
#pragma unroll
            for (int m = 0; m < 4; ++m) {
                const int mrow = rowbase + ai * 128 + m * 16, b = mrow >> 12, t = mrow & 4095;
                const int r = t & ((1 << dl) - 1), j = t >> dl;
                const int R = ((b * hpb + h) << 12) + (r << (12 - dl)) + j;
                bf16_t* p = base + (size_t)(R >> 6) * 4096 + (R & 63) * 32 + fq * 8;
#pragma unroll
                for (int bj = 0; bj < 2; ++bj) *(u32x4*)(p + bj * 2048) = pack8(acc[ai][bj][m][0], acc[ai][bj][m][1]);
            }
    }
    __device__ __forceinline__ void raw128(Acc& acc, int rowbase, int wc, int fq, bf16_t* base, int tl, int lg, bool isv, float* ssq) const {
#pragma unroll
        for (int ai = 0; ai < 2; ++ai)
#pragma unroll
            for (int m = 0; m < 4; ++m) {
                const int mrow = rowbase + ai * 128 + m * 16, b = mrow >> lg, t = mrow & ((1 << lg) - 1);
#pragma unroll
                for (int bj = 0; bj < 2; ++bj) {
                    if (ssq) {
                        const f32x4 x0 = acc[ai][bj][m][0], x1 = acc[ai][bj][m][1];
                        float ps = (x0[0] * x0[0] + x0[1] * x0[1]) + (x0[2] * x0[2] + x0[3] * x0[3]) + (x1[0] * x1[0] + x1[1] * x1[1]) + (x1[2] * x1[2] + x1[3] * x1[3]);
                        ps += __shfl_xor(ps, 16); ps += __shfl_xor(ps, 32);
                        if (fq == 0) atomicAdd(ssq + (size_t)mrow * 4 + 2 * tl + bj, ps);
                    }
                    const int R = ((b * 4 + 2 * tl + bj) << lg) + t;
                    bf16_t* p = isv ? base + (size_t)(R >> 6) * 8192 + wc * 2048 + (R & 63) * 32 + fq * 8
                                    : base + (size_t)(R >> 6) * 8192 + (4 * wc + fq) * 512 + (R & 63) * 8;
                    *(u32x4*)p = pack8(acc[ai][bj][m][0], acc[ai][bj][m][1]);
                }
            }
    }
    __device__ __forceinline__ void operator()(Acc& acc, const pg8::Unit& u, int wr, int wc, int fr_in, int fq_in) const {
        int fr = fr_in, fq = fq_in; asm volatile("" : "+v"(fr), "+v"(fq));
        const int pn = u.pn;
        const int rowbase = u.pm * 256 + wr * 64 + fr;
        if (pn < 15) {
            if (pn < 3)       norm64(acc, rowbase, wc, fq, g_qA, QSCALE, true, QA + (size_t)pn * M_ * 256, 4, wc, 2 * pn);
            else if (pn < 6)  norm64(acc, rowbase, wc, fq, g_kA, 1.0f, true, KA + (size_t)(pn - 3) * M_ * 256, 4, wc, 2 * (pn - 3));
            else if (pn < 9)  v64(acc, rowbase, fq, VA + (size_t)(pn - 6) * M_ * 256, 4, wc, 2 * (pn - 6));
            else if (pn < 11) norm64(acc, rowbase, wc, fq, g_qB, QSCALE, false, QB, 8, 4 * (pn - 9) + wc, 0);
            else if (pn < 13) norm64(acc, rowbase, wc, fq, g_kB, 1.0f, false, KB, 8, 4 * (pn - 11) + wc, 0);
            else              v64(acc, rowbase, fq, VB, 8, 4 * (pn - 13) + wc, 0);
        } else if (pn < 17) {
            raw128(acc, rowbase, wc, fq, QM, pn - 15, 12, false, SSQQ);
        } else if (pn < 29) {
            const int colt = (pn - 17) * 256 + wc * 32 + 8 * fq;
            f32x4 bv[2][2];
#pragma unroll
            for (int bj = 0; bj < 2; ++bj)
#pragma unroll
                for (int n = 0; n < 2; ++n) bv[bj][n] = *(const f32x4*)(b_gate + colt + bj * 128 + 4 * n);
            const int lane_ = fr + 16 * fq, wid_ = wr * 4 + wc;
#pragma unroll
            for (int ai = 0; ai < 2; ++ai)
#pragma unroll
                for (int m = 0; m < 4; ++m) {
                    u32x4 w;
#pragma unroll
                    for (int bj = 0; bj < 2; ++bj)
#pragma unroll
                        for (int n = 0; n < 2; ++n) {
                            const f32x4 v = acc[ai][bj][m][n] + bv[bj][n]; unsigned pk = 0;
#pragma unroll
                            for (int e = 0; e < 4; ++e) { unsigned q = (unsigned)(sigmoidf_(v[e]) * 255.0f + 0.5f); q = q < 1u ? 1u : q; pk |= q << (8 * e); }
                            w[bj * 2 + n] = pk;
                        }
                    *(u32x4*)(GATES8 + ((((((size_t)u.pm * 12 + (pn - 17)) * 2 + ai) * 4 + m) * 8 + wid_) * 64 + lane_) * 16) = w;
                }
        } else {
            const int rb = rowbase - M_;
            if (pn < 31) raw128(acc, rb, wc, fq, KM, pn - 29, 8, false, nullptr);
            else         raw128(acc, rb, wc, fq, VM, pn - 31, 8, true, nullptr);
        }
    }
};

struct EpiMerge {
    const unsigned char* GATES8; bf16_t* MERGED;
    __device__ __forceinline__ void operator()(Acc& acc, const pg8::Unit& u, int wr, int wc, int fr_in, int fq_in) const {
        int fr = fr_in, fq = fq_in; asm volatile("" : "+v"(fr), "+v"(fq));
        const int rowbase = u.pm * 256 + wr * 64 + fr, col = u.pn * 256 + wc * 32 + 8 * fq, br = u.tag;
        const int lane_ = fr + 16 * fq, wid_ = wr * 4 + wc;
#pragma unroll
        for (int ai = 0; ai < 2; ++ai)
#pragma unroll
            for (int m = 0; m < 4; ++m) {
                const size_t frag = (((size_t)ai * 4 + m) * 8 + wid_) * 64 + lane_;
                const u32x4 gn = *(const u32x4*)(GATES8 + ((((size_t)u.pm * 12 + br * 4 + u.pn) * 8) * 512 + frag) * 16);
                if (br < 2) {
                    const u32x4 gd = *(const u32x4*)(GATES8 + ((((size_t)u.pm * 12 + (br + 1) * 4 + u.pn) * 8) * 512 + frag) * 16);
#pragma unroll
                    for (int bj = 0; bj < 2; ++bj)
#pragma unroll
                        for (int n = 0; n < 2; ++n)
#pragma unroll
                            for (int e = 0; e < 4; ++e)
                                acc[ai][bj][m][n][e] *= (float)((gn[bj * 2 + n] >> (8 * e)) & 0xffu) * __builtin_amdgcn_rcpf((float)((gd[bj * 2 + n] >> (8 * e)) & 0xffu));
                } else {
                    const int row = rowbase + ai * 128 + m * 16;
#pragma unroll
                    for (int bj = 0; bj < 2; ++bj) {
                        f32x4 o[2];
#pragma unroll
                        for (int n = 0; n < 2; ++n)
#pragma unroll
                            for (int e = 0; e < 4; ++e) o[n][e] = acc[ai][bj][m][n][e] * ((float)((gn[bj * 2 + n] >> (8 * e)) & 0xffu) * (1.0f / 255.0f));
                        *(u32x4*)(MERGED + (size_t)row * 1024 + col + bj * 128) = pack8(o[0], o[1]);
                    }
                }
            }
    }
};
struct EpiOut {
    const float* X; float* OUT; bf16_t* X1B; float* SSQ;
    __device__ __forceinline__ void operator()(Acc& acc, const pg8::Unit& u, int wr, int wc, int fr_in, int fq_in) const {
        int fr = fr_in, fq = fq_in; asm volatile("" : "+v"(fr), "+v"(fq));
        const int rowbase = u.pm * 256 + wr * 64 + fr, col = u.pn * 256 + wc * 32 + 8 * fq;
#pragma unroll
        for (int ai = 0; ai < 2; ++ai)
#pragma unroll
            for (int m = 0; m < 4; ++m) {
                const int row = rowbase + ai * 128 + m * 16; const size_t off = (size_t)row * 1024 + col;
                float ss = 0.f;
#pragma unroll
                for (int bj = 0; bj < 2; ++bj) {
                    const f32x4 x0 = *(const f32x4*)(X + off + bj * 128), x1 = *(const f32x4*)(X + off + bj * 128 + 4);
                    const f32x4 v0 = acc[ai][bj][m][0] + x0, v1 = acc[ai][bj][m][1] + x1;
                    *(u32x4*)(X1B + off + bj * 128) = pack8(v0, v1);
                    ss += (v0[0] * v0[0] + v0[1] * v0[1]) + (v0[2] * v0[2] + v0[3] * v0[3]) + (v1[0] * v1[0] + v1[1] * v1[1]) + (v1[2] * v1[2] + v1[3] * v1[3]);
                }
                ss += __shfl_xor(ss, 16); ss += __shfl_xor(ss, 32);
                if (fq == 0) atomicAdd(SSQ + row, ss);
            }
    }
};
struct EpiUp {
    const float* SSQ; bf16_t* HMID;
    __device__ __forceinline__ void operator()(Acc& acc, const pg8::Unit& u, int wr, int wc, int fr_in, int fq_in) const {
        int fr = fr_in, fq = fq_in; asm volatile("" : "+v"(fr), "+v"(fq));
        const int rowbase = u.pm * 256 + wr * 64 + fr, col = u.pn * 256 + wc * 32 + 8 * fq;
#pragma unroll
        for (int ai = 0; ai < 2; ++ai)
#pragma unroll
            for (int m = 0; m < 4; ++m) {
                const int row = rowbase + ai * 128 + m * 16;
                const float rstd = __builtin_amdgcn_rsqf(SSQ[row] * (1.0f / 1024.0f) + EPS_);
#pragma unroll
                for (int bj = 0; bj < 2; ++bj) {
                    f32x4 v0 = acc[ai][bj][m][0] * rstd, v1 = acc[ai][bj][m][1] * rstd;
#pragma unroll
                    for (int e = 0; e < 4; ++e) { const float a = fmaxf(v0[e], 0.f), b = fmaxf(v1[e], 0.f); v0[e] = a * a; v1[e] = b * b; }
                    *(u32x4*)(HMID + (size_t)row * 4096 + col + bj * 128) = pack8(v0, v1);
                }
            }
    }
};
struct EpiDown {
    float* OUT; const bf16_t* X1B;
    __device__ __forceinline__ void operator()(Acc& acc, const pg8::Unit& u, int wr, int wc, int fr_in, int fq_in) const {
        int fr = fr_in, fq = fq_in; asm volatile("" : "+v"(fr), "+v"(fq));
        const int rowbase = u.pm * 256 + wr * 64 + fr, col = u.pn * 256 + wc * 32 + 8 * fq;
#pragma unroll
        for (int ai = 0; ai < 2; ++ai)
#pragma unroll
            for (int m = 0; m < 4; ++m) {
                const size_t off = (size_t)(rowbase + ai * 128 + m * 16) * 1024 + col;
#pragma unroll
                for (int bj = 0; bj < 2; ++bj) {
                    f32x4 x0, x1; unpack8(*(const u32x4*)(X1B + off + bj * 128), x0, x1);
                    *(f32x4*)(OUT + off + bj * 128) = acc[ai][bj][m][0] + x0; *(f32x4*)(OUT + off + bj * 128 + 4) = acc[ai][bj][m][1] + x1;
                }
            }
    }
};

struct SchedP1 { int G, c;
    __device__ __forceinline__ bool next(int i, pg8::Unit& u) const {
        const int L = i * G + c;
        if (L < 3712) pg8::tile_order(L, 128, 29, u.pm, u.pn);
        else if (L < 3744) { const int idx = L - 3712; u.pm = 128 + (idx >> 2); u.pn = 29 + (idx & 3); }
        else return false;
        u.k0 = 0; u.nt = 16; u.tag = 0; u.first = 1; return true; } };
struct SchedSimple { int G, c, nN, nt;
    __device__ __forceinline__ bool next(int i, pg8::Unit& u) const {
        const int L = i * G + c; if (L >= 128 * nN) return false;
        pg8::tile_order(L, 128, nN, u.pm, u.pn); u.k0 = 0; u.nt = nt; u.tag = 0; u.first = 1; return true; } };
struct SchedP3 { int G, c;
    __device__ __forceinline__ bool next(int i, pg8::Unit& u) const {
        const int ti = i / 3, br = i - 3 * ti; const int L = ti * G + c; if (L >= 512) return false;
        pg8::tile_order(L, 128, 4, u.pm, u.pn); u.k0 = (br == 0) ? 0 : (br == 1 ? 256 : 768); u.nt = (br == 0) ? 4 : 8; u.tag = br; u.first = (br == 0); return true; } };

__device__ __forceinline__ float max3f(float a, float b, float c) { float r; asm("v_max3_f32 %0, %1, %2, %3" : "=v"(r) : "v"(a), "v"(b), "v"(c)); return r; }
__device__ __forceinline__ float max2f(float a, float b) { float r; asm("v_max_f32_e32 %0, %1, %2" : "=v"(r) : "v"(a), "v"(b)); return r; }
__device__ __forceinline__ float halfmax(float m) { auto rr = __builtin_amdgcn_permlane32_swap(__float_as_uint(m), __float_as_uint(m), false, false); return max2f(__uint_as_float(rr[0]), __uint_as_float(rr[1])); }
__device__ __forceinline__ float halfsum(float m) { auto rr = __builtin_amdgcn_permlane32_swap(__float_as_uint(m), __float_as_uint(m), false, false); return __uint_as_float(rr[0]) + __uint_as_float(rr[1]); }
__device__ __forceinline__ float rowmax32(f32x16& p0, f32x16& p1) {
    asm volatile("s_nop 15\n\ts_nop 7" : "+v"(p0), "+v"(p1));
    float a = max3f(p0[0], p0[1], p1[0]), b = max3f(p0[2], p0[3], p1[1]); a = max3f(a, p1[2], p1[3]);
#pragma unroll
    for (int r = 4; r < 16; r += 4) { a = max3f(a, p0[r], p0[r + 1]); b = max3f(b, p0[r + 2], p0[r + 3]); a = max3f(a, p1[r], p1[r + 1]); b = max3f(b, p1[r + 2], p1[r + 3]); }
    return halfmax(max2f(a, b));
}

template <int D, int MODE>
__device__ __forceinline__ void attn_unit(LAS unsigned char* lds, const bf16_t* __restrict__ Qs, const bf16_t* __restrict__ Ks, const bf16_t* __restrict__ Vs,
                                          const float* __restrict__ c2s, int qblk, bf16_t* out, int opitch, int orow0, int odl, float* lse, int fox_lo, float smax) {
    constexpr int TB = 128 * D, NP = TB / 16 / 512, KS = D / 16, DB = D / 32, TE = 64 * D;
    constexpr int TPS = (D == 64) ? 2 : 1;
    constexpr int OFF_V = 2 * TPS * TB, OFF_C = 4 * TPS * TB, OFF_O = OFF_C + 2 * TPS * 256, PITCH = 2 * D + 16;
    const int tid = threadIdx.x, lane = tid & 63, wid = __builtin_amdgcn_readfirstlane(tid >> 6), r32 = lane & 31, hi = lane >> 5;
    const int jw = qblk * 256 + 32 * wid;
    int kt_lo = 0, kt_hi = 4;
    if (MODE == 0) { kt_lo = 4 * qblk - 2; if (kt_lo < 0) kt_lo = 0; kt_hi = 4 * qblk + 4; }
    if (MODE == 1) { kt_hi = 4 * qblk + 4; kt_lo = fox_lo; }
    const int ntile = kt_hi - kt_lo, nstep = (ntile + TPS - 1) / TPS;
#define KT(i) ((MODE == 1) ? (kt_hi - 1 - (i)) : (kt_lo + (i)))
    bf16x8 qf[KS];
    { const bf16_t* qp = Qs + (size_t)(jw >> 6) * TE + ((jw & 63) + r32) * 8 + hi * 512;
#pragma unroll
      for (int ks = 0; ks < KS; ++ks) qf[ks] = *(const bf16x8*)(qp + ks * 1024); }
    float cq = 0.f; if (MODE == 1) cq = c2s[jw + r32];
    float rq = 1.f; if (MODE == 2) rq = __builtin_amdgcn_rsqf(c2s[(size_t)(jw + r32) * 4] * (1.0f / 128.0f) + EPS_) * QSCALE_M;
    f32x16 o[DB];
#pragma unroll
    for (int d = 0; d < DB; ++d)
#pragma unroll
        for (int i = 0; i < 16; ++i) o[d][i] = 0.f;
    float mrun = (MODE == 1) ? 0.f : -1e30f, lrun = 0.f; bool started = false; (void)started;
    u32x4 kr[TPS][NP], vr[TPS][NP]; f32x4 cr[TPS];
#pragma unroll
    for (int sb = 0; sb < TPS; ++sb) cr[sb] = (f32x4){0.f, 0.f, 0.f, 0.f};
#define ATT_GLOAD(st_) do { _Pragma("unroll") for (int sb_ = 0; sb_ < TPS; ++sb_) { const int i_ = (st_) * TPS + sb_; if (i_ < ntile) { const int kt_ = KT(i_); \
        const u32x4* kp_ = (const u32x4*)(Ks + (size_t)kt_ * TE) + tid; const u32x4* vp_ = (const u32x4*)(Vs + (size_t)kt_ * TE) + tid; \
        _Pragma("unroll") for (int p_ = 0; p_ < NP; ++p_) { kr[sb_][p_] = kp_[p_ * 512]; vr[sb_][p_] = vp_[p_ * 512]; } \
        if (MODE == 1) { if (tid < 16) cr[sb_] = ((const f32x4*)(c2s + kt_ * 64))[tid]; } } } } while (0)
    constexpr int OFF_F = OFF_O + 8 * 32 * PITCH;
    if (MODE == 1) { if (lane == 0) ((LAS unsigned*)(lds + OFF_F))[wid] = 0u; }
    ATT_GLOAD(0);
    for (int st = 0; st < nstep; ++st) {
#pragma unroll
        for (int sb = 0; sb < TPS; ++sb) { const int slot = (st & 1) * TPS + sb;
          LAS u32x4* kd = (LAS u32x4*)(lds + slot * TB) + tid; LAS u32x4* vd = (LAS u32x4*)(lds + OFF_V + slot * TB) + tid;
#pragma unroll
          for (int p = 0; p < NP; ++p) { kd[p * 512] = kr[sb][p]; vd[p * 512] = vr[sb][p]; }
          if (MODE == 1) { if (tid < 16) ((LAS f32x4*)(lds + OFF_C + slot * 256))[tid] = cr[sb]; } }
        __syncthreads();
        if (MODE == 1) {
            const u32x4 f0 = ((const LAS u32x4*)(lds + OFF_F))[0], f1 = ((const LAS u32x4*)(lds + OFF_F))[1];
            if ((f0.x & f0.y & f0.z & f0.w & f1.x & f1.y & f1.z & f1.w) != 0u) break;
        }
        if (st + 1 < nstep) ATT_GLOAD(st + 1);
#pragma unroll
      for (int sb = 0; sb < TPS; ++sb) {
        const int it = st * TPS + sb; if (it >= ntile) break;
        const int kt = KT(it);
        const int buf = (st & 1) * TPS + sb;
        bool active = true;
        if (MODE == 0) active = (kt * 64 + 63 >= jw - 128) && (kt * 64 <= jw + 31);
        if (MODE == 1) {
            active = (kt * 64 <= jw + 31);
            if (active) { const float cend = ((const LAS float*)(lds + OFF_C + buf * 256))[63];
                active = !started || __builtin_amdgcn_ballot_w64(smax + cq - cend - mrun >= -135.0f) != 0;
                if (!active) { if (lane == 0) ((LAS unsigned*)(lds + OFF_F))[wid] = 1u; } }
        }
        if (active) {
            f32x16 s0, s1;
            if (MODE == 1) {
                const LAS f32x4* cb = (const LAS f32x4*)(lds + OFF_C + buf * 256);
                const float cqm = cq - mrun;
#pragma unroll
                for (int i4 = 0; i4 < 4; ++i4) { const f32x4 c0 = cb[2 * i4 + hi], c1 = cb[8 + 2 * i4 + hi];
#pragma unroll
                    for (int e = 0; e < 4; ++e) { s0[4 * i4 + e] = cqm - c0[e]; s1[4 * i4 + e] = cqm - c1[e]; } }
            } else {
#pragma unroll
                for (int i = 0; i < 16; ++i) { s0[i] = 0.f; s1[i] = 0.f; }
            }
            const LAS unsigned char* kb = lds + buf * TB + hi * 1024 + r32 * 16;
#pragma unroll
            for (int ks = 0; ks < KS; ++ks) {
                const bf16x8 a0 = *(const LAS bf16x8*)(kb + ks * 2048), a1 = *(const LAS bf16x8*)(kb + ks * 2048 + 512);
                s0 = __builtin_amdgcn_mfma_f32_32x32x16_bf16(a0, qf[ks], s0, 0, 0, 0);
                s1 = __builtin_amdgcn_mfma_f32_32x32x16_bf16(a1, qf[ks], s1, 0, 0, 0);
            }
            if (MODE == 2) {
#pragma unroll
                for (int i = 0; i < 16; ++i) { s0[i] *= rq; s1[i] *= rq; }
            }
            const int q = jw + r32, key0 = kt * 64 + 4 * hi;
            if (MODE == 0) {
#pragma unroll
                for (int i = 0; i < 16; ++i) { const int key = key0 + 8 * (i >> 2) + (i & 3);
                    if (key > q || key < q - 128) s0[i] = -INFINITY;
                    if (key + 32 > q || key + 32 < q - 128) s1[i] = -INFINITY; }
            }
            if (MODE == 1) {
                if (kt * 64 + 63 > jw) {
#pragma unroll
                    for (int i = 0; i < 16; ++i) { const int key = key0 + 8 * (i >> 2) + (i & 3);
                        if (key > q) s0[i] = -INFINITY;
                        if (key + 32 > q) s1[i] = -INFINITY; }
                }
            }
            const float mx = rowmax32(s0, s1);
            float rs = 0.f;
            if (MODE == 1) {
                if (!started) {
                    started = true; mrun = mx;
#pragma unroll
                    for (int i = 0; i < 16; ++i) { s0[i] -= mx; s1[i] -= mx; }
                } else if (__builtin_amdgcn_ballot_w64(mx > 0.f) != 0) {
                    const float dl = max2f(mx, 0.f), alpha = __builtin_amdgcn_exp2f(-dl);
                    mrun += dl; lrun *= alpha;
#pragma unroll
                    for (int i = 0; i < 16; ++i) { s0[i] -= dl; s1[i] -= dl; }
#pragma unroll
                    for (int d = 0; d < DB; ++d)
#pragma unroll
                        for (int i = 0; i < 16; ++i) o[d][i] *= alpha;
                }
#pragma unroll
                for (int i = 0; i < 16; ++i) { s0[i] = __builtin_amdgcn_exp2f(s0[i]); s1[i] = __builtin_amdgcn_exp2f(s1[i]); rs += s0[i] + s1[i]; }
            } else {
                const float mnew = max2f(mrun, mx);
                if (__builtin_amdgcn_ballot_w64(mnew > mrun) != 0) {
                    const float alpha = __builtin_amdgcn_exp2f(mrun - mnew);
                    lrun *= alpha;
#pragma unroll
                    for (int d = 0; d < DB; ++d)
#pragma unroll
                        for (int i = 0; i < 16; ++i) o[d][i] *= alpha;
                }
                mrun = mnew;
#pragma unroll
                for (int i = 0; i < 16; ++i) { s0[i] = __builtin_amdgcn_exp2f(s0[i] - mnew); s1[i] = __builtin_amdgcn_exp2f(s1[i] - mnew); rs += s0[i] + s1[i]; }
            }
            lrun += rs;
            u32x4 pw[4];
            pw[0] = (u32x4){pk2(s0[0], s0[1]), pk2(s0[2], s0[3]), pk2(s0[4], s0[5]), pk2(s0[6], s0[7])};
            pw[1] = (u32x4){pk2(s0[8], s0[9]), pk2(s0[10], s0[11]), pk2(s0[12], s0[13]), pk2(s0[14], s0[15])};
            pw[2] = (u32x4){pk2(s1[0], s1[1]), pk2(s1[2], s1[3]), pk2(s1[4], s1[5]), pk2(s1[6], s1[7])};
            pw[3] = (u32x4){pk2(s1[8], s1[9]), pk2(s1[10], s1[11]), pk2(s1[12], s1[13]), pk2(s1[14], s1[15])};
            const LAS unsigned char* vb = lds + OFF_V + buf * TB + ((lane >> 4) & 1) * 32 + (lane & 3) * 8 + (4 * hi + ((lane & 15) >> 2)) * 64;
#pragma unroll
            for (int d = 0; d < DB; ++d)
#pragma unroll
                for (int kk = 0; kk < 4; ++kk) {
                    typedef short v4i16_t __attribute__((ext_vector_type(4)));
                    const s16x4 lo = __builtin_bit_cast(s16x4, __builtin_amdgcn_ds_read_tr16_b64_v4i16((LAS v4i16_t*)(vb + d * 4096 + kk * 1024)));
                    const s16x4 hh = __builtin_bit_cast(s16x4, __builtin_amdgcn_ds_read_tr16_b64_v4i16((LAS v4i16_t*)(vb + d * 4096 + kk * 1024 + 512)));
                    const bf16x8 vf = (bf16x8){lo[0], lo[1], lo[2], lo[3], hh[0], hh[1], hh[2], hh[3]};
                    o[d] = __builtin_amdgcn_mfma_f32_32x32x16_bf16(vf, __builtin_bit_cast(bf16x8, pw[kk]), o[d], 0, 0, 0);
                }
        }
      }
    }
#undef ATT_GLOAD
#undef KT
    lrun = halfsum(lrun);
    const float inv = 1.0f / lrun;
    if (MODE == 0) { if (hi == 0) lse[(size_t)(orow0 + ((jw + r32) << odl)) * 4] = (mrun + __builtin_amdgcn_logf(lrun)) * LN2; }
    LAS unsigned char* stw = lds + OFF_O + wid * (32 * PITCH);
#pragma unroll
    for (int d = 0; d < DB; ++d)
#pragma unroll
        for (int i4 = 0; i4 < 4; ++i4) {
            u32x2 w; w.x = pk2(o[d][4 * i4] * inv, o[d][4 * i4 + 1] * inv); w.y = pk2(o[d][4 * i4 + 2] * inv, o[d][4 * i4 + 3] * inv);
            *(LAS u32x2*)(stw + r32 * PITCH + (32 * d + 8 * i4 + 4 * hi) * 2) = w;
        }
    constexpr int LPR = D / 8, RPI = 64 / LPR;
#pragma unroll
    for (int it = 0; it < 32 / RPI; ++it) {
        const int row = it * RPI + lane / LPR, ch = lane % LPR;
        const u32x4 v = *(const LAS u32x4*)(stw + row * PITCH + ch * 16);
        const int mrow = orow0 + ((jw + row) << odl);
        *(u32x4*)(out + (size_t)mrow * opitch + ch * 8) = v;
    }
    __syncthreads();
}

struct DilUnit { const bf16_t *Qs, *Ks, *Vs; bf16_t* out; float* lse; int qblk, orow0, odl; };
__device__ __forceinline__ void dil_decode(unsigned char* ws, bf16_t* DIL, float* LSE, int L, DilUnit& u) {
    const int gi = L / 512, rem = L % 512, bh = rem >> 4, rj = rem & 15, b = bh >> 2, h = bh & 3;
    const int dl = 2 * gi, qpb = 16 >> dl;
    const int r = rj / qpb; u.qblk = rj % qpb;
    const size_t Rs = ((size_t)(b * 4 + h) << 12) + ((size_t)r << (12 - dl));
    u.Qs = (const bf16_t*)(ws + WS_QA) + (size_t)gi * M_ * 256 + Rs * 64;
    u.Ks = (const bf16_t*)(ws + WS_KA) + (size_t)gi * M_ * 256 + Rs * 64;
    u.Vs = (const bf16_t*)(ws + WS_VA) + (size_t)gi * M_ * 256 + Rs * 64;
    u.out = DIL + (size_t)gi * M_ * 256 + h * 64; u.lse = LSE + (size_t)gi * M_ * 4 + h; u.orow0 = b * 4096 + r; u.odl = dl;
}
__device__ __forceinline__ void dil_phase(LAS unsigned char* lds, unsigned char* ws, bf16_t* DIL, float* LSE, int bx, int G) {
    constexpr int TB = 8192, TE = 4096, OFF_V = 6 * TB, OFF_O = 12 * TB, PITCH = 144;
    typedef short v4i16_t __attribute__((ext_vector_type(4)));
    int tid = threadIdx.x; asm volatile("" : "+v"(tid));
    const int lane = tid & 63, wid = __builtin_amdgcn_readfirstlane(tid >> 6), r32 = lane & 31, hi = lane >> 5;
    if (bx >= 1536) return;
    DilUnit cur, nxt; dil_decode(ws, DIL, LSE, bx, cur);
    u32x4 kr[6], vr[6]; bf16x8 qn[4];
#define DIL_LOAD(U) do { const int t0_ = 4 * (U).qblk - 2; \
        _Pragma("unroll") for (int s_ = 0; s_ < 6; ++s_) { if (t0_ + s_ >= 0) { kr[s_] = ((const u32x4*)((U).Ks + (size_t)(t0_ + s_) * TE))[tid]; vr[s_] = ((const u32x4*)((U).Vs + (size_t)(t0_ + s_) * TE))[tid]; } } \
        const int jw_ = (U).qblk * 256 + 32 * wid; const bf16_t* qp_ = (U).Qs + (size_t)(jw_ >> 6) * TE + ((jw_ & 63) + r32) * 8 + hi * 512; \
        _Pragma("unroll") for (int ks = 0; ks < 4; ++ks) qn[ks] = *(const bf16x8*)(qp_ + ks * 1024); } while (0)
#pragma unroll
    for (int s = 0; s < 6; ++s) { kr[s] = (u32x4){0u, 0u, 0u, 0u}; vr[s] = (u32x4){0u, 0u, 0u, 0u}; }
    DIL_LOAD(cur);
    for (int L = bx; L < 1536; L += G) {
        const bool has_next = (L + G < 1536);
        if (has_next) dil_decode(ws, DIL, LSE, L + G, nxt);
#pragma unroll
        for (int s = 0; s < 6; ++s) { ((LAS u32x4*)(lds + s * TB))[tid] = kr[s]; ((LAS u32x4*)(lds + OFF_V + s * TB))[tid] = vr[s]; }
        bf16x8 qf[4];
#pragma unroll
        for (int ks = 0; ks < 4; ++ks) qf[ks] = qn[ks];
        __syncthreads();
        if (has_next) DIL_LOAD(nxt);
        const int jw = cur.qblk * 256 + 32 * wid, q = jw + r32, t0 = 4 * cur.qblk - 2;
        int kfirst = (jw - 128) >> 6; if (kfirst < 0) kfirst = 0;
        const int klast = (jw + 31) >> 6;
        f32x16 o[2];
#pragma unroll
        for (int d = 0; d < 2; ++d)
#pragma unroll
            for (int i = 0; i < 16; ++i) o[d][i] = 0.f;
        float mrun = -1e30f, lrun = 0.f;
        for (int kt = kfirst; kt <= klast; ++kt) {
            const int slot = kt - t0;
            f32x16 s0, s1;
#pragma unroll
            for (int i = 0; i < 16; ++i) { s0[i] = 0.f; s1[i] = 0.f; }
            const LAS unsigned char* kb = lds + slot * TB + hi * 1024 + r32 * 16;
#pragma unroll
            for (int ks = 0; ks < 4; ++ks) {
                const bf16x8 a0 = *(const LAS bf16x8*)(kb + ks * 2048), a1 = *(const LAS bf16x8*)(kb + ks * 2048 + 512);
                s0 = __builtin_amdgcn_mfma_f32_32x32x16_bf16(a0, qf[ks], s0, 0, 0, 0);
                s1 = __builtin_amdgcn_mfma_f32_32x32x16_bf16(a1, qf[ks], s1, 0, 0, 0);
            }
            const int key0 = kt * 64 + 4 * hi;
#pragma unroll
            for (int i = 0; i < 16; ++i) { const int key = key0 + 8 * (i >> 2) + (i & 3);
                if (key > q || key < q - 128) s0[i] = -INFINITY;
                if (key + 32 > q || key + 32 < q - 128) s1[i] = -INFINITY; }
            const float mx = rowmax32(s0, s1);
            const float mnew = max2f(mrun, mx);
            if (__builtin_amdgcn_ballot_w64(mnew > mrun) != 0) {
                const float alpha = __builtin_amdgcn_exp2f(mrun - mnew);
                lrun *= alpha;
#pragma unroll
                for (int d = 0; d < 2; ++d)
#pragma unroll
                    for (int i = 0; i < 16; ++i) o[d][i] *= alpha;
            }
            mrun = mnew;
            float rs = 0.f;
#pragma unroll
            for (int i = 0; i < 16; ++i) { s0[i] = __builtin_amdgcn_exp2f(s0[i] - mnew); s1[i] = __builtin_amdgcn_exp2f(s1[i] - mnew); rs += s0[i] + s1[i]; }
            lrun += rs;
            u32x4 pw[4];
            pw[0] = (u32x4){pk2(s0[0], s0[1]), pk2(s0[2], s0[3]), pk2(s0[4], s0[5]), pk2(s0[6], s0[7])};
            pw[1] = (u32x4){pk2(s0[8], s0[9]), pk2(s0[10], s0[11]), pk2(s0[12], s0[13]), pk2(s0[14], s0[15])};
            pw[2] = (u32x4){pk2(s1[0], s1[1]), pk2(s1[2], s1[3]), pk2(s1[4], s1[5]), pk2(s1[6], s1[7])};
            pw[3] = (u32x4){pk2(s1[8], s1[9]), pk2(s1[10], s1[11]), pk2(s1[12], s1[13]), pk2(s1[14], s1[15])};
            const LAS unsigned char* vb = lds + OFF_V + slot * TB + ((lane >> 4) & 1) * 32 + (lane & 3) * 8 + (4 * hi + ((lane & 15) >> 2)) * 64;
#pragma unroll
            for (int d = 0; d < 2; ++d)
#pragma unroll
                for (int kk = 0; kk < 4; ++kk) {
                    const s16x4 lo = __builtin_bit_cast(s16x4, __builtin_amdgcn_ds_read_tr16_b64_v4i16((LAS v4i16_t*)(vb + d * 4096 + kk * 1024)));
                    const s16x4 hh = __builtin_bit_cast(s16x4, __builtin_amdgcn_ds_read_tr16_b64_v4i16((LAS v4i16_t*)(vb + d * 4096 + kk * 1024 + 512)));
                    const bf16x8 vf = (bf16x8){lo[0], lo[1], lo[2], lo[3], hh[0], hh[1], hh[2], hh[3]};
                    o[d] = __builtin_amdgcn_mfma_f32_32x32x16_bf16(vf, __builtin_bit_cast(bf16x8, pw[kk]), o[d], 0, 0, 0);
                }
        }
        lrun = halfsum(lrun);
        const float inv = 1.0f / lrun;
        if (hi == 0) cur.lse[(size_t)(cur.orow0 + ((jw + r32) << cur.odl)) * 4] = (mrun + __builtin_amdgcn_logf(lrun)) * LN2;
        LAS unsigned char* stw = lds + OFF_O + wid * (32 * PITCH);
#pragma unroll
        for (int d = 0; d < 2; ++d)
#pragma unroll
            for (int i4 = 0; i4 < 4; ++i4) {
                u32x2 w; w.x = pk2(o[d][4 * i4] * inv, o[d][4 * i4 + 1] * inv); w.y = pk2(o[d][4 * i4 + 2] * inv, o[d][4 * i4 + 3] * inv);
                *(LAS u32x2*)(stw + r32 * PITCH + (32 * d + 8 * i4 + 4 * hi) * 2) = w;
            }
#pragma unroll
        for (int it = 0; it < 4; ++it) {
            const int row = it * 8 + (lane >> 3), ch = lane & 7;
            const u32x4 v = *(const LAS u32x4*)(stw + row * PITCH + ch * 16);
            const int mrow = cur.orow0 + ((jw + row) << cur.odl);
            *(u32x4*)(cur.out + (size_t)mrow * 256 + ch * 8) = v;
        }
        __syncthreads();
        cur = nxt;
    }
#undef DIL_LOAD
}

__device__ __forceinline__ void memnorm_unit(LAS unsigned char* lds, bf16_t* tiles, const float* gain, const float* gain2, float scale) {
    int tid = threadIdx.x; asm volatile("" : "+v"(tid));
    const int lane = tid & 63, wid = tid >> 6;
    LAS float* part = (LAS float*)lds;
    u32x4 raw[4][2];
#pragma unroll
    for (int t = 0; t < 4; ++t) { raw[t][0] = *(const u32x4*)(tiles + (size_t)t * 8192 + (2 * wid) * 512 + lane * 8); raw[t][1] = *(const u32x4*)(tiles + (size_t)t * 8192 + (2 * wid + 1) * 512 + lane * 8); }
#pragma unroll
    for (int t = 0; t < 4; ++t) {
        f32x4 a0, a1, b0, b1; unpack8(raw[t][0], a0, a1); unpack8(raw[t][1], b0, b1);
        float ss = 0.f;
#pragma unroll
        for (int e = 0; e < 4; ++e) ss += a0[e] * a0[e] + a1[e] * a1[e] + b0[e] * b0[e] + b1[e] * b1[e];
        part[(t * 8 + wid) * 64 + lane] = ss;
    }
    __syncthreads();
    const f32x4 g0 = *(const f32x4*)(gain + 16 * wid) * *(const f32x4*)(gain2 + 16 * wid), g1 = *(const f32x4*)(gain + 16 * wid + 4) * *(const f32x4*)(gain2 + 16 * wid + 4),
                g2 = *(const f32x4*)(gain + 16 * wid + 8) * *(const f32x4*)(gain2 + 16 * wid + 8), g3 = *(const f32x4*)(gain + 16 * wid + 12) * *(const f32x4*)(gain2 + 16 * wid + 12);
#pragma unroll
    for (int t = 0; t < 4; ++t) {
        float tot = 0.f;
#pragma unroll
        for (int w = 0; w < 8; ++w) tot += part[(t * 8 + w) * 64 + lane];
        const float rstd = __builtin_amdgcn_rsqf(tot * (1.0f / 128.0f) + EPS_) * scale;
        f32x4 a0, a1, b0, b1; unpack8(raw[t][0], a0, a1); unpack8(raw[t][1], b0, b1);
        *(u32x4*)(tiles + (size_t)t * 8192 + (2 * wid) * 512 + lane * 8) = pack8(a0 * g0 * rstd, a1 * g1 * rstd);
        *(u32x4*)(tiles + (size_t)t * 8192 + (2 * wid + 1) * 512 + lane * 8) = pack8(b0 * g2 * rstd, b1 * g3 * rstd);
    }
    __syncthreads();
}

__device__ __forceinline__ void cumsum_unit(LAS unsigned char* lds, const float* logf, float* c2, int bh, const float* gq, const float* gk, int* lo_tab) {
    const int tid = threadIdx.x, lane = tid & 63, wid = tid >> 6, b = bh >> 3, h = bh & 7;
    LAS float* wt = (LAS float*)lds;
    LAS float* wstart = (LAS float*)(lds + 64); LAS float* wend = (LAS float*)(lds + 64 + 256);
    float v[8]; float run = 0.f;
#pragma unroll
    for (int k = 0; k < 8; ++k) { run += logf[(size_t)(b * 4096 + tid * 8 + k) * 8 + h]; v[k] = run; }
    float inc = run;
#pragma unroll
    for (int o = 1; o < 64; o <<= 1) { const float t = __shfl_up(inc, o); if (lane >= o) inc += t; }
    if (lane == 63) wt[wid] = inc;
    __syncthreads();
    float pre = inc - run;
    for (int w = 0; w < wid; ++w) pre += wt[w];
#pragma unroll
    for (int k = 0; k < 8; ++k) c2[(size_t)bh * 4096 + tid * 8 + k] = (pre + v[k]) * LOG2E;
    if ((tid & 7) == 0) wstart[tid >> 3] = (pre + v[0]) * LOG2E;
    if ((tid & 7) == 7) wend[tid >> 3] = (pre + v[7]) * LOG2E;
    __syncthreads();
    float gqm = 0.f, gkm = 0.f;
    for (int i = 0; i < 64; ++i) { gqm = fmaxf(gqm, fabsf(gq[i])); gkm = fmaxf(gkm, fabsf(gk[i])); }
    const float smax = 64.0f * QSCALE * gqm * gkm * 1.02f;
    if (tid < 16) {
        const float cq0 = wstart[4 * tid]; int lo = 0;
        while (lo < 4 * tid && smax + cq0 - wend[lo] + smax < -135.0f) ++lo;
        lo_tab[bh * 16 + tid] = lo;
    }
    if (bh == 0 && tid == 0) ((float*)lo_tab)[1024] = smax;
    __syncthreads();
}

__device__ __forceinline__ void merge_unit(const bf16_t* DIL, const float* LSE, bf16_t* Y, int u) {
    const int tid = threadIdx.x;
#pragma unroll
    for (int k = 0; k < 4; ++k) {
        const int it = tid + 512 * k, row = 64 * u + (it >> 5), c8 = it & 31, h = c8 >> 3;
        const float l0 = LSE[(size_t)row * 4 + h], l1 = LSE[(size_t)(M_ + row) * 4 + h], l2 = LSE[(size_t)(2 * M_ + row) * 4 + h];
        const float mx = fmaxf(l0, fmaxf(l1, l2));
        float w0 = __expf(l0 - mx), w1 = __expf(l1 - mx), w2 = __expf(l2 - mx);
        const float inv = 1.0f / (w0 + w1 + w2); w0 *= inv; w1 *= inv; w2 *= inv;
        f32x4 a0, a1, b0, b1, c0, c1;
        unpack8(*(const u32x4*)(DIL + (size_t)row * 256 + c8 * 8), a0, a1);
        unpack8(*(const u32x4*)(DIL + (size_t)(M_ + row) * 256 + c8 * 8), b0, b1);
        unpack8(*(const u32x4*)(DIL + (size_t)(2 * M_ + row) * 256 + c8 * 8), c0, c1);
        *(u32x4*)(Y + (size_t)row * 1280 + c8 * 8) = pack8(a0 * w0 + b0 * w1 + c0 * w2, a1 * w0 + b1 * w1 + c1 * w2);
    }
}

__device__ __forceinline__ float wave_sum(float v) {
#pragma unroll
    for (int o = 1; o < 64; o <<= 1) v += __shfl_xor(v, o);
    return v;
}
__device__ __forceinline__ void cat_src(const Params& P, int n, const float*& base, int& ld, int& col) {
    const int tile = n >> 8, c = n & 255, bj = c >> 7, wc = (c >> 5) & 3, j = c & 31;
    if (tile < 15) {
        int colbase, head; bool rope = false;
        if (tile < 3) { colbase = 0; head = tile * 4 + wc; rope = true; }
        else if (tile < 6) { colbase = 768; head = (tile - 3) * 4 + wc; rope = true; }
        else if (tile < 9) { colbase = 1536; head = (tile - 6) * 4 + wc; }
        else if (tile < 11) { colbase = 2304; head = (tile - 9) * 4 + wc; }
        else if (tile < 13) { colbase = 2816; head = (tile - 11) * 4 + wc; }
        else { colbase = 3328; head = (tile - 13) * 4 + wc; }
        const int p = 32 * bj + j; const int d = (rope && p < 16) ? ((p & 3) + 4 * ((p >> 3) & 1) + 8 * ((p >> 2) & 1)) : p;
        base = P.in[3]; ld = 4360; col = colbase + head * 64 + d;
    } else if (tile < 17) { base = P.in[3]; ld = 4360; col = 3848 + (2 * (tile - 15) + bj) * 128 + 32 * wc + j; }
    else if (tile < 29) { base = P.in[13]; ld = 3072; col = n - 4352; }
    else if (tile < 31) { base = P.in[10]; ld = 1024; col = (2 * (tile - 29) + bj) * 128 + 32 * wc + j; }
    else { base = P.in[10]; ld = 1024; col = 512 + (2 * (tile - 31) + bj) * 128 + 32 * wc + j; }
}
__device__ __forceinline__ void transpose_item(const float* srcp  , int ldsrc, int k0, const float* kscale, bf16_t* dst, int ldd, int drow0, int dcol0,
                                               LAS float* scr, int lane) {
    float tv[32];
#pragma unroll
    for (int i = 0; i < 32; ++i) { const int kk = 2 * i + (lane >> 5); tv[i] = srcp[(size_t)(k0 + kk) * ldsrc]; }
    if (kscale) {
#pragma unroll
        for (int i = 0; i < 32; ++i) tv[i] *= kscale[k0 + 2 * i + (lane >> 5)];
    }
#pragma unroll
    for (int i = 0; i < 32; ++i) scr[(2 * i + (lane >> 5)) * 33 + (lane & 31)] = tv[i];
    asm volatile("s_waitcnt lgkmcnt(0)" ::: "memory");
    const int c = lane & 7;
#pragma unroll
    for (int jx = 0; jx < 4; ++jx) { const int n = (lane >> 3) + 8 * jx; const LAS float* s = scr + (8 * c) * 33 + n;
        u32x4 o; o.x = pk2(s[0 * 33], s[1 * 33]); o.y = pk2(s[2 * 33], s[3 * 33]); o.z = pk2(s[4 * 33], s[5 * 33]); o.w = pk2(s[6 * 33], s[7 * 33]);
        *(u32x4*)(dst + (size_t)(drow0 + n) * ldd + dcol0 + k0 + 8 * c) = o; }
    asm volatile("s_waitcnt lgkmcnt(0)" ::: "memory");
}

constexpr int TR_I_CAT = 16 * 264, TR_NITEMS = TR_I_CAT + 4 * 32 + 8 * 32 + 8 * 32 + 16 * 32 + 16 * 128 + 64 * 32;
__device__ __forceinline__ void weight_transposes(const Params& P, LAS float* scr, int lane, int widx, int nw, int item_lo, int item_hi) {
    unsigned char* ws = P.ws;
    constexpr int I_CAT = 16 * 264, I_BA = 4 * 32, I_BB = 8 * 32, I_BM = 8 * 32, I_OUT = 16 * 32, I_UP = 16 * 128, I_DN = 64 * 32;
    bf16_t* WCAT = (bf16_t*)(ws + WS_WCAT); bf16_t* WBR = (bf16_t*)(ws + WS_WBR); bf16_t* WOUT = (bf16_t*)(ws + WS_WOUT); bf16_t* WUP = (bf16_t*)(ws + WS_WUP); bf16_t* WDN = (bf16_t*)(ws + WS_WDN);
    for (int it = item_lo + widx; it < item_hi; it += nw) {
        int r = it;
        if (r < I_CAT) { const int kb = r / 264, nb = r % 264; const float* base; int ld, col; cat_src(P, nb * 32 + (lane & 31), base, ld, col);
            transpose_item(base + col, ld, kb * 64, nullptr, WCAT, 1024, nb * 32, 0, scr, lane); continue; }
        r -= I_CAT;
        if (r < I_BA) { const int kb = r / 32, nb = r % 32; transpose_item(P.in[15] + nb * 32 + (lane & 31), 1024, kb * 64, nullptr, WBR, 1280, nb * 32, 0, scr, lane); continue; }
        r -= I_BA;
        if (r < I_BB) { const int kb = r / 32, nb = r % 32; transpose_item(P.in[16] + nb * 32 + (lane & 31), 1024, kb * 64, nullptr, WBR, 1280, nb * 32, 256, scr, lane); continue; }
        r -= I_BB;
        if (r < I_BM) { const int kb = r / 32, nb = r % 32; transpose_item(P.in[17] + nb * 32 + (lane & 31), 1024, kb * 64, nullptr, WBR, 1280, nb * 32, 768, scr, lane); continue; }
        r -= I_BM;
        if (r < I_OUT) { const int kb = r / 32, nb = r % 32; transpose_item(P.in[18] + nb * 32 + (lane & 31), 1024, kb * 64, nullptr, WOUT, 1024, nb * 32, 0, scr, lane); continue; }
        r -= I_OUT;
        if (r < I_UP) { const int kb = r / 128, nb = r % 128; transpose_item(P.in[20] + nb * 32 + (lane & 31), 4096, kb * 64, P.in[19], WUP, 1024, nb * 32, 0, scr, lane); continue; }
        r -= I_UP;
        { const int kb = r / 32, nb = r % 32; transpose_item(P.in[21] + nb * 32 + (lane & 31), 1024, kb * 64, nullptr, WDN, 4096, nb * 32, 0, scr, lane); }
    }
}

__device__ __forceinline__ void p0_prologue(const Params& P, LAS unsigned char* lds, int vcu, int G) {
    const int tid = threadIdx.x, lane = tid & 63, wave = tid >> 6;
    unsigned char* ws = P.ws;
    const float* w_in = P.in[3];
    LAS float* wfl = (LAS float*)(lds + 73728);
    { float wv[16], gv[16];
#pragma unroll
      for (int j = 0; j < 16; ++j) { const int i = tid + 512 * j, k = i >> 3, c = i & 7; wv[j] = w_in[(size_t)k * 4360 + 3840 + c]; gv[j] = P.in[2][k]; }
#pragma unroll
      for (int j = 0; j < 16; ++j) { const int i = tid + 512 * j, k = i >> 3, c = i & 7; wfl[c * 1024 + k] = wv[j] * gv[j]; } }
    const int gtid = vcu * 512 + tid, GT = G * 512;
    { float* ssq = (float*)(ws + WS_SSQ); for (int i = gtid; i < M_; i += GT) ssq[i] = 0.f;
      float* ssqq = (float*)(ws + WS_SSQQ); for (int i = gtid; i < M_ * 4; i += GT) ssqq[i] = 0.f; }
    { float* cosT = (float*)(ws + WS_COS); float* sinT = (float*)(ws + WS_SIN);
      for (int i = gtid; i < 4096 * 8; i += GT) { const int t = i >> 3, f = i & 7; const float inv = powf(500000.0f, -(float)(2 * f) / 16.0f); const float ang = (float)t * inv; cosT[i] = cosf(ang); sinT[i] = sinf(ang); } }
    LAS float* scr = (LAS float*)(lds + wave * 8448);
    const int gw = vcu * 8 + wave, NGW = G * 8;
    weight_transposes(P, scr, lane, gw, NGW, 0, TR_I_CAT);
    __syncthreads();
    bf16_t* AALL = (bf16_t*)P.out;
    float* logf = (float*)(ws + WS_LOGF);
    const float* bfv = P.in[4];
    constexpr int RB = 2;
    const int gwr = (gw + NGW / 2) % NGW;
    for (int base = gwr * RB; base < M_ + 2048; base += NGW * RB) {
        const bool ismem = base >= M_;
        const float* xb = ismem ? P.in[1] + (size_t)(base - M_) * 1024 : P.in[0] + (size_t)base * 1024;
        const float* gp = ismem ? P.in[9] : P.in[2];
        f32x4 v[RB][4];
#pragma unroll
        for (int r = 0; r < RB; ++r)
#pragma unroll
            for (int j = 0; j < 4; ++j) v[r][j] = ((const f32x4*)(xb + (size_t)r * 1024))[lane + 64 * j];
        float ssq[RB], red[RB];
#pragma unroll
        for (int r = 0; r < RB; ++r) { float s = 0.f;
#pragma unroll
            for (int j = 0; j < 4; ++j) s += (v[r][j][0] * v[r][j][0] + v[r][j][1] * v[r][j][1]) + (v[r][j][2] * v[r][j][2] + v[r][j][3] * v[r][j][3]);
            ssq[r] = s; red[r] = 0.f; }
        if (!ismem) {
            float a[RB][8];
#pragma unroll
            for (int c = 0; c < 8; ++c) {
                f32x4 w[4];
#pragma unroll
                for (int j = 0; j < 4; ++j) w[j] = ((const LAS f32x4*)(wfl + c * 1024))[lane + 64 * j];
#pragma unroll
                for (int r = 0; r < RB; ++r) { float t = 0.f;
#pragma unroll
                    for (int j = 0; j < 4; ++j) t += (v[r][j][0] * w[j][0] + v[r][j][1] * w[j][1]) + (v[r][j][2] * w[j][2] + v[r][j][3] * w[j][3]);
                    a[r][c] = t; }
            }
#pragma unroll
            for (int r = 0; r < RB; ++r) {
                float b4[4], b2[2];
#pragma unroll
                for (int i = 0; i < 4; ++i) { const float keep = (lane & 32) ? a[r][i + 4] : a[r][i], send = (lane & 32) ? a[r][i] : a[r][i + 4]; b4[i] = keep + __shfl_xor(send, 32); }
#pragma unroll
                for (int i = 0; i < 2; ++i) { const float keep = (lane & 16) ? b4[i + 2] : b4[i], send = (lane & 16) ? b4[i] : b4[i + 2]; b2[i] = keep + __shfl_xor(send, 16); }
                { const float keep = (lane & 8) ? b2[1] : b2[0], send = (lane & 8) ? b2[0] : b2[1]; red[r] = keep + __shfl_xor(send, 8); }
            }
#pragma unroll
            for (int o = 4; o >= 1; o >>= 1)
#pragma unroll
                for (int r = 0; r < RB; ++r) red[r] += __shfl_xor(red[r], o);
        }
#pragma unroll
        for (int o = 1; o < 64; o <<= 1)
#pragma unroll
            for (int r = 0; r < RB; ++r) ssq[r] += __shfl_xor(ssq[r], o);
#pragma unroll
        for (int r = 0; r < RB; ++r) {
            const float rstd = 1.0f / sqrtf(ssq[r] * (1.0f / 1024.0f) + EPS_);
#pragma unroll
            for (int j = 0; j < 4; ++j) { const f32x4 g = ((const f32x4*)gp)[lane + 64 * j]; const f32x4 y = v[r][j] * rstd * g;
                u32x2 w; w.x = pk2(y[0], y[1]); w.y = pk2(y[2], y[3]); ((u32x2*)(AALL + (size_t)(base + r) * 1024))[lane + 64 * j] = w; }
            if (!ismem && (lane & 7) == 0) { const int c = lane >> 3; const float z = red[r] * rstd + bfv[c]; logf[(size_t)(base + r) * 8 + c] = fminf(z, 0.f) - log1pf(expf(-fabsf(z))); }
        }
    }
}


#define XB_TMO      128
#define XB_XCNT(j)  (256  + 64 * (j))
#define XB_XSUB(j)  (1280 + 64 * (j))
#define XB_XGEN(j)  (2304 + 64 * (j))
#define XB_TOP      3328
#define XB_TOPGEN   3392
#define XCD_BAR_WORDS 3456
#define XB_SPIN_CAP (1u << 20)
__device__ __forceinline__ unsigned xb_ld(unsigned* p)              { return __hip_atomic_load(p, __ATOMIC_RELAXED, __HIP_MEMORY_SCOPE_AGENT); }
__device__ __forceinline__ unsigned xb_add(unsigned* p, unsigned v) { return __hip_atomic_fetch_add(p, v, __ATOMIC_RELAXED, __HIP_MEMORY_SCOPE_AGENT); }
__device__ __forceinline__ unsigned xb_xcc_id() { return (unsigned)__builtin_amdgcn_s_getreg((3 << 11) | 20) & 0xFu; }
#define XB_SPIN(cond, bar) do { unsigned _sp = 0; while (cond) { __builtin_amdgcn_s_sleep(1); \
    if ((++_sp & 255u) == 0u) { if (xb_ld(&(bar)[XB_TMO])) break; if (_sp > XB_SPIN_CAP) { atomicAdd(&(bar)[XB_TMO], 1u); break; } } } } while (0)
struct XcdBarrier { unsigned* bar; unsigned x; volatile LAS unsigned* st; };
__device__ __forceinline__ XcdBarrier xcd_barrier_post(unsigned* bar, volatile LAS unsigned* st) {
    XcdBarrier b; b.bar = bar; b.x = xb_xcc_id(); b.st = st;
    if (threadIdx.x == 0) (void)xb_add(&bar[XB_XCNT(b.x)], 1u);
    return b;
}
__device__ __forceinline__ void xcd_barrier_complete(unsigned* bar, unsigned x, unsigned& nloc, unsigned& nx) {
    const unsigned G = gridDim.x * gridDim.y * gridDim.z;
    unsigned sum, cnt, mine, sp = 0u;
    for (;;) {
        sum = 0u; cnt = 0u; mine = 0u;
#pragma unroll
        for (unsigned j = 0; j < 16; ++j) { const unsigned c = xb_ld(&bar[XB_XCNT(j)]); sum += c; cnt += (c > 0u) ? 1u : 0u; mine = (j == x) ? c : mine; }
        if (sum == G) break;
        __builtin_amdgcn_s_sleep(1);
        if ((++sp & 255u) == 0u) { if (xb_ld(&bar[XB_TMO])) break; if (sp > XB_SPIN_CAP) { atomicAdd(&bar[XB_TMO], 1u); break; } }
    }
    nloc = mine > 0u ? mine : 1u; nx = cnt > 0u ? cnt : 1u;
}
__device__ __forceinline__ void xcd_barrier(const XcdBarrier& b) {
    asm volatile("s_waitcnt vmcnt(0)" ::: "memory");
    __syncthreads();
    if (threadIdx.x == 0) {
        unsigned* bar = b.bar;
        __builtin_amdgcn_s_waitcnt(0);
        unsigned nloc = b.st[0], nx = b.st[1];
        if (nloc == 0u) { xcd_barrier_complete(bar, b.x, nloc, nx); b.st[0] = nloc; b.st[1] = nx; }
        const unsigned old = xb_add(&bar[XB_XSUB(b.x)], 1u);
        const unsigned gen = old / nloc;
        if (old + 1u == (gen + 1u) * nloc) {
            __builtin_amdgcn_fence(__ATOMIC_RELEASE, "agent");
            asm volatile("s_waitcnt vmcnt(0)" ::: "memory");
            const unsigned og = xb_add(&bar[XB_TOP], 1u);
            const unsigned tg = og / nx;
            if (og + 1u == (tg + 1u) * nx) xb_add(&bar[XB_TOPGEN], 1u);
            else XB_SPIN(xb_ld(&bar[XB_TOPGEN]) == tg, bar);
            __builtin_amdgcn_fence(__ATOMIC_ACQUIRE, "agent");
            xb_add(&bar[XB_XGEN(b.x)], 1u);
            asm volatile("s_waitcnt vmcnt(0)" ::: "memory");
        } else {
            XB_SPIN(xb_ld(&bar[XB_XGEN(b.x)]) == gen, bar);
            __builtin_amdgcn_fence(__ATOMIC_ACQUIRE, "agent");
            asm volatile("s_waitcnt vmcnt(0)" ::: "memory");
        }
    }
    __syncthreads();
}

__global__ void __launch_bounds__(512, 2) mk_fwd(Params P) {
    extern __shared__ __attribute__((aligned(16))) unsigned char lds_raw[];
    LAS unsigned char* lds = (LAS unsigned char*)lds_raw;
    const int G = gridDim.x, bx = blockIdx.x;
    const int vcu = (G % 8 == 0) ? (bx % 8) * (G / 8) + bx / 8 : bx;
    unsigned char* ws = P.ws;
    const int lo = P.ph_lo, hi = P.ph_hi;
#ifndef PHASE_MASK
#define PHASE_MASK 255
#endif
#define IN(k) (((PHASE_MASK >> (k)) & 1) && lo <= (k) && (k) < hi)
#define SEAM(k) do { if (IN(k) && IN((k) + 1)) { if ((k) == 0) cg::this_grid().sync(); else xcd_barrier(xbar); } } while (0)
    volatile LAS unsigned* xst = (volatile LAS unsigned*)(lds + LDS_BYTES - 64);
    if (threadIdx.x < 2) xst[threadIdx.x] = 0u;
    __syncthreads();
    XcdBarrier xbar; xbar.bar = (unsigned*)(ws + WS_BAR); xbar.x = 0; xbar.st = xst;
    if (hi - lo > 1) xbar = xcd_barrier_post((unsigned*)(ws + WS_BAR), xst);
    bf16_t* AALL = (bf16_t*)P.out;
    bf16_t* DIL = (bf16_t*)((unsigned char*)P.out + DO_DIL);
    bf16_t* Y = (bf16_t*)((unsigned char*)P.out + DO_Y);
    float* LSE = (float*)(ws + WS_LSE);
    float* C2 = (float*)(ws + WS_C2);

    if (IN(0)) { p0_prologue(P, lds, vcu, G); }
    SEAM(0);
    if (IN(1)) {
        if (G >= 224 && bx >= G - 64) cumsum_unit(lds, (const float*)(ws + WS_LOGF), C2, bx - (G - 64), P.in[7], P.in[8], (int*)(ws + WS_LO));
        pg8::Gemm g{AALL, (const bf16_t*)(ws + WS_WCAT), 1024, 1024};
        SchedP1 S{G, bx};
        EpiP1 E{(bf16_t*)(ws + WS_QA), (bf16_t*)(ws + WS_KA), (bf16_t*)(ws + WS_VA), (bf16_t*)(ws + WS_QB), (bf16_t*)(ws + WS_KB), (bf16_t*)(ws + WS_VB), (bf16_t*)(ws + WS_QM),
                (bf16_t*)(ws + WS_KM), (bf16_t*)(ws + WS_VM), (unsigned char*)(ws + WS_GATES), (float*)(ws + WS_SSQQ), P.in[5], P.in[6], P.in[7], P.in[8], P.in[14], (const float*)(ws + WS_COS), (const float*)(ws + WS_SIN)};
        pg8::gemm_phase<EpiP1, SchedP1>(lds, g, S, E);
        {
            const int maxu = (3744 + G - 1) / G; int first_short = 3744 - (maxu - 1) * G; if (first_short >= G) first_short = 0;
            if (bx >= first_short) {
                const int tid_ = threadIdx.x, wave_ = tid_ >> 6, lane_ = tid_ & 63;
                weight_transposes(P, (LAS float*)(lds + wave_ * 8448), lane_, (bx - first_short) * 8 + wave_, (G - first_short) * 8, TR_I_CAT, TR_NITEMS);
            }
        }
    }
    SEAM(1);
    if (IN(2)) {
        dil_phase(lds, ws, DIL, LSE, bx, G);
        for (int L = bx; L < 32 + 64; L += G) {
            if (L < 32) {
                memnorm_unit(lds, (bf16_t*)(ws + WS_KM) + (size_t)L * 4 * 8192, P.in[12], P.in[11], 1.0f);
            } else if (G < 224) {
                cumsum_unit(lds, (const float*)(ws + WS_LOGF), C2, L - 32, P.in[7], P.in[8], (int*)(ws + WS_LO));
            }
        }
    }
    SEAM(2);
    if (IN(3)) {
        const int* LO = (const int*)(ws + WS_LO); const float smax_fox = ((const float*)LO)[1024];
        unsigned* qctr = (unsigned*)(ws + WS_QCTR);
        volatile LAS int* qslot = (volatile LAS int*)(lds + LDS_BYTES - 128);
        for (;;) {
            if (threadIdx.x == 0) *qslot = (int)__hip_atomic_fetch_add(qctr, 1u, __ATOMIC_RELAXED, __HIP_MEMORY_SCOPE_AGENT);
            __syncthreads();
            const int L = __builtin_amdgcn_readfirstlane(*qslot);
            __syncthreads();
            if (L >= 2048) break;
            if (L < 1024) {
                const int qblk = 15 - (L >> 6), bh = L & 63, b = bh >> 3, h = bh & 7;
                const size_t Rs = (size_t)bh << 12;
                attn_unit<64, 1>(lds, (const bf16_t*)(ws + WS_QB) + Rs * 64, (const bf16_t*)(ws + WS_KB) + Rs * 64, (const bf16_t*)(ws + WS_VB) + Rs * 64, C2 + Rs, qblk,
                                 Y + 256 + h * 64, 1280, b * 4096, 0, nullptr, LO[bh * 16 + qblk], smax_fox);
            } else if (L < 1536) {
                const int u = L - 1024, bh = u >> 4, qblk = u & 15, b = bh >> 2, h = bh & 3;
                attn_unit<128, 2>(lds, (const bf16_t*)(ws + WS_QM) + ((size_t)bh << 12) * 128, (const bf16_t*)(ws + WS_KM) + ((size_t)bh << 8) * 128, (const bf16_t*)(ws + WS_VM) + ((size_t)bh << 8) * 128,
                                  (const float*)(ws + WS_SSQQ) + (size_t)b * 4096 * 4 + h, qblk, Y + 768 + h * 128, 1280, b * 4096, 0, nullptr, 0, 0.f);
            } else {
                merge_unit(DIL, LSE, Y, L - 1536);
            }
        }
    }
    SEAM(3);
    if (IN(4)) {
        pg8::Gemm g{Y, (const bf16_t*)(ws + WS_WBR), 1280, 1280};
        SchedP3 S{G, bx};
        EpiMerge E{(const unsigned char*)(ws + WS_GATES), (bf16_t*)(ws + WS_MERGED)};
        pg8::gemm_phase<EpiMerge, SchedP3>(lds, g, S, E);
    }
    SEAM(4);
    if (IN(5)) {
        pg8::Gemm g{(const bf16_t*)(ws + WS_MERGED), (const bf16_t*)(ws + WS_WOUT), 1024, 1024};
        SchedSimple S{G, bx, 4, 16};
        EpiOut E{P.in[0], P.out, (bf16_t*)(ws + WS_X1B), (float*)(ws + WS_SSQ)};
        pg8::gemm_phase<EpiOut, SchedSimple>(lds, g, S, E);
    }
    SEAM(5);
    if (IN(6)) {
        pg8::Gemm g{(const bf16_t*)(ws + WS_X1B), (const bf16_t*)(ws + WS_WUP), 1024, 1024};
        SchedSimple S{G, bx, 16, 16};
        EpiUp E{(const float*)(ws + WS_SSQ), (bf16_t*)(ws + WS_HMID)};
        pg8::gemm_phase<EpiUp, SchedSimple>(lds, g, S, E);
    }
    SEAM(6);
    if (IN(7)) {
        pg8::Gemm g{(const bf16_t*)(ws + WS_HMID), (const bf16_t*)(ws + WS_WDN), 4096, 4096};
        SchedSimple S{G, bx, 4, 64};
        EpiDown E{P.out, (const bf16_t*)(ws + WS_X1B)};
        pg8::gemm_phase<EpiDown, SchedSimple>(lds, g, S, E);
    }
#undef IN
#undef SEAM
}

extern "C" void kernel_launch(void* const* d_in, const int* in_sizes, int n_in, void* d_out, int out_size, void* d_ws, size_t ws_size, hipStream_t stream) {
    static int grid = 0;
    if (grid == 0) {
        if (n_in != 22 || in_sizes[0] != M_ * DM || out_size != M_ * DM || ws_size < WS_END) {
            fprintf(stderr, "kernel_launch: unexpected shapes (n_in %d, in0 %d, out %d, ws %zu); nothing launched\n", n_in, n_in > 0 ? in_sizes[0] : -1, out_size, ws_size); grid = -1; return; }
        int dev = 0, cus = 0, per_cu = 0;
        if (hipGetDevice(&dev) != hipSuccess || hipDeviceGetAttribute(&cus, hipDeviceAttributeMultiprocessorCount, dev) != hipSuccess) { grid = -1; return; }
        if (hipFuncSetAttribute((const void*)mk_fwd, hipFuncAttributeMaxDynamicSharedMemorySize, LDS_BYTES) != hipSuccess) { fprintf(stderr, "kernel_launch: hipFuncSetAttribute failed\n"); grid = -1; return; }
        if (hipOccupancyMaxActiveBlocksPerMultiprocessor(&per_cu, (const void*)mk_fwd, 512, LDS_BYTES) != hipSuccess || per_cu < 1) { fprintf(stderr, "kernel_launch: occupancy query gave %d\n", per_cu); (void)hipGetLastError(); grid = -1; return; }
        grid = cus * 1;
    }
    if (grid < 0) return;
    if (hipMemsetAsync((char*)d_ws + WS_BAR, 0, WS_BAR_BYTES, stream) != hipSuccess) { fprintf(stderr, "kernel_launch: hipMemsetAsync failed\n"); return; }
    Params p{};
    for (int i = 0; i < 22; ++i) p.in[i] = (const float*)d_in[i];
    p.out = (float*)d_out; p.ws = (unsigned char*)d_ws;
#if MK_MULTI
    for (int ph = 0; ph < NPH; ++ph) { p.ph_lo = ph; p.ph_hi = ph + 1; hipLaunchKernelGGL(mk_fwd, dim3(grid), dim3(512), LDS_BYTES, stream, p); }
#else
    p.ph_lo = 0; p.ph_hi = NPH;
    void* args[] = {&p};
    hipError_t e = hipLaunchCooperativeKernel((const void*)mk_fwd, dim3(grid), dim3(512), args, LDS_BYTES, stream);
    if (e != hipSuccess) fprintf(stderr, "cooperative launch failed: %s (grid %d)\n", hipGetErrorString(e), grid);
#endif
}
```

```cpp
#include <hip/hip_runtime.h>
#include <hip/hip_cooperative_groups.h>
#include <cstdio>
#include <cstdint>
namespace cg = cooperative_groups;

#ifndef MK_MULTI
#define MK_MULTI 0
#endif

#define LAS __attribute__((address_space(3)))
typedef unsigned short bf16_t;
typedef short bf16x8 __attribute__((ext_vector_type(8)));
typedef short s16x4 __attribute__((ext_vector_type(4)));
typedef float f32x4 __attribute__((ext_vector_type(4)));
typedef float f32x16 __attribute__((ext_vector_type(16)));
typedef unsigned u32x4 __attribute__((ext_vector_type(4)));
typedef unsigned u32x2 __attribute__((ext_vector_type(2)));

constexpr int B_ = 8, T_ = 4096, DM = 1024, M_ = B_ * T_;
constexpr int NPH = 8;
constexpr float EPS_ = 1e-6f;
constexpr float LOG2E = 1.4426950408889634f, LN2 = 0.6931471805599453f;
constexpr float QSCALE = 0.125f * LOG2E;
constexpr float QSCALE_M = 0.08838834764831845f * LOG2E;

constexpr size_t MiB = 1u << 20;
constexpr size_t WS_SSQ = 0, WS_COS = 256 * 1024, WS_SIN = 384 * 1024, WS_BAR = 512 * 1024, WS_BAR_BYTES = 16384, WS_QCTR = WS_BAR + 15 * 1024;
constexpr size_t WS_LOGF = 1 * MiB, WS_C2 = 2 * MiB, WS_LSE = 3 * MiB, WS_LO = 4 * MiB + 768 * 1024;
constexpr size_t WS_WCAT = 5 * MiB, WS_WBR = 22 * MiB, WS_WOUT = 25 * MiB, WS_WUP = 27 * MiB, WS_WDN = 35 * MiB;
constexpr size_t WS_KM = 43 * MiB, WS_VM = 45 * MiB, WS_SSQQ = 47 * MiB;
constexpr size_t WS_QA = 48 * MiB, WS_KA = 96 * MiB, WS_VA = 144 * MiB, WS_QB = 192 * MiB, WS_KB = 224 * MiB, WS_VB = 256 * MiB, WS_QM = 288 * MiB;
constexpr size_t WS_GATES = 320 * MiB, WS_END = 512 * MiB;
constexpr size_t WS_MERGED = 48 * MiB, WS_X1B = 320 * MiB, WS_HMID = 48 * MiB;
constexpr size_t DO_DIL = 0, DO_Y = 48 * MiB;
constexpr int LDS_BYTES = 147456;

struct Params { const float* in[22]; float* out; unsigned char* ws; int ph_lo, ph_hi; };

__device__ __forceinline__ unsigned pk2(float lo, float hi) {
    typedef float f2 __attribute__((ext_vector_type(2))); typedef __bf16 b2 __attribute__((ext_vector_type(2)));
    f2 v = {lo, hi}; b2 b = __builtin_convertvector(v, b2); return __builtin_bit_cast(unsigned, b);
}
__device__ __forceinline__ float bf2f(unsigned short u) { return __uint_as_float(((unsigned)u) << 16); }
__device__ __forceinline__ u32x4 pack8(f32x4 a, f32x4 b) { u32x4 w; w.x = pk2(a[0], a[1]); w.y = pk2(a[2], a[3]); w.z = pk2(b[0], b[1]); w.w = pk2(b[2], b[3]); return w; }
__device__ __forceinline__ void unpack8(u32x4 w, f32x4& a, f32x4& b) {
    a[0] = __uint_as_float(w.x << 16); a[1] = __uint_as_float(w.x & 0xffff0000u); a[2] = __uint_as_float(w.y << 16); a[3] = __uint_as_float(w.y & 0xffff0000u);
    b[0] = __uint_as_float(w.z << 16); b[1] = __uint_as_float(w.z & 0xffff0000u); b[2] = __uint_as_float(w.w << 16); b[3] = __uint_as_float(w.w & 0xffff0000u);
}
__device__ __forceinline__ float sigmoidf_(float x) { return __builtin_amdgcn_rcpf(1.0f + __builtin_amdgcn_exp2f(-x * LOG2E)); }

namespace pg8 {
constexpr int BM = 256, BK = 64, HALF = 128, HTB = HALF * BK * 2, STAGE_BYTES = 8 * HTB, NXCD = 8, WGM = 8;
__host__ __device__ __forceinline__ int lds_byte(int r, int c) { const int st = (r >> 4) * 2 + (c >> 5), rr = r & 15, cc = c & 31, ob = rr * 64 + cc * 2; return st * 1024 + (ob ^ (((ob >> 9) & 1) << 5)); }
__host__ __device__ __forceinline__ void stage_rc(int b, int& R, int& C) { const int st = b / 1024, sb = b % 1024, swz = sb ^ (((sb >> 9) & 1) << 5); R = (st >> 1) * 16 + swz / 64; C = (st & 1) * 32 + (swz % 64) / 2; }
__host__ __device__ __forceinline__ int perm32(int rho) { const int n = rho >> 4, i = rho & 15; return 8 * (i >> 2) + 4 * n + (i & 3); }

struct Unit { int pm, pn, k0, nt, tag, first; };
struct Gemm { const bf16_t* A; const bf16_t* Bt; int lda, ldb; };

__device__ __forceinline__ void tile_order(int L, int nM, int nN, int& pm, int& pn) {
    const int nwg = nM * nN; int wgid = L;
    { const int q = nwg / NXCD, r = nwg % NXCD, xcd = wgid % NXCD, off = wgid / NXCD; wgid = (xcd < r ? xcd * (q + 1) : r * (q + 1) + (xcd - r) * q) + off; }
    const int nig = WGM * nN, gid = wgid / nig, fm = gid * WGM, gsz = (nM - fm) < WGM ? (nM - fm) : WGM;
    pm = fm + ((wgid % nig) % gsz); pn = (wgid % nig) / gsz;
}

template <class Epi, class Sched>
__device__ __forceinline__ void gemm_phase(LAS unsigned char* lds, const Gemm g, const Sched& S, const Epi& E) {
    const int tid = threadIdx.x, wid = __builtin_amdgcn_readfirstlane(tid >> 6), lane = tid & 63, wr = wid >> 2, wc = wid & 3, fr = lane & 15, fq = lane >> 4;
    unsigned voffA[2], voffB[2];
#pragma unroll
    for (int i = 0; i < 2; ++i) { int R, C; stage_rc(tid * 16 + i * 8192, R, C); const int Rb = (R & ~31) + perm32(R & 31);
        voffA[i] = (unsigned)(R * g.lda + C) * 2u; voffB[i] = (unsigned)(Rb * g.ldb + C) * 2u; }
    const size_t kstep = (size_t)(BK * 2);
    const size_t hstepA = (size_t)HALF * g.lda * 2, hstepB = (size_t)HALF * g.ldb * 2, tstepA = 2 * hstepA, tstepB = 2 * hstepB;
    const unsigned ldsw = (unsigned)wid * 1024u;
    const int aoff = lds_byte(wr * 64 + fr, fq * 8), boff = lds_byte(wc * 32 + fr, fq * 8);
#define PG8_SA(b, h) (((b) * 2 + (h)) * HTB)
#define PG8_SB(b, h) ((4 + (b) * 2 + (h)) * HTB)
#define PG8_STAGE(bufoff, gbase, voff) do { _Pragma("unroll") for (int _i = 0; _i < 2; ++_i) \
        __builtin_amdgcn_global_load_lds((const unsigned*)((const char*)(gbase) + (voff)[_i]), (LAS unsigned*)(lds + (bufoff) + ldsw + _i * 8192), 16, 0, 0); } while (0)
#define PG8_LDA(dst, b, h) do { _Pragma("unroll") for (int m = 0; m < 4; ++m) _Pragma("unroll") for (int k = 0; k < 2; ++k) dst[m][k] = *(const LAS bf16x8*)(lds + PG8_SA(b, h) + aoff + m * 2048 + k * 1024); } while (0)
#define PG8_LDB(dst, b, h) do { _Pragma("unroll") for (int n = 0; n < 2; ++n) _Pragma("unroll") for (int k = 0; k < 2; ++k) dst[n][k] = *(const LAS bf16x8*)(lds + PG8_SB(b, h) + boff + n * 2048 + k * 1024); } while (0)
#define PG8_MMA(ai, bj, At, Bt) do { __builtin_amdgcn_s_setprio(1); _Pragma("unroll") for (int m = 0; m < 4; ++m) _Pragma("unroll") for (int n = 0; n < 2; ++n) _Pragma("unroll") for (int k = 0; k < 2; ++k) \
        acc[ai][bj][m][n] = __builtin_amdgcn_mfma_f32_16x16x32_bf16(Bt[n][k], At[m][k], acc[ai][bj][m][n], 0, 0, 0); __builtin_amdgcn_s_setprio(0); } while (0)
#define PG8_WAIT_V(n) asm volatile("s_waitcnt vmcnt(" #n ")" ::: "memory")
#define PG8_WAIT_L(n) asm volatile("s_waitcnt lgkmcnt(" #n ")" ::: "memory")
#define PG8_BAR __builtin_amdgcn_s_barrier()
#define PG8_SCHED __builtin_amdgcn_sched_barrier(0)
    Unit cur, nxt; int ui = 0;
    if (!S.next(0, cur)) return;
    f32x4 acc[2][2][4][2];
#pragma unroll
    for (int a = 0; a < 2; ++a)
#pragma unroll
        for (int b = 0; b < 2; ++b)
#pragma unroll
            for (int m = 0; m < 4; ++m)
#pragma unroll
                for (int n = 0; n < 2; ++n) acc[a][b][m][n] = (f32x4){0.f, 0.f, 0.f, 0.f};
    bf16x8 At[4][2], B0[2][2], B1[2][2];
    const char* cA = (const char*)g.A + (size_t)cur.pm * tstepA + (size_t)cur.k0 * 2; const char* cB = (const char*)g.Bt + (size_t)cur.pn * tstepB + (size_t)cur.k0 * 2;
    PG8_STAGE(PG8_SB(0, 0), cB, voffB); PG8_STAGE(PG8_SB(0, 1), cB + hstepB, voffB); PG8_STAGE(PG8_SA(0, 0), cA, voffA); PG8_STAGE(PG8_SA(0, 1), cA + hstepA, voffA);
    if (wr == 1) PG8_BAR;
    PG8_WAIT_V(2); PG8_BAR;
    PG8_STAGE(PG8_SB(1, 0), cB + kstep, voffB); PG8_STAGE(PG8_SA(1, 0), cA + kstep, voffA); PG8_STAGE(PG8_SB(1, 1), cB + hstepB + kstep, voffB);
    PG8_WAIT_V(6); PG8_BAR;
    for (;;) {
        const bool has_next = S.next(ui + 1, nxt);
        const char* nA = has_next ? (const char*)g.A + (size_t)nxt.pm * tstepA + (size_t)nxt.k0 * 2 : cA; const char* nB = has_next ? (const char*)g.Bt + (size_t)nxt.pn * tstepB + (size_t)nxt.k0 * 2 : cB;
        const int nt = cur.nt;
        for (int t = 0; t < nt; t += 2) {
            const bool last = (t == nt - 2);
            const char* a1 = cA + (size_t)(t + 1) * kstep;
            const char* a2 = last ? nA : cA + (size_t)(t + 2) * kstep; const char* b2 = last ? nB : cB + (size_t)(t + 2) * kstep;
            const char* a3 = a2 + kstep; const char* b3 = b2 + kstep;
            PG8_LDB(B0, 0, 0); PG8_LDB(B1, 0, 1); PG8_SCHED; PG8_LDA(At, 0, 0); PG8_STAGE(PG8_SA(1, 1), a1 + hstepA, voffA);
            PG8_WAIT_V(8); PG8_WAIT_L(0); PG8_BAR; PG8_MMA(0, 0, At, B0); PG8_MMA(0, 1, At, B1); PG8_BAR; PG8_SCHED;
            PG8_LDA(At, 0, 1); PG8_STAGE(PG8_SB(0, 0), b2, voffB); PG8_STAGE(PG8_SB(0, 1), b2 + hstepB, voffB); PG8_STAGE(PG8_SA(0, 0), a2, voffA);
            PG8_WAIT_V(8); PG8_WAIT_L(0); PG8_BAR; PG8_MMA(1, 0, At, B0); PG8_MMA(1, 1, At, B1); PG8_BAR; PG8_SCHED;
            PG8_LDB(B0, 1, 0); PG8_LDB(B1, 1, 1); PG8_SCHED; PG8_LDA(At, 1, 0); PG8_STAGE(PG8_SA(0, 1), a2 + hstepA, voffA);
            PG8_WAIT_V(8); PG8_WAIT_L(0); PG8_BAR; PG8_MMA(0, 0, At, B0); PG8_MMA(0, 1, At, B1); PG8_BAR; PG8_SCHED;
            PG8_LDA(At, 1, 1); PG8_STAGE(PG8_SB(1, 0), b3, voffB); PG8_STAGE(PG8_SB(1, 1), b3 + hstepB, voffB); PG8_STAGE(PG8_SA(1, 0), a3, voffA);
            PG8_WAIT_V(8); PG8_WAIT_L(0); PG8_BAR; PG8_MMA(1, 0, At, B0); PG8_MMA(1, 1, At, B1); PG8_BAR; PG8_SCHED;
        }
        if (wr == 0) PG8_BAR;
        E(acc, cur, wr, wc, fr, fq);
        if (!has_next) break;
        if (nxt.first) {
#pragma unroll
            for (int a = 0; a < 2; ++a)
#pragma unroll
                for (int b = 0; b < 2; ++b)
#pragma unroll
                    for (int m = 0; m < 4; ++m)
#pragma unroll
                        for (int n = 0; n < 2; ++n) acc[a][b][m][n] = (f32x4){0.f, 0.f, 0.f, 0.f};
        }
        cur = nxt; cA = nA; cB = nB; ++ui;
        if (wr == 1) PG8_BAR;
    }
    PG8_WAIT_V(0);
    PG8_BAR;
#undef PG8_SA
#undef PG8_SB
#undef PG8_STAGE
#undef PG8_LDA
#undef PG8_LDB
#undef PG8_MMA
#undef PG8_WAIT_V
#undef PG8_WAIT_L
#undef PG8_BAR
#undef PG8_SCHED
}
}

typedef f32x4 Acc[2][2][4][2];

struct EpiP1 {
    bf16_t *QA, *KA, *VA, *QB, *KB, *VB, *QM, *KM, *VM; unsigned char* GATES8; float* SSQQ;
    const float *g_qA, *g_kA, *g_qB, *g_kB, *b_gate, *cosT, *sinT;

    __device__ __forceinline__ void norm64(Acc& acc, int rowbase, int wc, int fq, const float* gain, float scale, bool rope, bf16_t* base, int hpb, int h, int dl) const {
        const bool dorope = rope && fq < 2;
        const int db0 = dorope ? 4 * fq : 8 * fq, dn = dorope ? 8 : 4;
#pragma unroll
        for (int ai = 0; ai < 2; ++ai)
#pragma unroll
            for (int m = 0; m < 4; ++m) {
                const int mrow = rowbase + ai * 128 + m * 16, b = mrow >> 12, t = mrow & 4095;
                float ss = 0.f;
#pragma unroll
                for (int bj = 0; bj < 2; ++bj)
#pragma unroll
                    for (int n = 0; n < 2; ++n) { const f32x4 x = acc[ai][bj][m][n]; ss += (x[0] * x[0] + x[1] * x[1]) + (x[2] * x[2] + x[3] * x[3]); }
                ss += __shfl_xor(ss, 16); ss += __shfl_xor(ss, 32);
                const float rstd = __builtin_amdgcn_rsqf(ss * (1.0f / 64.0f) + EPS_) * scale;
                f32x4 y[2][2];
#pragma unroll
                for (int n = 0; n < 2; ++n) { y[0][n] = acc[ai][0][m][n] * rstd * *(const f32x4*)(gain + db0 + dn * n); y[1][n] = acc[ai][1][m][n] * rstd * *(const f32x4*)(gain + 32 + 8 * fq + 4 * n); }
                if (dorope) {
                    const f32x4 c4 = *(const f32x4*)(cosT + t * 8 + 4 * fq), s4 = *(const f32x4*)(sinT + t * 8 + 4 * fq);
                    const f32x4 x1 = y[0][0], x2 = y[0][1];
                    y[0][0] = x1 * c4 - x2 * s4; y[0][1] = x2 * c4 + x1 * s4;
                }
                const int r = t & ((1 << dl) - 1), j = t >> dl;
                const int R = ((b * hpb + h) << 12) + (r << (12 - dl)) + j;
                bf16_t* p = base + (size_t)(R >> 6) * 4096 + (R & 63) * 8 + fq * 512;
#pragma unroll
                for (int bj = 0; bj < 2; ++bj) *(u32x4*)(p + bj * 2048) = pack8(y[bj][0], y[bj][1]);
            }
    }
    __device__ __forceinline__ void v64(Acc& acc, int rowbase, int fq, bf16_t* base, int hpb, int h, int dl) const {
#pragma unroll
        for (int ai = 0; ai < 2; ++ai)
#pragma unroll
            for (int m = 0; m < 4; ++m) {
                const int mrow = rowbase + ai * 128 + m * 16, b = mrow >> 12, t = mrow & 4095;
                const int r = t & ((1 << dl) - 1), j = t >> dl;
                const int R = ((b * hpb + h) << 12) + (r << (12 - dl)) + j;
                bf16_t* p = base + (size_t)(R >> 6) * 4096 + (R & 63) * 32 + fq * 8;
#pragma unroll
                for (int bj = 0; bj < 2; ++bj) *(u32x4*)(p + bj * 2048) = pack8(acc[ai][bj][m][0], acc[ai][bj][m][1]);
            }
    }
    __device__ __forceinline__ void raw128(Acc& acc, int rowbase, int wc, int fq, bf16_t* base, int tl, int lg, bool isv, float* ssq) const {
#pragma unroll
        for (int ai = 0; ai < 2; ++ai)
#pragma unroll
            for (int m = 0; m < 4; ++m) {
                const int mrow = rowbase + ai * 128 + m * 16, b = mrow >> lg, t = mrow & ((1 << lg) - 1);
#pragma unroll
                for (int bj = 0; bj < 2; ++bj) {
                    if (ssq) {
                        const f32x4 x0 = acc[ai][bj][m][0], x1 = acc[ai][bj][m][1];
                        float ps = (x0[0] * x0[0] + x0[1] * x0[1]) + (x0[2] * x0[2] + x0[3] * x0[3]) + (x1[0] * x1[0] + x1[1] * x1[1]) + (x1[2] * x1[2] + x1[3] * x1[3]);
                        ps += __shfl_xor(ps, 16); ps += __shfl_xor(ps, 32);
                        if (fq == 0) atomicAdd(ssq + (size_t)mrow * 4 + 2 * tl + bj, ps);
                    }
                    const int R = ((b * 4 + 2 * tl + bj) << lg) + t;
                    bf16_t* p = isv ? base + (size_t)(R >> 6) * 8192 + wc * 2048 + (R & 63) * 32 + fq * 8
                                    : base + (size_t)(R >> 6) * 8192 + (4 * wc + fq) * 512 + (R & 63) * 8;
                    *(u32x4*)p = pack8(acc[ai][bj][m][0], acc[ai][bj][m][1]);
                }
            }
    }
    __device__ __forceinline__ void operator()(Acc& acc, const pg8::Unit& u, int wr, int wc, int fr_in, int fq_in) const {
        int fr = fr_in, fq = fq_in; asm volatile("" : "+v"(fr), "+v"(fq));
        const int pn = u.pn;
        const int rowbase = u.pm * 256 + wr * 64 + fr;
        if (pn < 15) {
            if (pn < 3)       norm64(acc, rowbase, wc, fq, g_qA, QSCALE, true, QA + (size_t)pn * M_ * 256, 4, wc, 2 * pn);
            else if (pn < 6)  norm64(acc, rowbase, wc, fq, g_kA, 1.0f, true, KA + (size_t)(pn - 3) * M_ * 256, 4, wc, 2 * (pn - 3));
            else if (pn < 9)  v64(acc, rowbase, fq, VA + (size_t)(pn - 6) * M_ * 256, 4, wc, 2 * (pn - 6));
            else if (pn < 11) norm64(acc, rowbase, wc, fq, g_qB, QSCALE, false, QB, 8, 4 * (pn - 9) + wc, 0);
            else if (pn < 13) norm64(acc, rowbase, wc, fq, g_kB, 1.0f, false, KB, 8, 4 * (pn - 11) + wc, 0);
            else              v64(acc, rowbase, fq, VB, 8, 4 * (pn - 13) + wc, 0);
        } else if (pn < 17) {
            raw128(acc, rowbase, wc, fq, QM, pn - 15, 12, false, SSQQ);
        } else if (pn < 29) {
            const int colt = (pn - 17) * 256 + wc * 32 + 8 * fq;
            f32x4 bv[2][2];
#pragma unroll
            for (int bj = 0; bj < 2; ++bj)
#pragma unroll
                for (int n = 0; n < 2; ++n) bv[bj][n] = *(const f32x4*)(b_gate + colt + bj * 128 + 4 * n);
            const int lane_ = fr + 16 * fq, wid_ = wr * 4 + wc;
#pragma unroll
            for (int ai = 0; ai < 2; ++ai)
#pragma unroll
                for (int m = 0; m < 4; ++m) {
                    u32x4 w;
#pragma unroll
                    for (int bj = 0; bj < 2; ++bj)
#pragma unroll
                        for (int n = 0; n < 2; ++n) {
                            const f32x4 v = acc[ai][bj][m][n] + bv[bj][n]; unsigned pk = 0;
#pragma unroll
                            for (int e = 0; e < 4; ++e) { unsigned q = (unsigned)(sigmoidf_(v[e]) * 255.0f + 0.5f); q = q < 1u ? 1u : q; pk |= q << (8 * e); }
                            w[bj * 2 + n] = pk;
                        }
                    *(u32x4*)(GATES8 + ((((((size_t)u.pm * 12 + (pn - 17)) * 2 + ai) * 4 + m) * 8 + wid_) * 64 + lane_) * 16) = w;
                }
        } else {
            const int rb = rowbase - M_;
            if (pn < 31) raw128(acc, rb, wc, fq, KM, pn - 29, 8, false, nullptr);
            else         raw128(acc, rb, wc, fq, VM, pn - 31, 8, true, nullptr);
        }
    }
};

struct EpiMerge {
    const unsigned char* GATES8; bf16_t* MERGED;
    __device__ __forceinline__ void operator()(Acc& acc, const pg8::Unit& u, int wr, int wc, int fr_in, int fq_in) const {
        int fr = fr_in, fq = fq_in; asm volatile("" : "+v"(fr), "+v"(fq));
        const int rowbase = u.pm * 256 + wr * 64 + fr, col = u.pn * 256 + wc * 32 + 8 * fq, br = u.tag;
        const int lane_ = fr + 16 * fq, wid_ = wr * 4 + wc;
#pragma unroll
        for (int ai = 0; ai < 2; ++ai)
#pragma unroll
            for (int m = 0; m < 4; ++m) {
                const size_t frag = (((size_t)ai * 4 + m) * 8 + wid_) * 64 + lane_;
                const u32x4 gn = *(const u32x4*)(GATES8 + ((((size_t)u.pm * 12 + br * 4 + u.pn) * 8) * 512 + frag) * 16);
                if (br < 2) {
                    const u32x4 gd = *(const u32x4*)(GATES8 + ((((size_t)u.pm * 12 + (br + 1) * 4 + u.pn) * 8) * 512 + frag) * 16);
#pragma unroll
                    for (int bj = 0; bj < 2; ++bj)
#pragma unroll
                        for (int n = 0; n < 2; ++n)
#pragma unroll
                            for (int e = 0; e < 4; ++e)
                                acc[ai][bj][m][n][e] *= (float)((gn[bj * 2 + n] >> (8 * e)) & 0xffu) * __builtin_amdgcn_rcpf((float)((gd[bj * 2 + n] >> (8 * e)) & 0xffu));
                } else {
                    const int row = rowbase + ai * 128 + m * 16;
#pragma unroll
                    for (int bj = 0; bj < 2; ++bj) {
                        f32x4 o[2];
#pragma unroll
                        for (int n = 0; n < 2; ++n)
#pragma unroll
                            for (int e = 0; e < 4; ++e) o[n][e] = acc[ai][bj][m][n][e] * ((float)((gn[bj * 2 + n] >> (8 * e)) & 0xffu) * (1.0f / 255.0f));
                        *(u32x4*)(MERGED + (size_t)row * 1024 + col + bj * 128) = pack8(o[0], o[1]);
                    }
                }
            }
    }
};
struct EpiOut {
    const float* X; float* OUT; bf16_t* X1B; float* SSQ;
    __device__ __forceinline__ void operator()(Acc& acc, const pg8::Unit& u, int wr, int wc, int fr_in, int fq_in) const {
        int fr = fr_in, fq = fq_in; asm volatile("" : "+v"(fr), "+v"(fq));
        const int rowbase = u.pm * 256 + wr * 64 + fr, col = u.pn * 256 + wc * 32 + 8 * fq;
#pragma unroll
        for (int ai = 0; ai < 2; ++ai)
#pragma unroll
            for (int m = 0; m < 4; ++m) {
                const int row = rowbase + ai * 128 + m * 16; const size_t off = (size_t)row * 1024 + col;
                float ss = 0.f;
#pragma unroll
                for (int bj = 0; bj < 2; ++bj) {
                    const f32x4 x0 = *(const f32x4*)(X + off + bj * 128), x1 = *(const f32x4*)(X + off + bj * 128 + 4);
                    const f32x4 v0 = acc[ai][bj][m][0] + x0, v1 = acc[ai][bj][m][1] + x1;
                    *(u32x4*)(X1B + off + bj * 128) = pack8(v0, v1);
                    ss += (v0[0] * v0[0] + v0[1] * v0[1]) + (v0[2] * v0[2] + v0[3] * v0[3]) + (v1[0] * v1[0] + v1[1] * v1[1]) + (v1[2] * v1[2] + v1[3] * v1[3]);
                }
                ss += __shfl_xor(ss, 16); ss += __shfl_xor(ss, 32);
                if (fq == 0) atomicAdd(SSQ + row, ss);
            }
    }
};
struct EpiUp {
    const float* SSQ; bf16_t* HMID;
    __device__ __forceinline__ void operator()(Acc& acc, const pg8::Unit& u, int wr, int wc, int fr_in, int fq_in) const {
        int fr = fr_in, fq = fq_in; asm volatile("" : "+v"(fr), "+v"(fq));
        const int rowbase = u.pm * 256 + wr * 64 + fr, col = u.pn * 256 + wc * 32 + 8 * fq;
#pragma unroll
        for (int ai = 0; ai < 2; ++ai)
#pragma unroll
            for (int m = 0; m < 4; ++m) {
                const int row = rowbase + ai * 128 + m * 16;
                const float rstd = __builtin_amdgcn_rsqf(SSQ[row] * (1.0f / 1024.0f) + EPS_);
#pragma unroll
                for (int bj = 0; bj < 2; ++bj) {
                    f32x4 v0 = acc[ai][bj][m][0] * rstd, v1 = acc[ai][bj][m][1] * rstd;
#pragma unroll
                    for (int e = 0; e < 4; ++e) { const float a = fmaxf(v0[e], 0.f), b = fmaxf(v1[e], 0.f); v0[e] = a * a; v1[e] = b * b; }
                    *(u32x4*)(HMID + (size_t)row * 4096 + col + bj * 128) = pack8(v0, v1);
                }
            }
    }
};
struct EpiDown {
    float* OUT; const bf16_t* X1B;
    __device__ __forceinline__ void operator()(Acc& acc, const pg8::Unit& u, int wr, int wc, int fr_in, int fq_in) const {
        int fr = fr_in, fq = fq_in; asm volatile("" : "+v"(fr), "+v"(fq));
        const int rowbase = u.pm * 256 + wr * 64 + fr, col = u.pn * 256 + wc * 32 + 8 * fq;
#pragma unroll
        for (int ai = 0; ai < 2; ++ai)
#pragma unroll
            for (int m = 0; m < 4; ++m) {
                const size_t off = (size_t)(rowbase + ai * 128 + m * 16) * 1024 + col;
#pragma unroll
                for (int bj = 0; bj < 2; ++bj) {
                    f32x4 x0, x1; unpack8(*(const u32x4*)(X1B + off + bj * 128), x0, x1);
                    *(f32x4*)(OUT + off + bj * 128) = acc[ai][bj][m][0] + x0; *(f32x4*)(OUT + off + bj * 128 + 4) = acc[ai][bj][m][1] + x1;
                }
            }
    }
};

struct SchedP1 { int G, c;
    __device__ __forceinline__ bool next(int i, pg8::Unit& u) const {
        const int L = i * G + c;
        if (L < 3712) pg8::tile_order(L, 128, 29, u.pm, u.pn);
        else if (L < 3744) { const int idx = L - 3712; u.pm = 128 + (idx >> 2); u.pn = 29 + (idx & 3); }
        else return false;
        u.k0 = 0; u.nt = 16; u.tag = 0; u.first = 1; return true; } };
struct SchedSimple { int G, c, nN, nt;
    __device__ __forceinline__ bool next(int i, pg8::Unit& u) const {
        const int L = i * G + c; if (L >= 128 * nN) return false;
        pg8::tile_order(L, 128, nN, u.pm, u.pn); u.k0 = 0; u.nt = nt; u.tag = 0; u.first = 1; return true; } };
struct SchedP3 { int G, c;
    __device__ __forceinline__ bool next(int i, pg8::Unit& u) const {
        const int ti = i / 3, br = i - 3 * ti; const int L = ti * G + c; if (L >= 512) return false;
        pg8::tile_order(L, 128, 4, u.pm, u.pn); u.k0 = (br == 0) ? 0 : (br == 1 ? 256 : 768); u.nt = (br == 0) ? 4 : 8; u.tag = br; u.first = (br == 0); return true; } };

__device__ __forceinline__ float max3f(float a, float b, float c) { float r; asm("v_max3_f32 %0, %1, %2, %3" : "=v"(r) : "v"(a), "v"(b), "v"(c)); return r; }
__device__ __forceinline__ float max2f(float a, float b) { float r; asm("v_max_f32_e32 %0, %1, %2" : "=v"(r) : "v"(a), "v"(b)); return r; }
__device__ __forceinline__ float halfmax(float m) { auto rr = __builtin_amdgcn_permlane32_swap(__float_as_uint(m), __float_as_uint(m), false, false); return max2f(__uint_as_float(rr[0]), __uint_as_float(rr[1])); }
__device__ __forceinline__ float halfsum(float m) { auto rr = __builtin_amdgcn_permlane32_swap(__float_as_uint(m), __float_as_uint(m), false, false); return __uint_as_float(rr[0]) + __uint_as_float(rr[1]); }
__device__ __forceinline__ float rowmax32(f32x16& p0, f32x16& p1) {
    asm volatile("s_nop 15\n\ts_nop 7" : "+v"(p0), "+v"(p1));
    float a = max3f(p0[0], p0[1], p1[0]), b = max3f(p0[2], p0[3], p1[1]); a = max3f(a, p1[2], p1[3]);
#pragma unroll
    for (int r = 4; r < 16; r += 4) { a = max3f(a, p0[r], p0[r + 1]); b = max3f(b, p0[r + 2], p0[r + 3]); a = max3f(a, p1[r], p1[r + 1]); b = max3f(b, p1[r + 2], p1[r + 3]); }
    return halfmax(max2f(a, b));
}

template <int D, int MODE>
__device__ __forceinline__ void attn_unit(LAS unsigned char* lds, const bf16_t* __restrict__ Qs, const bf16_t* __restrict__ Ks, const bf16_t* __restrict__ Vs,
                                          const float* __restrict__ c2s, int qblk, bf16_t* out, int opitch, int orow0, int odl, float* lse, int fox_lo, float smax) {
    constexpr int TB = 128 * D, NP = TB / 16 / 512, KS = D / 16, DB = D / 32, TE = 64 * D;
    constexpr int TPS = (D == 64) ? 2 : 1;
    constexpr int OFF_V = 2 * TPS * TB, OFF_C = 4 * TPS * TB, OFF_O = OFF_C + 2 * TPS * 256, PITCH = 2 * D + 16;
    const int tid = threadIdx.x, lane = tid & 63, wid = __builtin_amdgcn_readfirstlane(tid >> 6), r32 = lane & 31, hi = lane >> 5;
    const int jw = qblk * 256 + 32 * wid;
    int kt_lo = 0, kt_hi = 4;
    if (MODE == 0) { kt_lo = 4 * qblk - 2; if (kt_lo < 0) kt_lo = 0; kt_hi = 4 * qblk + 4; }
    if (MODE == 1) { kt_hi = 4 * qblk + 4; kt_lo = fox_lo; }
    const int ntile = kt_hi - kt_lo, nstep = (ntile + TPS - 1) / TPS;
#define KT(i) ((MODE == 1) ? (kt_hi - 1 - (i)) : (kt_lo + (i)))
    bf16x8 qf[KS];
    { const bf16_t* qp = Qs + (size_t)(jw >> 6) * TE + ((jw & 63) + r32) * 8 + hi * 512;
#pragma unroll
      for (int ks = 0; ks < KS; ++ks) qf[ks] = *(const bf16x8*)(qp + ks * 1024); }
    float cq = 0.f; if (MODE == 1) cq = c2s[jw + r32];
    float rq = 1.f; if (MODE == 2) rq = __builtin_amdgcn_rsqf(c2s[(size_t)(jw + r32) * 4] * (1.0f / 128.0f) + EPS_) * QSCALE_M;
    f32x16 o[DB];
#pragma unroll
    for (int d = 0; d < DB; ++d)
#pragma unroll
        for (int i = 0; i < 16; ++i) o[d][i] = 0.f;
    float mrun = (MODE == 1) ? 0.f : -1e30f, lrun = 0.f; bool started = false; (void)started;
    u32x4 kr[TPS][NP], vr[TPS][NP]; f32x4 cr[TPS];
#pragma unroll
    for (int sb = 0; sb < TPS; ++sb) cr[sb] = (f32x4){0.f, 0.f, 0.f, 0.f};
#define ATT_GLOAD(st_) do { _Pragma("unroll") for (int sb_ = 0; sb_ < TPS; ++sb_) { const int i_ = (st_) * TPS + sb_; if (i_ < ntile) { const int kt_ = KT(i_); \
        const u32x4* kp_ = (const u32x4*)(Ks + (size_t)kt_ * TE) + tid; const u32x4* vp_ = (const u32x4*)(Vs + (size_t)kt_ * TE) + tid; \
        _Pragma("unroll") for (int p_ = 0; p_ < NP; ++p_) { kr[sb_][p_] = kp_[p_ * 512]; vr[sb_][p_] = vp_[p_ * 512]; } \
        if (MODE == 1) { if (tid < 16) cr[sb_] = ((const f32x4*)(c2s + kt_ * 64))[tid]; } } } } while (0)
    constexpr int OFF_F = OFF_O + 8 * 32 * PITCH;
    if (MODE == 1) { if (lane == 0) ((LAS unsigned*)(lds + OFF_F))[wid] = 0u; }
    ATT_GLOAD(0);
    for (int st = 0; st < nstep; ++st) {
#pragma unroll
        for (int sb = 0; sb < TPS; ++sb) { const int slot = (st & 1) * TPS + sb;
          LAS u32x4* kd = (LAS u32x4*)(lds + slot * TB) + tid; LAS u32x4* vd = (LAS u32x4*)(lds + OFF_V + slot * TB) + tid;
#pragma unroll
          for (int p = 0; p < NP; ++p) { kd[p * 512] = kr[sb][p]; vd[p * 512] = vr[sb][p]; }
          if (MODE == 1) { if (tid < 16) ((LAS f32x4*)(lds + OFF_C + slot * 256))[tid] = cr[sb]; } }
        __syncthreads();
        if (MODE == 1) {
            const u32x4 f0 = ((const LAS u32x4*)(lds + OFF_F))[0], f1 = ((const LAS u32x4*)(lds + OFF_F))[1];
            if ((f0.x & f0.y & f0.z & f0.w & f1.x & f1.y & f1.z & f1.w) != 0u) break;
        }
        if (st + 1 < nstep) ATT_GLOAD(st + 1);
#pragma unroll
      for (int sb = 0; sb < TPS; ++sb) {
        const int it = st * TPS + sb; if (it >= ntile) break;
        const int kt = KT(it);
        const int buf = (st & 1) * TPS + sb;
        bool active = true;
        if (MODE == 0) active = (kt * 64 + 63 >= jw - 128) && (kt * 64 <= jw + 31);
        if (MODE == 1) {
            active = (kt * 64 <= jw + 31);
            if (active) { const float cend = ((const LAS float*)(lds + OFF_C + buf * 256))[63];
                active = !started || __builtin_amdgcn_ballot_w64(smax + cq - cend - mrun >= -135.0f) != 0;
                if (!active) { if (lane == 0) ((LAS unsigned*)(lds + OFF_F))[wid] = 1u; } }
        }
        if (active) {
            f32x16 s0, s1;
            if (MODE == 1) {
                const LAS f32x4* cb = (const LAS f32x4*)(lds + OFF_C + buf * 256);
                const float cqm = cq - mrun;
#pragma unroll
                for (int i4 = 0; i4 < 4; ++i4) { const f32x4 c0 = cb[2 * i4 + hi], c1 = cb[8 + 2 * i4 + hi];
#pragma unroll
                    for (int e = 0; e < 4; ++e) { s0[4 * i4 + e] = cqm - c0[e]; s1[4 * i4 + e] = cqm - c1[e]; } }
            } else {
#pragma unroll
                for (int i = 0; i < 16; ++i) { s0[i] = 0.f; s1[i] = 0.f; }
            }
            const LAS unsigned char* kb = lds + buf * TB + hi * 1024 + r32 * 16;
#pragma unroll
            for (int ks = 0; ks < KS; ++ks) {
                const bf16x8 a0 = *(const LAS bf16x8*)(kb + ks * 2048), a1 = *(const LAS bf16x8*)(kb + ks * 2048 + 512);
                s0 = __builtin_amdgcn_mfma_f32_32x32x16_bf16(a0, qf[ks], s0, 0, 0, 0);
                s1 = __builtin_amdgcn_mfma_f32_32x32x16_bf16(a1, qf[ks], s1, 0, 0, 0);
            }
            if (MODE == 2) {
#pragma unroll
                for (int i = 0; i < 16; ++i) { s0[i] *= rq; s1[i] *= rq; }
            }
            const int q = jw + r32, key0 = kt * 64 + 4 * hi;
            if (MODE == 0) {
#pragma unroll
                for (int i = 0; i < 16; ++i) { const int key = key0 + 8 * (i >> 2) + (i & 3);
                    if (key > q || key < q - 128) s0[i] = -INFINITY;
                    if (key + 32 > q || key + 32 < q - 128) s1[i] = -INFINITY; }
            }
            if (MODE == 1) {
                if (kt * 64 + 63 > jw) {
#pragma unroll
                    for (int i = 0; i < 16; ++i) { const int key = key0 + 8 * (i >> 2) + (i & 3);
                        if (key > q) s0[i] = -INFINITY;
                        if (key + 32 > q) s1[i] = -INFINITY; }
                }
            }
            const float mx = rowmax32(s0, s1);
            float rs = 0.f;
            if (MODE == 1) {
                if (!started) {
                    started = true; mrun = mx;
#pragma unroll
                    for (int i = 0; i < 16; ++i) { s0[i] -= mx; s1[i] -= mx; }
                } else if (__builtin_amdgcn_ballot_w64(mx > 0.f) != 0) {
                    const float dl = max2f(mx, 0.f), alpha = __builtin_amdgcn_exp2f(-dl);
                    mrun += dl; lrun *= alpha;
#pragma unroll
                    for (int i = 0; i < 16; ++i) { s0[i] -= dl; s1[i] -= dl; }
#pragma unroll
                    for (int d = 0; d < DB; ++d)
#pragma unroll
                        for (int i = 0; i < 16; ++i) o[d][i] *= alpha;
                }
#pragma unroll
                for (int i = 0; i < 16; ++i) { s0[i] = __builtin_amdgcn_exp2f(s0[i]); s1[i] = __builtin_amdgcn_exp2f(s1[i]); rs += s0[i] + s1[i]; }
            } else {
                const float mnew = max2f(mrun, mx);
                if (__builtin_amdgcn_ballot_w64(mnew > mrun) != 0) {
                    const float alpha = __builtin_amdgcn_exp2f(mrun - mnew);
                    lrun *= alpha;
#pragma unroll
                    for (int d = 0; d < DB; ++d)
#pragma unroll
                        for (int i = 0; i < 16; ++i) o[d][i] *= alpha;
                }
                mrun = mnew;
#pragma unroll
                for (int i = 0; i < 16; ++i) { s0[i] = __builtin_amdgcn_exp2f(s0[i] - mnew); s1[i] = __builtin_amdgcn_exp2f(s1[i] - mnew); rs += s0[i] + s1[i]; }
            }
            lrun += rs;
            u32x4 pw[4];
            pw[0] = (u32x4){pk2(s0[0], s0[1]), pk2(s0[2], s0[3]), pk2(s0[4], s0[5]), pk2(s0[6], s0[7])};
            pw[1] = (u32x4){pk2(s0[8], s0[9]), pk2(s0[10], s0[11]), pk2(s0[12], s0[13]), pk2(s0[14], s0[15])};
            pw[2] = (u32x4){pk2(s1[0], s1[1]), pk2(s1[2], s1[3]), pk2(s1[4], s1[5]), pk2(s1[6], s1[7])};
            pw[3] = (u32x4){pk2(s1[8], s1[9]), pk2(s1[10], s1[11]), pk2(s1[12], s1[13]), pk2(s1[14], s1[15])};
            const LAS unsigned char* vb = lds + OFF_V + buf * TB + ((lane >> 4) & 1) * 32 + (lane & 3) * 8 + (4 * hi + ((lane & 15) >> 2)) * 64;
#pragma unroll
            for (int d = 0; d < DB; ++d)
#pragma unroll
                for (int kk = 0; kk < 4; ++kk) {
                    typedef short v4i16_t __attribute__((ext_vector_type(4)));
                    const s16x4 lo = __builtin_bit_cast(s16x4, __builtin_amdgcn_ds_read_tr16_b64_v4i16((LAS v4i16_t*)(vb + d * 4096 + kk * 1024)));
                    const s16x4 hh = __builtin_bit_cast(s16x4, __builtin_amdgcn_ds_read_tr16_b64_v4i16((LAS v4i16_t*)(vb + d * 4096 + kk * 1024 + 512)));
                    const bf16x8 vf = (bf16x8){lo[0], lo[1], lo[2], lo[3], hh[0], hh[1], hh[2], hh[3]};
                    o[d] = __builtin_amdgcn_mfma_f32_32x32x16_bf16(vf, __builtin_bit_cast(bf16x8, pw[kk]), o[d], 0, 0, 0);
                }
        }
      }
    }
#undef ATT_GLOAD
#undef KT
    lrun = halfsum(lrun);
    const float inv = 1.0f / lrun;
    if (MODE == 0) { if (hi == 0) lse[(size_t)(orow0 + ((jw + r32) << odl)) * 4] = (mrun + __builtin_amdgcn_logf(lrun)) * LN2; }
    LAS unsigned char* stw = lds + OFF_O + wid * (32 * PITCH);
#pragma unroll
    for (int d = 0; d < DB; ++d)
#pragma unroll
        for (int i4 = 0; i4 < 4; ++i4) {
            u32x2 w; w.x = pk2(o[d][4 * i4] * inv, o[d][4 * i4 + 1] * inv); w.y = pk2(o[d][4 * i4 + 2] * inv, o[d][4 * i4 + 3] * inv);
            *(LAS u32x2*)(stw + r32 * PITCH + (32 * d + 8 * i4 + 4 * hi) * 2) = w;
        }
    constexpr int LPR = D / 8, RPI = 64 / LPR;
#pragma unroll
    for (int it = 0; it < 32 / RPI; ++it) {
        const int row = it * RPI + lane / LPR, ch = lane % LPR;
        const u32x4 v = *(const LAS u32x4*)(stw + row * PITCH + ch * 16);
        const int mrow = orow0 + ((jw + row) << odl);
        *(u32x4*)(out + (size_t)mrow * opitch + ch * 8) = v;
    }
    __syncthreads();
}

struct DilUnit { const bf16_t *Qs, *Ks, *Vs; bf16_t* out; float* lse; int qblk, orow0, odl; };
__device__ __forceinline__ void dil_decode(unsigned char* ws, bf16_t* DIL, float* LSE, int L, DilUnit& u) {
    const int gi = L / 512, rem = L % 512, bh = rem >> 4, rj = rem & 15, b = bh >> 2, h = bh & 3;
    const int dl = 2 * gi, qpb = 16 >> dl;
    const int r = rj / qpb; u.qblk = rj % qpb;
    const size_t Rs = ((size_t)(b * 4 + h) << 12) + ((size_t)r << (12 - dl));
    u.Qs = (const bf16_t*)(ws + WS_QA) + (size_t)gi * M_ * 256 + Rs * 64;
    u.Ks = (const bf16_t*)(ws + WS_KA) + (size_t)gi * M_ * 256 + Rs * 64;
    u.Vs = (const bf16_t*)(ws + WS_VA) + (size_t)gi * M_ * 256 + Rs * 64;
    u.out = DIL + (size_t)gi * M_ * 256 + h * 64; u.lse = LSE + (size_t)gi * M_ * 4 + h; u.orow0 = b * 4096 + r; u.odl = dl;
}
__device__ __forceinline__ void dil_phase(LAS unsigned char* lds, unsigned char* ws, bf16_t* DIL, float* LSE, int bx, int G) {
    constexpr int TB = 8192, TE = 4096, OFF_V = 6 * TB, OFF_O = 12 * TB, PITCH = 144;
    typedef short v4i16_t __attribute__((ext_vector_type(4)));
    int tid = threadIdx.x; asm volatile("" : "+v"(tid));
    const int lane = tid & 63, wid = __builtin_amdgcn_readfirstlane(tid >> 6), r32 = lane & 31, hi = lane >> 5;
    if (bx >= 1536) return;
    DilUnit cur, nxt; dil_decode(ws, DIL, LSE, bx, cur);
    u32x4 kr[6], vr[6]; bf16x8 qn[4];
#define DIL_LOAD(U) do { const int t0_ = 4 * (U).qblk - 2; \
        _Pragma("unroll") for (int s_ = 0; s_ < 6; ++s_) { if (t0_ + s_ >= 0) { kr[s_] = ((const u32x4*)((U).Ks + (size_t)(t0_ + s_) * TE))[tid]; vr[s_] = ((const u32x4*)((U).Vs + (size_t)(t0_ + s_) * TE))[tid]; } } \
        const int jw_ = (U).qblk * 256 + 32 * wid; const bf16_t* qp_ = (U).Qs + (size_t)(jw_ >> 6) * TE + ((jw_ & 63) + r32) * 8 + hi * 512; \
        _Pragma("unroll") for (int ks = 0; ks < 4; ++ks) qn[ks] = *(const bf16x8*)(qp_ + ks * 1024); } while (0)
#pragma unroll
    for (int s = 0; s < 6; ++s) { kr[s] = (u32x4){0u, 0u, 0u, 0u}; vr[s] = (u32x4){0u, 0u, 0u, 0u}; }
    DIL_LOAD(cur);
    for (int L = bx; L < 1536; L += G) {
        const bool has_next = (L + G < 1536);
        if (has_next) dil_decode(ws, DIL, LSE, L + G, nxt);
#pragma unroll
        for (int s = 0; s < 6; ++s) { ((LAS u32x4*)(lds + s * TB))[tid] = kr[s]; ((LAS u32x4*)(lds + OFF_V + s * TB))[tid] = vr[s]; }
        bf16x8 qf[4];
#pragma unroll
        for (int ks = 0; ks < 4; ++ks) qf[ks] = qn[ks];
        __syncthreads();
        if (has_next) DIL_LOAD(nxt);
        const int jw = cur.qblk * 256 + 32 * wid, q = jw + r32, t0 = 4 * cur.qblk - 2;
        int kfirst = (jw - 128) >> 6; if (kfirst < 0) kfirst = 0;
        const int klast = (jw + 31) >> 6;
        f32x16 o[2];
#pragma unroll
        for (int d = 0; d < 2; ++d)
#pragma unroll
            for (int i = 0; i < 16; ++i) o[d][i] = 0.f;
        float mrun = -1e30f, lrun = 0.f;
        for (int kt = kfirst; kt <= klast; ++kt) {
            const int slot = kt - t0;
            f32x16 s0, s1;
#pragma unroll
            for (int i = 0; i < 16; ++i) { s0[i] = 0.f; s1[i] = 0.f; }
            const LAS unsigned char* kb = lds + slot * TB + hi * 1024 + r32 * 16;
#pragma unroll
            for (int ks = 0; ks < 4; ++ks) {
                const bf16x8 a0 = *(const LAS bf16x8*)(kb + ks * 2048), a1 = *(const LAS bf16x8*)(kb + ks * 2048 + 512);
                s0 = __builtin_amdgcn_mfma_f32_32x32x16_bf16(a0, qf[ks], s0, 0, 0, 0);
                s1 = __builtin_amdgcn_mfma_f32_32x32x16_bf16(a1, qf[ks], s1, 0, 0, 0);
            }
            const int key0 = kt * 64 + 4 * hi;
#pragma unroll
            for (int i = 0; i < 16; ++i) { const int key = key0 + 8 * (i >> 2) + (i & 3);
                if (key > q || key < q - 128) s0[i] = -INFINITY;
                if (key + 32 > q || key + 32 < q - 128) s1[i] = -INFINITY; }
            const float mx = rowmax32(s0, s1);
            const float mnew = max2f(mrun, mx);
            if (__builtin_amdgcn_ballot_w64(mnew > mrun) != 0) {
                const float alpha = __builtin_amdgcn_exp2f(mrun - mnew);
                lrun *= alpha;
#pragma unroll
                for (int d = 0; d < 2; ++d)
#pragma unroll
                    for (int i = 0; i < 16; ++i) o[d][i] *= alpha;
            }
            mrun = mnew;
            float rs = 0.f;
#pragma unroll
            for (int i = 0; i < 16; ++i) { s0[i] = __builtin_amdgcn_exp2f(s0[i] - mnew); s1[i] = __builtin_amdgcn_exp2f(s1[i] - mnew); rs += s0[i] + s1[i]; }
            lrun += rs;
            u32x4 pw[4];
            pw[0] = (u32x4){pk2(s0[0], s0[1]), pk2(s0[2], s0[3]), pk2(s0[4], s0[5]), pk2(s0[6], s0[7])};
            pw[1] = (u32x4){pk2(s0[8], s0[9]), pk2(s0[10], s0[11]), pk2(s0[12], s0[13]), pk2(s0[14], s0[15])};
            pw[2] = (u32x4){pk2(s1[0], s1[1]), pk2(s1[2], s1[3]), pk2(s1[4], s1[5]), pk2(s1[6], s1[7])};
            pw[3] = (u32x4){pk2(s1[8], s1[9]), pk2(s1[10], s1[11]), pk2(s1[12], s1[13]), pk2(s1[14], s1[15])};
            const LAS unsigned char* vb = lds + OFF_V + slot * TB + ((lane >> 4) & 1) * 32 + (lane & 3) * 8 + (4 * hi + ((lane & 15) >> 2)) * 64;
#pragma unroll
            for (int d = 0; d < 2; ++d)
#pragma unroll
                for (int kk = 0; kk < 4; ++kk) {
                    const s16x4 lo = __builtin_bit_cast(s16x4, __builtin_amdgcn_ds_read_tr16_b64_v4i16((LAS v4i16_t*)(vb + d * 4096 + kk * 1024)));
                    const s16x4 hh = __builtin_bit_cast(s16x4, __builtin_amdgcn_ds_read_tr16_b64_v4i16((LAS v4i16_t*)(vb + d * 4096 + kk * 1024 + 512)));
                    const bf16x8 vf = (bf16x8){lo[0], lo[1], lo[2], lo[3], hh[0], hh[1], hh[2], hh[3]};
                    o[d] = __builtin_amdgcn_mfma_f32_32x32x16_bf16(vf, __builtin_bit_cast(bf16x8, pw[kk]), o[d], 0, 0, 0);
                }
        }
        lrun = halfsum(lrun);
        const float inv = 1.0f / lrun;
        if (hi == 0) cur.lse[(size_t)(cur.orow0 + ((jw + r32) << cur.odl)) * 4] = (mrun + __builtin_amdgcn_logf(lrun)) * LN2;
        LAS unsigned char* stw = lds + OFF_O + wid * (32 * PITCH);
#pragma unroll
        for (int d = 0; d < 2; ++d)
#pragma unroll
            for (int i4 = 0; i4 < 4; ++i4) {
                u32x2 w; w.x = pk2(o[d][4 * i4] * inv, o[d][4 * i4 + 1] * inv); w.y = pk2(o[d][4 * i4 + 2] * inv, o[d][4 * i4 + 3] * inv);
                *(LAS u32x2*)(stw + r32 * PITCH + (32 * d + 8 * i4 + 4 * hi) * 2) = w;
            }
#pragma unroll
        for (int it = 0; it < 4; ++it) {
            const int row = it * 8 + (lane >> 3), ch = lane & 7;
            const u32x4 v = *(const LAS u32x4*)(stw + row * PITCH + ch * 16);
            const int mrow = cur.orow0 + ((jw + row) << cur.odl);
            *(u32x4*)(cur.out + (size_t)mrow * 256 + ch * 8) = v;
        }
        __syncthreads();
        cur = nxt;
    }
#undef DIL_LOAD
}

__device__ __forceinline__ void memnorm_unit(LAS unsigned char* lds, bf16_t* tiles, const float* gain, const float* gain2, float scale) {
    int tid = threadIdx.x; asm volatile("" : "+v"(tid));
    const int lane = tid & 63, wid = tid >> 6;
    LAS float* part = (LAS float*)lds;
    u32x4 raw[4][2];
#pragma unroll
    for (int t = 0; t < 4; ++t) { raw[t][0] = *(const u32x4*)(tiles + (size_t)t * 8192 + (2 * wid) * 512 + lane * 8); raw[t][1] = *(const u32x4*)(tiles + (size_t)t * 8192 + (2 * wid + 1) * 512 + lane * 8); }
#pragma unroll
    for (int t = 0; t < 4; ++t) {
        f32x4 a0, a1, b0, b1; unpack8(raw[t][0], a0, a1); unpack8(raw[t][1], b0, b1);
        float ss = 0.f;
#pragma unroll
        for (int e = 0; e < 4; ++e) ss += a0[e] * a0[e] + a1[e] * a1[e] + b0[e] * b0[e] + b1[e] * b1[e];
        part[(t * 8 + wid) * 64 + lane] = ss;
    }
    __syncthreads();
    const f32x4 g0 = *(const f32x4*)(gain + 16 * wid) * *(const f32x4*)(gain2 + 16 * wid), g1 = *(const f32x4*)(gain + 16 * wid + 4) * *(const f32x4*)(gain2 + 16 * wid + 4),
                g2 = *(const f32x4*)(gain + 16 * wid + 8) * *(const f32x4*)(gain2 + 16 * wid + 8), g3 = *(const f32x4*)(gain + 16 * wid + 12) * *(const f32x4*)(gain2 + 16 * wid + 12);
#pragma unroll
    for (int t = 0; t < 4; ++t) {
        float tot = 0.f;
#pragma unroll
        for (int w = 0; w < 8; ++w) tot += part[(t * 8 + w) * 64 + lane];
        const float rstd = __builtin_amdgcn_rsqf(tot * (1.0f / 128.0f) + EPS_) * scale;
        f32x4 a0, a1, b0, b1; unpack8(raw[t][0], a0, a1); unpack8(raw[t][1], b0, b1);
        *(u32x4*)(tiles + (size_t)t * 8192 + (2 * wid) * 512 + lane * 8) = pack8(a0 * g0 * rstd, a1 * g1 * rstd);
        *(u32x4*)(tiles + (size_t)t * 8192 + (2 * wid + 1) * 512 + lane * 8) = pack8(b0 * g2 * rstd, b1 * g3 * rstd);
    }
    __syncthreads();
}

__device__ __forceinline__ void cumsum_unit(LAS unsigned char* lds, const float* logf, float* c2, int bh, const float* gq, const float* gk, int* lo_tab) {
    const int tid = threadIdx.x, lane = tid & 63, wid = tid >> 6, b = bh >> 3, h = bh & 7;
    LAS float* wt = (LAS float*)lds;
    LAS float* wstart = (LAS float*)(lds + 64); LAS float* wend = (LAS float*)(lds + 64 + 256);
    float v[8]; float run = 0.f;
#pragma unroll
    for (int k = 0; k < 8; ++k) { run += logf[(size_t)(b * 4096 + tid * 8 + k) * 8 + h]; v[k] = run; }
    float inc = run;
#pragma unroll
    for (int o = 1; o < 64; o <<= 1) { const float t = __shfl_up(inc, o); if (lane >= o) inc += t; }
    if (lane == 63) wt[wid] = inc;
    __syncthreads();
    float pre = inc - run;
    for (int w = 0; w < wid; ++w) pre += wt[w];
#pragma unroll
    for (int k = 0; k < 8; ++k) c2[(size_t)bh * 4096 + tid * 8 + k] = (pre + v[k]) * LOG2E;
    if ((tid & 7) == 0) wstart[tid >> 3] = (pre + v[0]) * LOG2E;
    if ((tid & 7) == 7) wend[tid >> 3] = (pre + v[7]) * LOG2E;
    __syncthreads();
    float gqm = 0.f, gkm = 0.f;
    for (int i = 0; i < 64; ++i) { gqm = fmaxf(gqm, fabsf(gq[i])); gkm = fmaxf(gkm, fabsf(gk[i])); }
    const float smax = 64.0f * QSCALE * gqm * gkm * 1.02f;
    if (tid < 16) {
        const float cq0 = wstart[4 * tid]; int lo = 0;
        while (lo < 4 * tid && smax + cq0 - wend[lo] + smax < -135.0f) ++lo;
        lo_tab[bh * 16 + tid] = lo;
    }
    if (bh == 0 && tid == 0) ((float*)lo_tab)[1024] = smax;
    __syncthreads();
}

__device__ __forceinline__ void merge_unit(const bf16_t* DIL, const float* LSE, bf16_t* Y, int u) {
    const int tid = threadIdx.x;
#pragma unroll
    for (int k = 0; k < 4; ++k) {
        const int it = tid + 512 * k, row = 64 * u + (it >> 5), c8 = it & 31, h = c8 >> 3;
        const float l0 = LSE[(size_t)row * 4 + h], l1 = LSE[(size_t)(M_ + row) * 4 + h], l2 = LSE[(size_t)(2 * M_ + row) * 4 + h];
        const float mx = fmaxf(l0, fmaxf(l1, l2));
        float w0 = __expf(l0 - mx), w1 = __expf(l1 - mx), w2 = __expf(l2 - mx);
        const float inv = 1.0f / (w0 + w1 + w2); w0 *= inv; w1 *= inv; w2 *= inv;
        f32x4 a0, a1, b0, b1, c0, c1;
        unpack8(*(const u32x4*)(DIL + (size_t)row * 256 + c8 * 8), a0, a1);
        unpack8(*(const u32x4*)(DIL + (size_t)(M_ + row) * 256 + c8 * 8), b0, b1);
        unpack8(*(const u32x4*)(DIL + (size_t)(2 * M_ + row) * 256 + c8 * 8), c0, c1);
        *(u32x4*)(Y + (size_t)row * 1280 + c8 * 8) = pack8(a0 * w0 + b0 * w1 + c0 * w2, a1 * w0 + b1 * w1 + c1 * w2);
    }
}

__device__ __forceinline__ float wave_sum(float v) {
#pragma unroll
    for (int o = 1; o < 64; o <<= 1) v += __shfl_xor(v, o);
    return v;
}
__device__ __forceinline__ void cat_src(const Params& P, int n, const float*& base, int& ld, int& col) {
    const int tile = n >> 8, c = n & 255, bj = c >> 7, wc = (c >> 5) & 3, j = c & 31;
    if (tile < 15) {
        int colbase, head; bool rope = false;
        if (tile < 3) { colbase = 0; head = tile * 4 + wc; rope = true; }
        else if (tile < 6) { colbase = 768; head = (tile - 3) * 4 + wc; rope = true; }
        else if (tile < 9) { colbase = 1536; head = (tile - 6) * 4 + wc; }
        else if (tile < 11) { colbase = 2304; head = (tile - 9) * 4 + wc; }
        else if (tile < 13) { colbase = 2816; head = (tile - 11) * 4 + wc; }
        else { colbase = 3328; head = (tile - 13) * 4 + wc; }
        const int p = 32 * bj + j; const int d = (rope && p < 16) ? ((p & 3) + 4 * ((p >> 3) & 1) + 8 * ((p >> 2) & 1)) : p;
        base = P.in[3]; ld = 4360; col = colbase + head * 64 + d;
    } else if (tile < 17) { base = P.in[3]; ld = 4360; col = 3848 + (2 * (tile - 15) + bj) * 128 + 32 * wc + j; }
    else if (tile < 29) { base = P.in[13]; ld = 3072; col = n - 4352; }
    else if (tile < 31) { base = P.in[10]; ld = 1024; col = (2 * (tile - 29) + bj) * 128 + 32 * wc + j; }
    else { base = P.in[10]; ld = 1024; col = 512 + (2 * (tile - 31) + bj) * 128 + 32 * wc + j; }
}
__device__ __forceinline__ void transpose_item(const float* srcp  , int ldsrc, int k0, const float* kscale, bf16_t* dst, int ldd, int drow0, int dcol0,
                                               LAS float* scr, int lane) {
    float tv[32];
#pragma unroll
    for (int i = 0; i < 32; ++i) { const int kk = 2 * i + (lane >> 5); tv[i] = srcp[(size_t)(k0 + kk) * ldsrc]; }
    if (kscale) {
#pragma unroll
        for (int i = 0; i < 32; ++i) tv[i] *= kscale[k0 + 2 * i + (lane >> 5)];
    }
#pragma unroll
    for (int i = 0; i < 32; ++i) scr[(2 * i + (lane >> 5)) * 33 + (lane & 31)] = tv[i];
    asm volatile("s_waitcnt lgkmcnt(0)" ::: "memory");
    const int c = lane & 7;
#pragma unroll
    for (int jx = 0; jx < 4; ++jx) { const int n = (lane >> 3) + 8 * jx; const LAS float* s = scr + (8 * c) * 33 + n;
        u32x4 o; o.x = pk2(s[0 * 33], s[1 * 33]); o.y = pk2(s[2 * 33], s[3 * 33]); o.z = pk2(s[4 * 33], s[5 * 33]); o.w = pk2(s[6 * 33], s[7 * 33]);
        *(u32x4*)(dst + (size_t)(drow0 + n) * ldd + dcol0 + k0 + 8 * c) = o; }
    asm volatile("s_waitcnt lgkmcnt(0)" ::: "memory");
}

constexpr int TR_I_CAT = 16 * 264, TR_NITEMS = TR_I_CAT + 4 * 32 + 8 * 32 + 8 * 32 + 16 * 32 + 16 * 128 + 64 * 32;
__device__ __forceinline__ void weight_transposes(const Params& P, LAS float* scr, int lane, int widx, int nw, int item_lo, int item_hi) {
    unsigned char* ws = P.ws;
    constexpr int I_CAT = 16 * 264, I_BA = 4 * 32, I_BB = 8 * 32, I_BM = 8 * 32, I_OUT = 16 * 32, I_UP = 16 * 128, I_DN = 64 * 32;
    bf16_t* WCAT = (bf16_t*)(ws + WS_WCAT); bf16_t* WBR = (bf16_t*)(ws + WS_WBR); bf16_t* WOUT = (bf16_t*)(ws + WS_WOUT); bf16_t* WUP = (bf16_t*)(ws + WS_WUP); bf16_t* WDN = (bf16_t*)(ws + WS_WDN);
    for (int it = item_lo + widx; it < item_hi; it += nw) {
        int r = it;
        if (r < I_CAT) { const int kb = r / 264, nb = r % 264; const float* base; int ld, col; cat_src(P, nb * 32 + (lane & 31), base, ld, col);
            transpose_item(base + col, ld, kb * 64, nullptr, WCAT, 1024, nb * 32, 0, scr, lane); continue; }
        r -= I_CAT;
        if (r < I_BA) { const int kb = r / 32, nb = r % 32; transpose_item(P.in[15] + nb * 32 + (lane & 31), 1024, kb * 64, nullptr, WBR, 1280, nb * 32, 0, scr, lane); continue; }
        r -= I_BA;
        if (r < I_BB) { const int kb = r / 32, nb = r % 32; transpose_item(P.in[16] + nb * 32 + (lane & 31), 1024, kb * 64, nullptr, WBR, 1280, nb * 32, 256, scr, lane); continue; }
        r -= I_BB;
        if (r < I_BM) { const int kb = r / 32, nb = r % 32; transpose_item(P.in[17] + nb * 32 + (lane & 31), 1024, kb * 64, nullptr, WBR, 1280, nb * 32, 768, scr, lane); continue; }
        r -= I_BM;
        if (r < I_OUT) { const int kb = r / 32, nb = r % 32; transpose_item(P.in[18] + nb * 32 + (lane & 31), 1024, kb * 64, nullptr, WOUT, 1024, nb * 32, 0, scr, lane); continue; }
        r -= I_OUT;
        if (r < I_UP) { const int kb = r / 128, nb = r % 128; transpose_item(P.in[20] + nb * 32 + (lane & 31), 4096, kb * 64, P.in[19], WUP, 1024, nb * 32, 0, scr, lane); continue; }
        r -= I_UP;
        { const int kb = r / 32, nb = r % 32; transpose_item(P.in[21] + nb * 32 + (lane & 31), 1024, kb * 64, nullptr, WDN, 4096, nb * 32, 0, scr, lane); }
    }
}

__device__ __forceinline__ void p0_prologue(const Params& P, LAS unsigned char* lds, int vcu, int G) {
    const int tid = threadIdx.x, lane = tid & 63, wave = tid >> 6;
    unsigned char* ws = P.ws;
    const float* w_in = P.in[3];
    LAS float* wfl = (LAS float*)(lds + 73728);
    { float wv[16], gv[16];
#pragma unroll
      for (int j = 0; j < 16; ++j) { const int i = tid + 512 * j, k = i >> 3, c = i & 7; wv[j] = w_in[(size_t)k * 4360 + 3840 + c]; gv[j] = P.in[2][k]; }
#pragma unroll
      for (int j = 0; j < 16; ++j) { const int i = tid + 512 * j, k = i >> 3, c = i & 7; wfl[c * 1024 + k] = wv[j] * gv[j]; } }
    const int gtid = vcu * 512 + tid, GT = G * 512;
    { float* ssq = (float*)(ws + WS_SSQ); for (int i = gtid; i < M_; i += GT) ssq[i] = 0.f;
      float* ssqq = (float*)(ws + WS_SSQQ); for (int i = gtid; i < M_ * 4; i += GT) ssqq[i] = 0.f; }
    { float* cosT = (float*)(ws + WS_COS); float* sinT = (float*)(ws + WS_SIN);
      for (int i = gtid; i < 4096 * 8; i += GT) { const int t = i >> 3, f = i & 7; const float inv = powf(500000.0f, -(float)(2 * f) / 16.0f); const float ang = (float)t * inv; cosT[i] = cosf(ang); sinT[i] = sinf(ang); } }
    LAS float* scr = (LAS float*)(lds + wave * 8448);
    const int gw = vcu * 8 + wave, NGW = G * 8;
    weight_transposes(P, scr, lane, gw, NGW, 0, TR_I_CAT);
    __syncthreads();
    bf16_t* AALL = (bf16_t*)P.out;
    float* logf = (float*)(ws + WS_LOGF);
    const float* bfv = P.in[4];
    constexpr int RB = 2;
    const int gwr = (gw + NGW / 2) % NGW;
    for (int base = gwr * RB; base < M_ + 2048; base += NGW * RB) {
        const bool ismem = base >= M_;
        const float* xb = ismem ? P.in[1] + (size_t)(base - M_) * 1024 : P.in[0] + (size_t)base * 1024;
        const float* gp = ismem ? P.in[9] : P.in[2];
        f32x4 v[RB][4];
#pragma unroll
        for (int r = 0; r < RB; ++r)
#pragma unroll
            for (int j = 0; j < 4; ++j) v[r][j] = ((const f32x4*)(xb + (size_t)r * 1024))[lane + 64 * j];
        float ssq[RB], red[RB];
#pragma unroll
        for (int r = 0; r < RB; ++r) { float s = 0.f;
#pragma unroll
            for (int j = 0; j < 4; ++j) s += (v[r][j][0] * v[r][j][0] + v[r][j][1] * v[r][j][1]) + (v[r][j][2] * v[r][j][2] + v[r][j][3] * v[r][j][3]);
            ssq[r] = s; red[r] = 0.f; }
        if (!ismem) {
            float a[RB][8];
#pragma unroll
            for (int c = 0; c < 8; ++c) {
                f32x4 w[4];
#pragma unroll
                for (int j = 0; j < 4; ++j) w[j] = ((const LAS f32x4*)(wfl + c * 1024))[lane + 64 * j];
#pragma unroll
                for (int r = 0; r < RB; ++r) { float t = 0.f;
#pragma unroll
                    for (int j = 0; j < 4; ++j) t += (v[r][j][0] * w[j][0] + v[r][j][1] * w[j][1]) + (v[r][j][2] * w[j][2] + v[r][j][3] * w[j][3]);
                    a[r][c] = t; }
            }
#pragma unroll
            for (int r = 0; r < RB; ++r) {
                float b4[4], b2[2];
#pragma unroll
                for (int i = 0; i < 4; ++i) { const float keep = (lane & 32) ? a[r][i + 4] : a[r][i], send = (lane & 32) ? a[r][i] : a[r][i + 4]; b4[i] = keep + __shfl_xor(send, 32); }
#pragma unroll
                for (int i = 0; i < 2; ++i) { const float keep = (lane & 16) ? b4[i + 2] : b4[i], send = (lane & 16) ? b4[i] : b4[i + 2]; b2[i] = keep + __shfl_xor(send, 16); }
                { const float keep = (lane & 8) ? b2[1] : b2[0], send = (lane & 8) ? b2[0] : b2[1]; red[r] = keep + __shfl_xor(send, 8); }
            }
#pragma unroll
            for (int o = 4; o >= 1; o >>= 1)
#pragma unroll
                for (int r = 0; r < RB; ++r) red[r] += __shfl_xor(red[r], o);
        }
#pragma unroll
        for (int o = 1; o < 64; o <<= 1)
#pragma unroll
            for (int r = 0; r < RB; ++r) ssq[r] += __shfl_xor(ssq[r], o);
#pragma unroll
        for (int r = 0; r < RB; ++r) {
            const float rstd = 1.0f / sqrtf(ssq[r] * (1.0f / 1024.0f) + EPS_);
#pragma unroll
            for (int j = 0; j < 4; ++j) { const f32x4 g = ((const f32x4*)gp)[lane + 64 * j]; const f32x4 y = v[r][j] * rstd * g;
                u32x2 w; w.x = pk2(y[0], y[1]); w.y = pk2(y[2], y[3]); ((u32x2*)(AALL + (size_t)(base + r) * 1024))[lane + 64 * j] = w; }
            if (!ismem && (lane & 7) == 0) { const int c = lane >> 3; const float z = red[r] * rstd + bfv[c]; logf[(size_t)(base + r) * 8 + c] = fminf(z, 0.f) - log1pf(expf(-fabsf(z))); }
        }
    }
}


#define XB_TMO      128
#define XB_XCNT(j)  (256  + 64 * (j))
#define XB_XSUB(j)  (1280 + 64 * (j))
#define XB_XGEN(j)  (2304 + 64 * (j))
#define XB_TOP      3328
#define XB_TOPGEN   3392
#define XCD_BAR_WORDS 3456
#define XB_SPIN_CAP (1u << 20)
__device__ __forceinline__ unsigned xb_ld(unsigned* p)              { return __hip_atomic_load(p, __ATOMIC_RELAXED, __HIP_MEMORY_SCOPE_AGENT); }
__device__ __forceinline__ unsigned xb_add(unsigned* p, unsigned v) { return __hip_atomic_fetch_add(p, v, __ATOMIC_RELAXED, __HIP_MEMORY_SCOPE_AGENT); }
__device__ __forceinline__ unsigned xb_xcc_id() { return (unsigned)__builtin_amdgcn_s_getreg((3 << 11) | 20) & 0xFu; }
#define XB_SPIN(cond, bar) do { unsigned _sp = 0; while (cond) { __builtin_amdgcn_s_sleep(1); \
    if ((++_sp & 255u) == 0u) { if (xb_ld(&(bar)[XB_TMO])) break; if (_sp > XB_SPIN_CAP) { atomicAdd(&(bar)[XB_TMO], 1u); break; } } } } while (0)
struct XcdBarrier { unsigned* bar; unsigned x; volatile LAS unsigned* st; };
__device__ __forceinline__ XcdBarrier xcd_barrier_post(unsigned* bar, volatile LAS unsigned* st) {
    XcdBarrier b; b.bar = bar; b.x = xb_xcc_id(); b.st = st;
    if (threadIdx.x == 0) (void)xb_add(&bar[XB_XCNT(b.x)], 1u);
    return b;
}
__device__ __forceinline__ void xcd_barrier_complete(unsigned* bar, unsigned x, unsigned& nloc, unsigned& nx) {
    const unsigned G = gridDim.x * gridDim.y * gridDim.z;
    unsigned sum, cnt, mine, sp = 0u;
    for (;;) {
        sum = 0u; cnt = 0u; mine = 0u;
#pragma unroll
        for (unsigned j = 0; j < 16; ++j) { const unsigned c = xb_ld(&bar[XB_XCNT(j)]); sum += c; cnt += (c > 0u) ? 1u : 0u; mine = (j == x) ? c : mine; }
        if (sum == G) break;
        __builtin_amdgcn_s_sleep(1);
        if ((++sp & 255u) == 0u) { if (xb_ld(&bar[XB_TMO])) break; if (sp > XB_SPIN_CAP) { atomicAdd(&bar[XB_TMO], 1u); break; } }
    }
    nloc = mine > 0u ? mine : 1u; nx = cnt > 0u ? cnt : 1u;
}
__device__ __forceinline__ void xcd_barrier(const XcdBarrier& b) {
    asm volatile("s_waitcnt vmcnt(0)" ::: "memory");
    __syncthreads();
    if (threadIdx.x == 0) {
        unsigned* bar = b.bar;
        __builtin_amdgcn_s_waitcnt(0);
        unsigned nloc = b.st[0], nx = b.st[1];
        if (nloc == 0u) { xcd_barrier_complete(bar, b.x, nloc, nx); b.st[0] = nloc; b.st[1] = nx; }
        const unsigned old = xb_add(&bar[XB_XSUB(b.x)], 1u);
        const unsigned gen = old / nloc;
        if (old + 1u == (gen + 1u) * nloc) {
            __builtin_amdgcn_fence(__ATOMIC_RELEASE, "agent");
            asm volatile("s_waitcnt vmcnt(0)" ::: "memory");
            const unsigned og = xb_add(&bar[XB_TOP], 1u);
            const unsigned tg = og / nx;
            if (og + 1u == (tg + 1u) * nx) xb_add(&bar[XB_TOPGEN], 1u);
            else XB_SPIN(xb_ld(&bar[XB_TOPGEN]) == tg, bar);
            __builtin_amdgcn_fence(__ATOMIC_ACQUIRE, "agent");
            xb_add(&bar[XB_XGEN(b.x)], 1u);
            asm volatile("s_waitcnt vmcnt(0)" ::: "memory");
        } else {
            XB_SPIN(xb_ld(&bar[XB_XGEN(b.x)]) == gen, bar);
            __builtin_amdgcn_fence(__ATOMIC_ACQUIRE, "agent");
            asm volatile("s_waitcnt vmcnt(0)" ::: "memory");
        }
    }
    __syncthreads();
}

__global__ void __launch_bounds__(512, 2) mk_fwd(Params P) {
    extern __shared__ __attribute__((aligned(16))) unsigned char lds_raw[];
    LAS unsigned char* lds = (LAS unsigned char*)lds_raw;
    const int G = gridDim.x, bx = blockIdx.x;
    const int vcu = (G % 8 == 0) ? (bx % 8) * (G / 8) + bx / 8 : bx;
    unsigned char* ws = P.ws;
    const int lo = P.ph_lo, hi = P.ph_hi;
#ifndef PHASE_MASK
#define PHASE_MASK 255
#endif
#define IN(k) (((PHASE_MASK >> (k)) & 1) && lo <= (k) && (k) < hi)
#define SEAM(k) do { if (IN(k) && IN((k) + 1)) { if ((k) == 0) cg::this_grid().sync(); else xcd_barrier(xbar); } } while (0)
    volatile LAS unsigned* xst = (volatile LAS unsigned*)(lds + LDS_BYTES - 64);
    if (threadIdx.x < 2) xst[threadIdx.x] = 0u;
    __syncthreads();
    XcdBarrier xbar; xbar.bar = (unsigned*)(ws + WS_BAR); xbar.x = 0; xbar.st = xst;
    if (hi - lo > 1) xbar = xcd_barrier_post((unsigned*)(ws + WS_BAR), xst);
    bf16_t* AALL = (bf16_t*)P.out;
    bf16_t* DIL = (bf16_t*)((unsigned char*)P.out + DO_DIL);
    bf16_t* Y = (bf16_t*)((unsigned char*)P.out + DO_Y);
    float* LSE = (float*)(ws + WS_LSE);
    float* C2 = (float*)(ws + WS_C2);

    if (IN(0)) { p0_prologue(P, lds, vcu, G); }
    SEAM(0);
    if (IN(1)) {
        if (G >= 224 && bx >= G - 64) cumsum_unit(lds, (const float*)(ws + WS_LOGF), C2, bx - (G - 64), P.in[7], P.in[8], (int*)(ws + WS_LO));
        pg8::Gemm g{AALL, (const bf16_t*)(ws + WS_WCAT), 1024, 1024};
        SchedP1 S{G, bx};
        EpiP1 E{(bf16_t*)(ws + WS_QA), (bf16_t*)(ws + WS_KA), (bf16_t*)(ws + WS_VA), (bf16_t*)(ws + WS_QB), (bf16_t*)(ws + WS_KB), (bf16_t*)(ws + WS_VB), (bf16_t*)(ws + WS_QM),
                (bf16_t*)(ws + WS_KM), (bf16_t*)(ws + WS_VM), (unsigned char*)(ws + WS_GATES), (float*)(ws + WS_SSQQ), P.in[5], P.in[6], P.in[7], P.in[8], P.in[14], (const float*)(ws + WS_COS), (const float*)(ws + WS_SIN)};
        pg8::gemm_phase<EpiP1, SchedP1>(lds, g, S, E);
        {
            const int maxu = (3744 + G - 1) / G; int first_short = 3744 - (maxu - 1) * G; if (first_short >= G) first_short = 0;
            if (bx >= first_short) {
                const int tid_ = threadIdx.x, wave_ = tid_ >> 6, lane_ = tid_ & 63;
                weight_transposes(P, (LAS float*)(lds + wave_ * 8448), lane_, (bx - first_short) * 8 + wave_, (G - first_short) * 8, TR_I_CAT, TR_NITEMS);
            }
        }
    }
    SEAM(1);
    const bool fuse23 = IN(2) && IN(3) && G >= 224;
    if (IN(2)) {
        dil_phase(lds, ws, DIL, LSE, bx, G);
        for (int L = bx; L < 32 + 64; L += G) {
            if (L < 32) {
                memnorm_unit(lds, (bf16_t*)(ws + WS_KM) + (size_t)L * 4 * 8192, P.in[12], P.in[11], 1.0f);
            } else if (G < 224) {
                cumsum_unit(lds, (const float*)(ws + WS_LOGF), C2, L - 32, P.in[7], P.in[8], (int*)(ws + WS_LO));
            }
        }
        if (fuse23) {
            asm volatile("s_waitcnt vmcnt(0)" ::: "memory");
            __syncthreads();
            if (threadIdx.x == 0) {
                __builtin_amdgcn_fence(__ATOMIC_RELEASE, "agent");
                asm volatile("s_waitcnt vmcnt(0)" ::: "memory");
                (void)__hip_atomic_fetch_add((unsigned*)(ws + WS_QCTR) + 64, 1u, __ATOMIC_RELAXED, __HIP_MEMORY_SCOPE_AGENT);
            }
        }
    }
    if (!fuse23) SEAM(2);
    if (IN(3)) {
        const int* LO = (const int*)(ws + WS_LO); const float smax_fox = ((const float*)LO)[1024];
        unsigned* qctr = (unsigned*)(ws + WS_QCTR);
        volatile LAS int* qslot = (volatile LAS int*)(lds + LDS_BYTES - 128);
        bool p2a_seen = false;
        for (;;) {
            if (threadIdx.x == 0) *qslot = (int)__hip_atomic_fetch_add(qctr, 1u, __ATOMIC_RELAXED, __HIP_MEMORY_SCOPE_AGENT);
            __syncthreads();
            const int L = __builtin_amdgcn_readfirstlane(*qslot);
            __syncthreads();
            if (L >= 2048) break;
            if (fuse23 && L >= 1024 && !p2a_seen) {
                if (threadIdx.x == 0) {
                    unsigned* dn = (unsigned*)(ws + WS_QCTR) + 64; unsigned sp = 0;
                    while (__hip_atomic_load(dn, __ATOMIC_RELAXED, __HIP_MEMORY_SCOPE_AGENT) < (unsigned)G) { __builtin_amdgcn_s_sleep(1); if (++sp > (1u << 22)) break; }
                    __builtin_amdgcn_fence(__ATOMIC_ACQUIRE, "agent");
                    asm volatile("s_waitcnt vmcnt(0)" ::: "memory");
                }
                __syncthreads();
                p2a_seen = true;
            }
            if (L < 1024) {
                const int qblk = 15 - (L >> 6), bh = L & 63, b = bh >> 3, h = bh & 7;
                const size_t Rs = (size_t)bh << 12;
                attn_unit<64, 1>(lds, (const bf16_t*)(ws + WS_QB) + Rs * 64, (const bf16_t*)(ws + WS_KB) + Rs * 64, (const bf16_t*)(ws + WS_VB) + Rs * 64, C2 + Rs, qblk,
                                 Y + 256 + h * 64, 1280, b * 4096, 0, nullptr, LO[bh * 16 + qblk], smax_fox);
            } else if (L < 1536) {
                const int u = L - 1024, bh = u >> 4, qblk = u & 15, b = bh >> 2, h = bh & 3;
                attn_unit<128, 2>(lds, (const bf16_t*)(ws + WS_QM) + ((size_t)bh << 12) * 128, (const bf16_t*)(ws + WS_KM) + ((size_t)bh << 8) * 128, (const bf16_t*)(ws + WS_VM) + ((size_t)bh << 8) * 128,
                                  (const float*)(ws + WS_SSQQ) + (size_t)b * 4096 * 4 + h, qblk, Y + 768 + h * 128, 1280, b * 4096, 0, nullptr, 0, 0.f);
            } else {
                merge_unit(DIL, LSE, Y, L - 1536);
            }
        }
    }
    SEAM(3);
    if (IN(4)) {
        pg8::Gemm g{Y, (const bf16_t*)(ws + WS_WBR), 1280, 1280};
        SchedP3 S{G, bx};
        EpiMerge E{(const unsigned char*)(ws + WS_GATES), (bf16_t*)(ws + WS_MERGED)};
        pg8::gemm_phase<EpiMerge, SchedP3>(lds, g, S, E);
    }
    SEAM(4);
    if (IN(5)) {
        pg8::Gemm g{(const bf16_t*)(ws + WS_MERGED), (const bf16_t*)(ws + WS_WOUT), 1024, 1024};
        SchedSimple S{G, bx, 4, 16};
        EpiOut E{P.in[0], P.out, (bf16_t*)(ws + WS_X1B), (float*)(ws + WS_SSQ)};
        pg8::gemm_phase<EpiOut, SchedSimple>(lds, g, S, E);
    }
    SEAM(5);
    if (IN(6)) {
        pg8::Gemm g{(const bf16_t*)(ws + WS_X1B), (const bf16_t*)(ws + WS_WUP), 1024, 1024};
        SchedSimple S{G, bx, 16, 16};
        EpiUp E{(const float*)(ws + WS_SSQ), (bf16_t*)(ws + WS_HMID)};
        pg8::gemm_phase<EpiUp, SchedSimple>(lds, g, S, E);
    }
    SEAM(6);
    if (IN(7)) {
        pg8::Gemm g{(const bf16_t*)(ws + WS_HMID), (const bf16_t*)(ws + WS_WDN), 4096, 4096};
        SchedSimple S{G, bx, 4, 64};
        EpiDown E{P.out, (const bf16_t*)(ws + WS_X1B)};
        pg8::gemm_phase<EpiDown, SchedSimple>(lds, g, S, E);
    }
#undef IN
#undef SEAM
}

extern "C" void kernel_launch(void* const* d_in, const int* in_sizes, int n_in, void* d_out, int out_size, void* d_ws, size_t ws_size, hipStream_t stream) {
    static int grid = 0;
    if (grid == 0) {
        if (n_in != 22 || in_sizes[0] != M_ * DM || out_size != M_ * DM || ws_size < WS_END) {
            fprintf(stderr, "kernel_launch: unexpected shapes (n_in %d, in0 %d, out %d, ws %zu); nothing launched\n", n_in, n_in > 0 ? in_sizes[0] : -1, out_size, ws_size); grid = -1; return; }
        int dev = 0, cus = 0, per_cu = 0;
        if (hipGetDevice(&dev) != hipSuccess || hipDeviceGetAttribute(&cus, hipDeviceAttributeMultiprocessorCount, dev) != hipSuccess) { grid = -1; return; }
        if (hipFuncSetAttribute((const void*)mk_fwd, hipFuncAttributeMaxDynamicSharedMemorySize, LDS_BYTES) != hipSuccess) { fprintf(stderr, "kernel_launch: hipFuncSetAttribute failed\n"); grid = -1; return; }
        if (hipOccupancyMaxActiveBlocksPerMultiprocessor(&per_cu, (const void*)mk_fwd, 512, LDS_BYTES) != hipSuccess || per_cu < 1) { fprintf(stderr, "kernel_launch: occupancy query gave %d\n", per_cu); (void)hipGetLastError(); grid = -1; return; }
        grid = cus * 1;
    }
    if (grid < 0) return;
    if (hipMemsetAsync((char*)d_ws + WS_BAR, 0, WS_BAR_BYTES, stream) != hipSuccess) { fprintf(stderr, "kernel_launch: hipMemsetAsync failed\n"); return; }
    Params p{};
    for (int i = 0; i < 22; ++i) p.in[i] = (const float*)d_in[i];
    p.out = (float*)d_out; p.ws = (unsigned char*)d_ws;
#if MK_MULTI
    for (int ph = 0; ph < NPH; ++ph) { p.ph_lo = ph; p.ph_hi = ph + 1; hipLaunchKernelGGL(mk_fwd, dim3(grid), dim3(512), LDS_BYTES, stream, p); }
#else
    p.ph_lo = 0; p.ph_hi = NPH;
    void* args[] = {&p};
    hipError_t e = hipLaunchCooperativeKernel((const void*)mk_fwd, dim3(grid), dim3(512), args, LDS_BYTES, stream);
    if (e != hipSuccess) fprintf(stderr, "cooperative launch failed: %s (grid %d)\n", hipGetErrorString(e), grid);
#endif
}
```
